# Optimizing an MI355X kernel written in HIP

```python
import math
import jax, jax.numpy as jnp
from jax import lax
import numpy as np

D_MODEL = 1024
BATCH = 4
SEQ = 8192
DEPTH = 2

GRID_W = 64
CTX_LEN = 256
EPS = 1e-6
N_MOD = 9
D_FF = 2816
D_CONV = 512
CONV_W = 3
MLA_HEADS = 8
MLA_NOPE = 64
MLA_ROPE = 32
MLA_V = 64
MLA_Q_RANK = 256
MLA_KV_RANK = 128
MLA_SCALE = (MLA_NOPE + MLA_ROPE) ** -0.5
ROPE_BASE = 10000.0
Q_BLOCK = 128
EVEN_Q_START = 3 * D_CONV
EVEN_KV_START = EVEN_Q_START + MLA_Q_RANK
D_EVEN_IN = EVEN_KV_START + MLA_KV_RANK + MLA_ROPE
D_EVEN_OUT = D_CONV + MLA_HEADS * MLA_V
HGRN_HEADS = 8
HGRN_EXPAND = 128
D_HGRN = HGRN_HEADS * HGRN_EXPAND
HGRN_SCALE = HGRN_EXPAND ** -0.5
HGRN_CHUNK = 64
D_ODD_IN = 5 * D_HGRN
N_EVEN = (DEPTH + 1) // 2
N_ODD = DEPTH // 2

kernel_name = "hybrid_conv_mla_hgrn2_macaron_dit"


def rmsnorm(x, g):
    xf = x.astype(jnp.float32)
    y = xf * lax.rsqrt(jnp.mean(xf * xf, axis=-1, keepdims=True) + EPS)
    return (y * g.astype(jnp.float32)).astype(x.dtype)


def modulate(h, shift, scale):
    return h * (1 + scale) + shift


def swiglu(u, w1, w3, w2):
    return (jax.nn.silu(u @ w1) * (u @ w3)) @ w2


def ada_mod(cond, w, b):
    m = jax.nn.silu(cond) @ w + b
    return m.reshape(m.shape[:-1] + (N_MOD, D_MODEL))


def ffn_half(h, m, j, g, w1, w3, w2):
    u = modulate(rmsnorm(h, g), m[:, :, 3 * j], m[:, :, 3 * j + 1])
    return h + 0.5 * m[:, :, 3 * j + 2] * swiglu(u, w1, w3, w2)


def axial_rope_tables(rows):
    row = jnp.repeat(jnp.arange(rows, dtype=jnp.int32), GRID_W).astype(jnp.float32)
    col = jnp.tile(jnp.arange(GRID_W, dtype=jnp.int32), rows).astype(jnp.float32)
    n_freq = MLA_ROPE // 4
    inv = ROPE_BASE ** (-jnp.arange(n_freq, dtype=jnp.float32) / n_freq)
    ang = jnp.stack([row[:, None] * inv, col[:, None] * inv], axis=1)
    return jnp.cos(ang), jnp.sin(ang)


def apply_axial_rope(x, cos, sin):
    shp = x.shape
    xr = x.reshape(shp[:-1] + (2, 2, MLA_ROPE // 4))
    x1, x2 = xr[..., 0, :], xr[..., 1, :]
    c = cos[:, None].astype(x.dtype)
    s = sin[:, None].astype(x.dtype)
    return jnp.stack([x1 * c - x2 * s, x1 * s + x2 * c], axis=-2).reshape(shp)


def short_conv_centred(u, w):
    n = u.shape[1]
    up = jnp.pad(u, ((0, 0), (1, 1), (0, 0)))
    return up[:, :n] * w[0] + up[:, 1:n + 1] * w[1] + up[:, 2:] * w[2]


def short_conv_mixer(p, conv_w):
    gate_b, gate_c, v = jnp.split(p, 3, axis=-1)
    return gate_b * short_conv_centred(gate_c * v, conv_w)


def mla_queries(c_q, q_norm_g, w_uq):
    bsz, n = c_q.shape[:2]
    q = (rmsnorm(c_q, q_norm_g) @ w_uq).reshape(bsz, n, MLA_HEADS, MLA_NOPE + MLA_ROPE)
    return q[..., :MLA_NOPE], q[..., MLA_NOPE:]


def mla_keys_values(p_kv, kv_norm_g, w_ukv):
    bsz, n = p_kv.shape[:2]
    c_kv, k_r = p_kv[..., :MLA_KV_RANK], p_kv[..., MLA_KV_RANK:]
    kv = (rmsnorm(c_kv, kv_norm_g) @ w_ukv).reshape(bsz, n, MLA_HEADS, MLA_NOPE + MLA_V)
    return kv[..., :MLA_NOPE], k_r[:, :, None, :], kv[..., MLA_NOPE:]


def mla_attend(q_n, q_r, k_n, k_r, v):
    s = jnp.einsum('bqhd,bkhd->bhqk', q_n, k_n) + jnp.einsum('bqhd,bkd->bhqk', q_r, k_r)
    p = jax.nn.softmax(s.astype(jnp.float32) * MLA_SCALE, axis=-1).astype(v.dtype)
    return jnp.einsum('bhqk,bkhd->bqhd', p, v)


def mla_blocked(q_n, q_r, k_n, k_r, v):
    bsz, n, H, _ = q_n.shape
    nb = n // Q_BLOCK

    def to_blocks(a):
        return jnp.moveaxis(a.reshape(bsz, nb, Q_BLOCK, H, a.shape[-1]), 1, 0)

    o = lax.map(lambda qs: mla_attend(qs[0], qs[1], k_n, k_r, v), (to_blocks(q_n), to_blocks(q_r)))
    return jnp.moveaxis(o, 0, 1).reshape(bsz, n, H * v.shape[-1])


def even_mixer(h_x, h_c, w_in, conv_w, q_norm_g, w_uq, kv_norm_g, w_ukv, w_out, cos, sin, need_ctx_out):
    bsz, n_ctx = h_c.shape[:2]
    p_x = h_x @ w_in
    a_x = short_conv_mixer(p_x[..., :EVEN_Q_START], conv_w)
    qn_x, qr_x = mla_queries(p_x[..., EVEN_Q_START:EVEN_KV_START], q_norm_g, w_uq)
    kn_x, kr_x, v_x = mla_keys_values(p_x[..., EVEN_KV_START:], kv_norm_g, w_ukv)
    qr_x = apply_axial_rope(qr_x, cos, sin)
    kr_x = apply_axial_rope(kr_x, cos, sin)
    kn_c, kr_c, v_c = mla_keys_values(h_c @ w_in[:, EVEN_KV_START:], kv_norm_g, w_ukv)
    k_n = jnp.concatenate([kn_c, kn_x], axis=1)
    k_r = jnp.concatenate([kr_c, kr_x], axis=1)[:, :, 0]
    v = jnp.concatenate([v_c, v_x], axis=1)
    b_x = mla_blocked(qn_x, qr_x, k_n, k_r, v)
    y_x = jnp.concatenate([a_x, b_x], axis=-1) @ w_out
    if not need_ctx_out:
        return y_x, None
    p_c = h_c @ w_in[:, :EVEN_KV_START]
    a_c = short_conv_mixer(p_c[..., :EVEN_Q_START], conv_w)
    qn_c, qr_c = mla_queries(p_c[..., EVEN_Q_START:], q_norm_g, w_uq)
    b_c = mla_attend(qn_c, qr_c, kn_c, kr_c[:, :, 0], v_c).reshape(bsz, n_ctx, MLA_HEADS * MLA_V)
    y_c = jnp.concatenate([a_c, b_c], axis=-1) @ w_out
    return y_x, y_c


def gla_chunked(q, k, v, log_f, s0):
    bsz, n, H, _ = q.shape
    nc = n // HGRN_CHUNK

    def chunks(a):
        return a.reshape(bsz, nc, HGRN_CHUNK, H, a.shape[-1])

    q, k, v, log_f = chunks(q), chunks(k), chunks(v), chunks(log_f)
    b = jnp.cumsum(log_f, axis=2)
    b_last = b[:, :, -1:]
    q_t = q * jnp.exp(b)
    k_t = k * jnp.exp(-b)
    k_end = k * jnp.exp(b_last - b)
    mask = jnp.tril(jnp.ones((HGRN_CHUNK, HGRN_CHUNK), dtype=bool))
    att = jnp.where(mask, jnp.einsum('bnchk,bnshk->bnhcs', q_t, k_t), 0.0)
    o_intra = jnp.einsum('bnhcs,bnshv->bnchv', att, v)
    ds = jnp.einsum('bnchk,bnchv->nbhkv', k_end, v)
    decay = jnp.moveaxis(jnp.exp(b_last[:, :, 0]), 1, 0)

    def step(s, inp):
        a, d = inp
        return a[..., None] * s + d, s

    s_final, s_prev = lax.scan(step, s0, (decay, ds))
    o_inter = jnp.einsum('bnchk,nbhkv->bnchv', q_t, s_prev)
    return (o_intra + o_inter).reshape(bsz, n, H, v.shape[-1]), s_final


def context_final_state(k, v, log_f):
    b = jnp.cumsum(log_f, axis=1)
    return jnp.einsum('bthk,bthv->bhkv', k * jnp.exp(b[:, -1:] - b), v)


def odd_mixer(h_x, h_c, w_in, lb, g_norm_g, w_out, need_ctx_out):
    f32 = jnp.float32

    def heads(a):
        return a.reshape(a.shape[:2] + (HGRN_HEADS, HGRN_EXPAND)).astype(f32)

    lb = lb.reshape(2, HGRN_HEADS, HGRN_EXPAND)

    def gates(z, lb_dir):
        f = lb_dir + (1 - lb_dir) * jax.nn.sigmoid(z)
        return jnp.log(f), 1 - f

    def flip(a):
        return jnp.flip(a, axis=1)

    def readout(o, g, dtype):
        y = rmsnorm(o, g_norm_g).astype(dtype) * jax.nn.silu(g.reshape(o.shape).astype(dtype))
        return y.reshape(y.shape[:2] + (D_HGRN,)) @ w_out

    q_x, i_x, zf_x, zb_x, g_x = jnp.split(h_x @ w_in, 5, axis=-1)
    q_x, i_x = heads(q_x) * HGRN_SCALE, heads(i_x)
    lf_xf, k_xf = gates(heads(zf_x), lb[0])
    lf_xb, k_xb = gates(heads(zb_x), lb[1])
    i_c, zf_c, zb_c = jnp.split(h_c @ w_in[:, D_HGRN:4 * D_HGRN], 3, axis=-1)
    i_c = heads(i_c)
    lf_cf, k_cf = gates(heads(zf_c), lb[0])
    lf_cb, k_cb = gates(heads(zb_c), lb[1])
    y_c = None
    if need_ctx_out:
        q_c = heads(h_c @ w_in[:, :D_HGRN]) * HGRN_SCALE
        g_c = h_c @ w_in[:, 4 * D_HGRN:]
        zeros = jnp.zeros((h_c.shape[0], HGRN_HEADS, HGRN_EXPAND, HGRN_EXPAND), f32)
        o_cf, s_cf = gla_chunked(q_c, k_cf, i_c, lf_cf, zeros)
        o_cb, s_cb = gla_chunked(flip(q_c), flip(k_cb), flip(i_c), flip(lf_cb), zeros)
        y_c = readout(o_cf + flip(o_cb), g_c, h_c.dtype)
    else:
        s_cf = context_final_state(k_cf, i_c, lf_cf)
        s_cb = context_final_state(flip(k_cb), flip(i_c), flip(lf_cb))
    o_xf, _ = gla_chunked(q_x, k_xf, i_x, lf_xf, s_cf)
    o_xb, _ = gla_chunked(flip(q_x), flip(k_xb), flip(i_x), flip(lf_xb), s_cb)
    y_x = readout(o_xf + flip(o_xb), g_x, h_x.dtype)
    return y_x, y_c


def setup_inputs(seed: int = 0) -> dict:
    key = jax.random.key(seed)
    ks = jax.random.split(key, 22)

    def nrm(k, shape, scale=1.0):
        return jax.random.normal(k, shape, jnp.float32) * scale

    def w(k, shape, fan_in, scale=1.0):
        return nrm(k, shape, scale * fan_in ** -0.5)

    def gain(k, shape):
        return 1.0 + nrm(k, shape, 0.02)

    return {
        "x": nrm(ks[0], (BATCH, SEQ, D_MODEL)),
        "c": nrm(ks[1], (BATCH, D_MODEL)),
        "ctx": nrm(ks[2], (BATCH, CTX_LEN, D_MODEL)),
        "c_ctx": nrm(ks[3], (D_MODEL,)),
        "ada_w": w(ks[4], (DEPTH, D_MODEL, N_MOD * D_MODEL), D_MODEL, 0.5),
        "ada_b": nrm(ks[5], (DEPTH, N_MOD * D_MODEL), 0.02),
        "norm_g": gain(ks[6], (DEPTH, 3, D_MODEL)),
        "ffn_w1": w(ks[7], (DEPTH, 2, D_MODEL, D_FF), D_MODEL),
        "ffn_w3": w(ks[8], (DEPTH, 2, D_MODEL, D_FF), D_MODEL),
        "ffn_w2": w(ks[9], (DEPTH, 2, D_FF, D_MODEL), D_FF),
        "even_w_in": w(ks[10], (N_EVEN, D_MODEL, D_EVEN_IN), D_MODEL),
        "even_conv_w": w(ks[11], (N_EVEN, CONV_W, D_CONV), CONV_W),
        "mla_q_norm_g": gain(ks[12], (N_EVEN, MLA_Q_RANK)),
        "mla_w_uq": w(ks[13], (N_EVEN, MLA_Q_RANK, MLA_HEADS * (MLA_NOPE + MLA_ROPE)), MLA_Q_RANK),
        "mla_kv_norm_g": gain(ks[14], (N_EVEN, MLA_KV_RANK)),
        "mla_w_ukv": w(ks[15], (N_EVEN, MLA_KV_RANK, MLA_HEADS * (MLA_NOPE + MLA_V)), MLA_KV_RANK),
        "even_w_out": w(ks[16], (N_EVEN, D_EVEN_OUT, D_MODEL), D_EVEN_OUT),
        "odd_w_in": w(ks[17], (N_ODD, D_MODEL, D_ODD_IN), D_MODEL),
        "hgrn_lb_logits": nrm(ks[18], (DEPTH, 2, D_HGRN), 0.1),
        "hgrn_g_norm_g": gain(ks[19], (N_ODD, HGRN_EXPAND)),
        "odd_w_out": w(ks[20], (N_ODD, D_HGRN, D_MODEL), D_HGRN),
        "final_norm_g": gain(ks[21], (D_MODEL,)),
    }


def reference(x, c, ctx, c_ctx, ada_w, ada_b, norm_g, ffn_w1, ffn_w3, ffn_w2, even_w_in, even_conv_w,
              mla_q_norm_g, mla_w_uq, mla_kv_norm_g, mla_w_ukv, even_w_out, odd_w_in, hgrn_lb_logits,
              hgrn_g_norm_g, odd_w_out, final_norm_g):
    rows = x.shape[1] // GRID_W
    cos, sin = axial_rope_tables(rows)
    lb_p = jax.nn.softmax(hgrn_lb_logits.astype(jnp.float32), axis=0)
    lb_table = jnp.cumsum(lb_p, axis=0) - lb_p[0]
    h = ctx
    for l in range(DEPTH):
        need_ctx_out = l < DEPTH - 1
        mx = ada_mod(c, ada_w[l], ada_b[l])[:, None]
        mc = ada_mod(c_ctx, ada_w[l], ada_b[l])[None, None]
        x = ffn_half(x, mx, 0, norm_g[l, 0], ffn_w1[l, 0], ffn_w3[l, 0], ffn_w2[l, 0])
        h = ffn_half(h, mc, 0, norm_g[l, 0], ffn_w1[l, 0], ffn_w3[l, 0], ffn_w2[l, 0])
        ux = modulate(rmsnorm(x, norm_g[l, 1]), mx[:, :, 3], mx[:, :, 4])
        uh = modulate(rmsnorm(h, norm_g[l, 1]), mc[:, :, 3], mc[:, :, 4])
        if l % 2 == 0:
            e = l // 2
            y_x, y_c = even_mixer(ux, uh, even_w_in[e], even_conv_w[e], mla_q_norm_g[e], mla_w_uq[e],
                                  mla_kv_norm_g[e], mla_w_ukv[e], even_w_out[e], cos, sin, need_ctx_out)
        else:
            o = l // 2
            y_x, y_c = odd_mixer(ux, uh, odd_w_in[o], lb_table[l], hgrn_g_norm_g[o], odd_w_out[o], need_ctx_out)
        x = x + mx[:, :, 5] * y_x
        x = ffn_half(x, mx, 2, norm_g[l, 2], ffn_w1[l, 1], ffn_w3[l, 1], ffn_w2[l, 1])
        if need_ctx_out:
            h = h + mc[:, :, 5] * y_c
            h = ffn_half(h, mc, 2, norm_g[l, 2], ffn_w1[l, 1], ffn_w3[l, 1], ffn_w2[l, 1])
    return rmsnorm(x, final_norm_g)
```

```cpp
#include <hip/hip_runtime.h>
#include <hip/hip_cooperative_groups.h>
#include <cstdio>
namespace cg = cooperative_groups;

typedef unsigned short bf16_t;
typedef short bf16x8 __attribute__((ext_vector_type(8)));
typedef float f32x4 __attribute__((ext_vector_type(4)));
typedef unsigned u32x2 __attribute__((ext_vector_type(2)));
typedef unsigned u32x4 __attribute__((ext_vector_type(4)));
typedef _Float16 h16x4 __attribute__((ext_vector_type(4)));
typedef _Float16 h16x8 __attribute__((ext_vector_type(8)));

constexpr int M_ALL = 33792;
constexpr int NCTX = 1024;
constexpr int DM = 1024;
constexpr int DFF = 2816;
constexpr int NKEY = 8448;
constexpr int NTHR = 512;
constexpr float QSCALE = 0.10206207261596577f * 1.4426950408889634f;
constexpr float HSCALE = 0.08838834764831845f;

struct Params {
  const float *x, *c, *ctx, *c_ctx, *ada_w, *ada_b, *norm_g, *ffn_w1, *ffn_w3, *ffn_w2, *even_w_in, *even_conv_w,
      *q_norm_g, *w_uq, *kv_norm_g, *w_ukv, *even_w_out, *odd_w_in, *lb_logits, *g_norm_g, *odd_w_out, *final_norm_g;
  float* out;
  bf16_t *W13[4], *W2[4], *WinE, *Wqkv, *WoutE, *WinO, *WoutO;
  float *mod, *XC, *RS, *rope;
  unsigned* bar;
  bf16_t* U;
  char* R;
};

__device__ __forceinline__ float bf2f(bf16_t v) { return __uint_as_float(((unsigned)v) << 16); }
typedef float f32x2 __attribute__((ext_vector_type(2)));
typedef __bf16 bf16v2 __attribute__((ext_vector_type(2)));
__device__ __forceinline__ unsigned pk2(float lo, float hi) { f32x2 v = {lo, hi}; return __builtin_bit_cast(unsigned, __builtin_convertvector(v, bf16v2)); }
__device__ __forceinline__ bf16_t f2bf(float f) { return (bf16_t)(pk2(f, 0.f) & 0xffffu); }
__device__ __forceinline__ float lo2f(unsigned u) { return __uint_as_float(u << 16); }
__device__ __forceinline__ float hi2f(unsigned u) { return __uint_as_float(u & 0xffff0000u); }
__device__ __forceinline__ float wave_sum(float v) {
#pragma unroll
  for (int o = 32; o > 0; o >>= 1) v += __shfl_xor(v, o);
  return v;
}
__device__ __forceinline__ float sigmoidf_(float a) { return __builtin_amdgcn_rcpf(1.f + __expf(-a)); }
__device__ __forceinline__ int row_mi(int r) { return r < NCTX ? 4 : ((r - NCTX) >> 13); }
__device__ __forceinline__ void row_bk(int r, int& b, int& key) {
  if (r < NCTX) { b = r >> 8; key = r & 255; } else { int rr = r - NCTX; b = rr >> 13; key = 256 + (rr & 8191); }
}

constexpr int BM = 256, BK = 64, HALF = 128, NXCD = 8, WGM = 8, HT = HALF * BK, SHM_B = 8 * HT * 2;

__device__ __forceinline__ int lds_byte(int r, int c) {
  int st = (r >> 4) * 2 + (c >> 5), rr = r & 15, cc = c & 31, ob = rr * 64 + cc * 2;
  return st * 1024 + (ob ^ (((ob >> 9) & 1) << 5));
}
__device__ __forceinline__ void stage_rc(int b, int& R, int& C) {
  int st = b / 1024, sb = b % 1024, swz = sb ^ (((sb >> 9) & 1) << 5);
  R = (st >> 1) * 16 + swz / 64; C = (st & 1) * 32 + (swz % 64) / 2;
}

#define NO_EPI_DRAIN 1
#define LAS __attribute__((address_space(3)))
struct EpiNone { static constexpr bool HALFOK = false; __device__ __forceinline__ void operator()(const f32x4 (&)[2][2][4][2], int, int, int, int, int, int, int) const {} };
template <class Epi, class Epi2 = EpiNone>
__device__ __forceinline__ void gemm_phase(const bf16_t* A, int lda, const bf16_t* Bt, int ldb, int K, int pm0, int nM, int pn0, int nN,
                                           const Epi& epi, LAS unsigned char* lds, int nsm = 0, int ksl = 1, const Epi2& epi2 = Epi2()) {
  const int tid = threadIdx.x, wid = __builtin_amdgcn_readfirstlane(tid >> 6), lane = tid & 63, wr = wid >> 2, wc = wid & 3, fr = lane & 15, fq = lane >> 4;
  const int nt = K / BK;
  const int nwg = nM * nN, G = gridDim.x;
  const int nsplit = nsm * nN * ksl, nts = nt / ksl;
  if ((int)blockIdx.x >= nwg + nsplit) return;
  const int Rfull = nwg / G, Lleft = nwg - Rfull * G;
  const bool tail_split = Epi::HALFOK && nsm == 0 && Lleft > 0 && 2 * Lleft <= G;
  unsigned voffA[2], voffB[2];
#pragma unroll
  for (int i = 0; i < 2; ++i) { int R, C; stage_rc(tid * 16 + i * 8192, R, C); voffA[i] = (unsigned)(R * lda + C) * 2u; voffB[i] = (unsigned)(R * ldb + C) * 2u; }
  const size_t kstep = (size_t)(BK * 2);
  const size_t hstepA = (size_t)HALF * lda * 2, hstepB = (size_t)HALF * ldb * 2;
  const unsigned ldsw = (unsigned)wid * 1024u;
  const int aoff = lds_byte(wr * 64 + fr, fq * 8), boff = lds_byte(wc * 32 + fr, fq * 8);
#define G_SA(b, h) (((b) * 2 + (h)) * (HT * 2))
#define G_SB(b, h) ((4 + (b) * 2 + (h)) * (HT * 2))
#define G_STAGE(bufoff, gbase, voff) do { _Pragma("unroll") for (int _i = 0; _i < 2; ++_i) \
    __builtin_amdgcn_global_load_lds((const unsigned*)((const char*)(gbase) + (voff)[_i]), (LAS unsigned*)(lds + (bufoff) + ldsw + _i * 8192), 16, 0, 0); } while (0)
#define G_LDA(dst, b, h) do { _Pragma("unroll") for (int m = 0; m < 4; ++m) _Pragma("unroll") for (int k = 0; k < 2; ++k) dst[m][k] = *(const LAS bf16x8*)(lds + G_SA(b, h) + aoff + m * 2048 + k * 1024); } while (0)
#define G_LDB(dst, b, h) do { _Pragma("unroll") for (int n = 0; n < 2; ++n) _Pragma("unroll") for (int k = 0; k < 2; ++k) dst[n][k] = *(const LAS bf16x8*)(lds + G_SB(b, h) + boff + n * 2048 + k * 1024); } while (0)
#define G_MMA(ai, bj, At, Bx) do { __builtin_amdgcn_s_setprio(1); _Pragma("unroll") for (int m = 0; m < 4; ++m) _Pragma("unroll") for (int n = 0; n < 2; ++n) _Pragma("unroll") for (int k = 0; k < 2; ++k) \
    acc[ai][bj][m][n] = __builtin_amdgcn_mfma_f32_16x16x32_bf16(Bx[n][k], At[m][k], acc[ai][bj][m][n], 0, 0, 0); __builtin_amdgcn_s_setprio(0); } while (0)
#define WAIT_V(n) asm volatile("s_waitcnt vmcnt(" #n ")" ::: "memory")
#define WAIT_L(n) asm volatile("s_waitcnt lgkmcnt(" #n ")" ::: "memory")
#define BAR __builtin_amdgcn_s_barrier()
#define SCHED __builtin_amdgcn_sched_barrier(0)
  auto unit = [&](int i, int& pm, int& pn, int& sl, int& hf) -> bool {
    long L = (long)i * G + blockIdx.x; sl = -1; hf = -1;
    if (tail_split && i >= Rfull) { if (i > Rfull || (int)blockIdx.x >= 2 * Lleft) return false; L = (long)Rfull * G + (blockIdx.x >> 1); hf = blockIdx.x & 1; }
    if (L >= nwg) { const int j = (int)(L - nwg); if (j >= nsplit) return false; sl = j % ksl; const int tile = j / ksl; pm = tile / nN; pn = pn0 + tile % nN; return true; }
    int wgid = (int)L; { const int q = nwg / NXCD, r = nwg % NXCD, xcd = wgid % NXCD, off = wgid / NXCD; wgid = (xcd < r ? xcd * (q + 1) : r * (q + 1) + (xcd - r) * q) + off; }
    const int nig = WGM * nN, gid = wgid / nig, fm = gid * WGM, gsz = (nM - fm) < WGM ? (nM - fm) : WGM;
    pm = pm0 + fm + ((wgid % nig) % gsz); pn = pn0 + (wgid % nig) / gsz; return true;
  };
  int cpm, cpn, csl, chf, npm = 0, npn = 0, nsl = -1, nhf = -1, ui = 0;
  unit(0, cpm, cpn, csl, chf);
  f32x4 acc[2][2][4][2];
#pragma unroll
  for (int a = 0; a < 2; ++a)
#pragma unroll
    for (int b = 0; b < 2; ++b)
#pragma unroll
      for (int m = 0; m < 4; ++m)
#pragma unroll
        for (int n = 0; n < 2; ++n) acc[a][b][m][n] = (f32x4){0.f, 0.f, 0.f, 0.f};
  bf16x8 At[4][2], B0[2][2], B1[2][2];
  const char* cA = (const char*)A + (size_t)cpm * 2 * hstepA + (csl < 0 ? 0 : (size_t)csl * nts * kstep) + (chf > 0 ? hstepA : 0);
  size_t chA = chf < 0 ? hstepA : 0, nhA = hstepA;
  const char* cB = (const char*)Bt + (size_t)cpn * 2 * hstepB + (csl < 0 ? 0 : (size_t)csl * nts * kstep);
  G_STAGE(G_SB(0, 0), cB, voffB); G_STAGE(G_SA(0, 0), cA, voffA); G_STAGE(G_SB(0, 1), cB + hstepB, voffB); G_STAGE(G_SA(0, 1), cA + chA, voffA);
  if (wr == 1) BAR;
  WAIT_V(4); BAR;
  G_STAGE(G_SB(1, 0), cB + kstep, voffB); G_STAGE(G_SA(1, 0), cA + kstep, voffA); G_STAGE(G_SB(1, 1), cB + hstepB + kstep, voffB);
  WAIT_V(6); BAR;
#define G_KLOOP(AI1) \
    _Pragma("nounroll") \
    for (int t = 0; t < cnt; t += 2) { \
      const bool last = (t == cnt - 2); \
      const char* a1 = cA + (size_t)(t + 1) * kstep; \
      const char* a2 = last ? nA : cA + (size_t)(t + 2) * kstep; const char* b2 = last ? nB : cB + (size_t)(t + 2) * kstep; \
      const char* a3 = a2 + kstep; const char* b3 = b2 + kstep; \
      G_LDB(B0, 0, 0); SCHED; G_LDA(At, 0, 0); G_STAGE(G_SA(1, 1), a1 + chA, voffA); \
      WAIT_L(8); BAR; WAIT_L(0); G_MMA(0, 0, At, B0); BAR; SCHED; \
      G_LDB(B1, 0, 1); G_STAGE(G_SB(0, 0), b2, voffB); \
      BAR; WAIT_L(0); G_MMA(0, 1, At, B1); BAR; \
      G_LDA(At, 0, 1); G_STAGE(G_SA(0, 0), a2, voffA); \
      BAR; WAIT_L(0); if (AI1) G_MMA(1, 0, At, B0); BAR; SCHED; \
      G_STAGE(G_SB(0, 1), b2 + hstepB, voffB); \
      WAIT_V(6); BAR; if (AI1) G_MMA(1, 1, At, B1); BAR; \
      G_LDB(B0, 1, 0); SCHED; G_LDA(At, 1, 0); G_STAGE(G_SA(0, 1), a2 + (last ? nhA : chA), voffA); \
      WAIT_L(8); BAR; WAIT_L(0); G_MMA(0, 0, At, B0); BAR; SCHED; \
      G_LDB(B1, 1, 1); G_STAGE(G_SB(1, 0), b3, voffB); \
      BAR; WAIT_L(0); G_MMA(0, 1, At, B1); BAR; \
      G_LDA(At, 1, 1); G_STAGE(G_SA(1, 0), a3, voffA); \
      BAR; WAIT_L(0); if (AI1) G_MMA(1, 0, At, B0); BAR; SCHED; \
      G_STAGE(G_SB(1, 1), b3 + hstepB, voffB); \
      WAIT_V(6); BAR; if (AI1) G_MMA(1, 1, At, B1); BAR; \
    }
  bool pending_half = false;
  for (;;) {
    const bool has_next = unit(ui + 1, npm, npn, nsl, nhf);
    const char* nA = has_next ? (const char*)A + (size_t)npm * 2 * hstepA + (nsl < 0 ? 0 : (size_t)nsl * nts * kstep) + (nhf > 0 ? hstepA : 0) : cA;
    const char* nB = has_next ? (const char*)Bt + (size_t)npn * 2 * hstepB + (nsl < 0 ? 0 : (size_t)nsl * nts * kstep) : cB;
    nhA = has_next ? (nhf < 0 ? hstepA : 0) : chA;
    const int cnt = csl < 0 ? nt : nts;
    G_KLOOP(1)
    if (csl < 0) {
      if constexpr (Epi::HALFOK) epi(acc, cpm * BM, cpn * BM, wr, wc, fr, fq, 2);
      else epi(acc, cpm * BM, cpn * BM, wr, wc, fr, fq);
    } else epi2(acc, cpm * BM, cpn * BM, wr, wc, fr, fq, csl);
#ifndef NO_EPI_DRAIN
    WAIT_V(0);
#endif
    if (!has_next) break;
#pragma unroll
    for (int a = 0; a < 2; ++a)
#pragma unroll
      for (int b = 0; b < 2; ++b)
#pragma unroll
        for (int m = 0; m < 4; ++m)
#pragma unroll
          for (int n = 0; n < 2; ++n) acc[a][b][m][n] = (f32x4){0.f, 0.f, 0.f, 0.f};
    cpm = npm; cpn = npn; csl = nsl; chf = nhf; chA = nhA; cA = nA; cB = nB; ++ui;
    if (chf >= 0) { pending_half = true; break; }
  }
  if constexpr (Epi::HALFOK) {
    if (pending_half) {
      const char* nA = cA; const char* nB = cB; nhA = chA;
      const int cnt = nt;
      G_KLOOP(0)
      epi(acc, cpm * BM + (chf > 0 ? HALF : 0), cpn * BM, wr, wc, fr, fq, 1);
    }
  }
#undef G_KLOOP
  WAIT_V(0);
  if (wr == 0) BAR;
  BAR;
}

typedef f32x4 Acc[2][2][4][2];

struct EpiSwiglu { static constexpr bool HALFOK = true;
  bf16_t* G;
  __device__ __forceinline__ void operator()(const Acc& acc, int brow, int bcol, int wr, int wc, int fr, int fq, int nai) const {
    const int f0 = (bcol >> 1) + 32 * wc + 8 * fq;
    asm volatile("s_waitcnt vmcnt(14)" ::: "memory");
#pragma unroll
    for (int ai = 0; ai < 2; ++ai)
#pragma unroll
      for (int m = 0; m < 4; ++m) if (ai < nai) {
        const int r = brow + 128 * ai + 64 * wr + 16 * m + fr;
        u32x4 o;
#pragma unroll
        for (int bj = 0; bj < 2; ++bj) {
          const f32x4 a = acc[ai][bj][m][0], b = acc[ai][bj][m][1];
          const float g0 = a[0] * sigmoidf_(a[0]) * b[0], g1 = a[1] * sigmoidf_(a[1]) * b[1];
          const float g2 = a[2] * sigmoidf_(a[2]) * b[2], g3 = a[3] * sigmoidf_(a[3]) * b[3];
          if (bj == 0) { o.x = pk2(g0, g1); o.y = pk2(g2, g3); } else { o.z = pk2(g0, g1); o.w = pk2(g2, g3); }
        }
        *(u32x4*)(G + (size_t)r * DFF + f0) = o;
      }
  }
};

struct EpiResid { static constexpr bool HALFOK = false;
  const float *srcC, *srcL; float *dstC, *dstL; const float* gate;   float coef;
  __device__ __forceinline__ void operator()(const Acc& acc, int brow, int bcol, int wr, int wc, int fr, int fq) const {
    const float* g = gate + (size_t)row_mi(brow) * 9 * DM + bcol + 32 * wc + 4 * fq;
    f32x4 gv[2][2];
#pragma unroll
    for (int bj = 0; bj < 2; ++bj)
#pragma unroll
      for (int n = 0; n < 2; ++n) gv[bj][n] = coef * *(const f32x4*)(g + 128 * bj + 16 * n);
    const size_t rb = (size_t)(brow - NCTX + 64 * wr + fr) * DM + bcol + 32 * wc + 4 * fq;
#pragma unroll
    for (int ai = 0; ai < 2; ++ai)
#pragma unroll
      for (int mp = 0; mp < 2; ++mp) {
        f32x4 xv[2][2][2];
#pragma unroll
        for (int mm = 0; mm < 2; ++mm)
#pragma unroll
          for (int bj = 0; bj < 2; ++bj)
#pragma unroll
            for (int n = 0; n < 2; ++n)
              xv[mm][bj][n] = *(const f32x4*)(srcL + rb + (size_t)(128 * ai + 16 * (2 * mp + mm)) * DM + 128 * bj + 16 * n);
#pragma unroll
        for (int mm = 0; mm < 2; ++mm)
#pragma unroll
          for (int bj = 0; bj < 2; ++bj)
#pragma unroll
            for (int n = 0; n < 2; ++n)
              *(f32x4*)(dstL + rb + (size_t)(128 * ai + 16 * (2 * mp + mm)) * DM + 128 * bj + 16 * n) = xv[mm][bj][n] + gv[bj][n] * acc[ai][bj][2 * mp + mm][n];
      }
  }
};

struct EpiPart { static constexpr bool HALFOK = false;
  float* PART;
  __device__ __forceinline__ void operator()(const Acc& acc, int brow, int bcol, int wr, int wc, int fr, int fq, int sl) const {
#pragma unroll
    for (int ai = 0; ai < 2; ++ai)
#pragma unroll
      for (int m = 0; m < 4; ++m) {
        const int r = brow + 128 * ai + 64 * wr + 16 * m + fr;
        float* d = PART + ((size_t)sl * NCTX + r) * DM;
#pragma unroll
        for (int bj = 0; bj < 2; ++bj)
#pragma unroll
          for (int n = 0; n < 2; ++n) *(f32x4*)(d + bcol + 128 * bj + 32 * wc + 16 * n + 4 * fq) = acc[ai][bj][m][n];
      }
  }
};

struct EpiBf16 { static constexpr bool HALFOK = false;
  bf16_t* O; int ldc;
  __device__ __forceinline__ void operator()(const Acc& acc, int brow, int bcol, int wr, int wc, int fr, int fq) const {
#pragma unroll
    for (int ai = 0; ai < 2; ++ai)
#pragma unroll
      for (int m = 0; m < 4; ++m) {
        const int r = brow + 128 * ai + 64 * wr + 16 * m + fr;
#pragma unroll
        for (int bj = 0; bj < 2; ++bj)
#pragma unroll
          for (int n = 0; n < 2; ++n) {
            const int c = bcol + 128 * bj + 32 * wc + 16 * n + 4 * fq;
            f32x4 v = acc[ai][bj][m][n];
            u32x2 o; o.x = pk2(v[0], v[1]); o.y = pk2(v[2], v[3]);
            *(u32x2*)(O + (size_t)r * ldc + c) = o;
          }
      }
  }
};

struct EpiP { static constexpr bool HALFOK = true;
  bf16_t* O; float* RS;
  __device__ __forceinline__ void operator()(const Acc& acc, int brow, int bcol, int wr, int wc, int fr, int fq, int nai) const {
    asm volatile("s_waitcnt vmcnt(14)" ::: "memory");
#pragma unroll
    for (int ai = 0; ai < 2; ++ai)
#pragma unroll
      for (int m = 0; m < 4; ++m) if (ai < nai) {
        const int r = brow + 128 * ai + 64 * wr + 16 * m + fr;
        float ss0 = 0.f, ss1 = 0.f;
#pragma unroll
        for (int bj = 0; bj < 2; ++bj) {
          const int c = bcol + 128 * bj + 32 * wc + 8 * fq;
          const f32x4 v0 = acc[ai][bj][m][0], v1 = acc[ai][bj][m][1];
          const float q = v0[0] * v0[0] + v0[1] * v0[1] + v0[2] * v0[2] + v0[3] * v0[3] + v1[0] * v1[0] + v1[1] * v1[1] + v1[2] * v1[2] + v1[3] * v1[3];
          if (bj == 0) ss0 += q; else ss1 += q;
          u32x4 o; o.x = pk2(v0[0], v0[1]); o.y = pk2(v0[2], v0[3]); o.z = pk2(v1[0], v1[1]); o.w = pk2(v1[2], v1[3]);
          *(u32x4*)(O + (size_t)r * 2048 + c) = o;
        }
        if (bcol == 1536) {
          float ss = ss0 + ss1; ss += __shfl_xor(ss, 16); ss += __shfl_xor(ss, 32);
          if (fq == 0) atomicAdd(RS + 2 * r, ss);
        } else if (bcol == 1792) {
          float ss = ss0; ss += __shfl_xor(ss, 16); ss += __shfl_xor(ss, 32);
          if (fq == 0) atomicAdd(RS + 2 * r + 1, ss);
        }
      }
  }
};

struct EpiQ { static constexpr bool HALFOK = false;
  const float* RS; const float* rope;   bf16_t* Qall;
  __device__ __forceinline__ void operator()(const Acc& acc, int brow, int bcol, int wr, int wc, int fr, int fq) const {
#pragma unroll
    for (int ai = 0; ai < 2; ++ai)
#pragma unroll
      for (int m = 0; m < 4; ++m) {
        const int r = brow + 128 * ai + 64 * wr + 16 * m + fr;
        const float rstd = rsqrtf(RS[2 * r] * (1.f / 256.f) + 1e-6f) * QSCALE;
        int b, key; row_bk(r, b, key);
        const bool latent = r >= NCTX;
        const int t = (r - NCTX) & 8191;
        bf16_t* qrow = Qall + ((size_t)(b * 8) * NKEY + key) * 96 + 4 * fq;
#pragma unroll
        for (int bj = 0; bj < 2; ++bj) {
          const int c32 = bcol + 128 * bj + 32 * wc;
          const int h = c32 / 96, d32 = c32 - 96 * h;
#pragma unroll
          for (int n = 0; n < 2; ++n) {
            f32x4 v = acc[ai][bj][m][n] * rstd;
            if (d32 == 64) {
              f32x4 pv;
#pragma unroll
              for (int j = 0; j < 4; ++j) pv[j] = __shfl_xor(v[j], 32);
              if (latent) {
                const float* rp = rope + ((size_t)t * 2 + n) * 16 + 4 * (fq & 1);
                const f32x4 cs = *(const f32x4*)rp, sn = *(const f32x4*)(rp + 8);
                v = (fq < 2) ? (v * cs - pv * sn) : (pv * sn + v * cs);
              }
            }
            u32x2 o; o.x = pk2(v[0], v[1]); o.y = pk2(v[2], v[3]);
            *(u32x2*)(qrow + (size_t)h * (NKEY * 96) + d32 + 16 * n) = o;
          }
        }
      }
  }
};
struct EpiKV { static constexpr bool HALFOK = false;
  const float* RS; bf16_t *Kall, *Vt;
  __device__ __forceinline__ void operator()(const Acc& acc, int brow, int bcol, int wr, int wc, int fr, int fq) const {
#pragma unroll
    for (int ai = 0; ai < 2; ++ai)
#pragma unroll
      for (int m = 0; m < 4; ++m) {
        const int r = brow + 128 * ai + 64 * wr + 16 * m + fr;
        const float rstd = rsqrtf(RS[2 * r + 1] * (1.f / 128.f) + 1e-6f);
        int b, key; row_bk(r, b, key);
        bf16_t* krow = Kall + ((size_t)(b * 8) * NKEY + key) * 96 + 4 * fq;
        bf16_t* vrow = Vt + (size_t)(b * 8) * 64 * NKEY + key + (size_t)(4 * fq) * NKEY;
#pragma unroll
        for (int bj = 0; bj < 2; ++bj) {
          const int cc = bcol - 768 + 128 * bj + 32 * wc, h = cc >> 7, e32 = cc & 127;
#pragma unroll
          for (int n = 0; n < 2; ++n) {
            const f32x4 v = acc[ai][bj][m][n] * rstd;
            if (e32 < 64) {
              u32x2 o; o.x = pk2(v[0], v[1]); o.y = pk2(v[2], v[3]);
              *(u32x2*)(krow + (size_t)h * (NKEY * 96) + e32 + 16 * n) = o;
            } else {
              bf16_t* vp = vrow + (size_t)(h * 64 + e32 - 64 + 16 * n) * NKEY;
#pragma unroll
              for (int j = 0; j < 4; ++j) vp[(size_t)j * NKEY] = f2bf(v[j]);
            }
          }
        }
      }
  }
};

struct EpiQKV { static constexpr bool HALFOK = false;
  EpiQ q; EpiKV kv;
  __device__ __forceinline__ void operator()(const Acc& acc, int brow, int bcol, int wr, int wc, int fr, int fq) const {
    if (bcol < 768) q(acc, brow, bcol, wr, wc, fr, fq); else kv(acc, brow, bcol, wr, wc, fr, fq);
  }
};

struct EpiOdd { static constexpr bool HALFOK = true;
  bf16_t *Qh, *Vv, *Gg; _Float16 *Lf, *Lb; const float* lbl;
  __device__ __forceinline__ void operator()(const Acc& acc, int brow, int bcol, int wr, int wc, int fr, int fq, int nai) const {
    const int sec = bcol >> 10;
    const int cb = (bcol & 1023) + 32 * wc + 8 * fq;
    asm volatile("s_waitcnt vmcnt(14)" ::: "memory");
    if (sec == 2 || sec == 3) {
      const int dir = sec - 2;
      _Float16* O = Lf + (size_t)dir * ((size_t)M_ALL * DM);
#pragma unroll
      for (int bj = 0; bj < 2; ++bj) {
        const int c = cb + 128 * bj;
        f32x4 lb[2];
#pragma unroll
        for (int n = 0; n < 2; ++n) {
          const f32x4 z0 = *(const f32x4*)(lbl + dir * 1024 + c + 4 * n), z1 = *(const f32x4*)(lbl + 2048 + dir * 1024 + c + 4 * n);
#pragma unroll
          for (int j = 0; j < 4; ++j) lb[n][j] = __builtin_amdgcn_rcpf(1.f + __expf(z0[j] - z1[j]));
        }
#pragma unroll
        for (int ai = 0; ai < 2; ++ai)
#pragma unroll
          for (int m = 0; m < 4; ++m) if (ai < nai) {
            const int r = brow + 128 * ai + 64 * wr + 16 * m + fr;
            h16x8 hv;
#pragma unroll
            for (int n = 0; n < 2; ++n) {
              const f32x4 v = acc[ai][bj][m][n];
#pragma unroll
              for (int j = 0; j < 4; ++j) hv[4 * n + j] = (_Float16)__logf(lb[n][j] + (1.f - lb[n][j]) * sigmoidf_(v[j]));
            }
            *(h16x8*)(O + (size_t)r * DM + c) = hv;
          }
      }
    } else {
      bf16_t* O = Qh + (size_t)(sec == 4 ? 2 : sec) * ((size_t)M_ALL * DM);
      const float sc = sec == 0 ? HSCALE : 1.f;
#pragma unroll
      for (int ai = 0; ai < 2; ++ai)
#pragma unroll
        for (int m = 0; m < 4; ++m) if (ai < nai) {
          const int r = brow + 128 * ai + 64 * wr + 16 * m + fr;
#pragma unroll
          for (int bj = 0; bj < 2; ++bj) {
            const int c = cb + 128 * bj;
            const f32x4 v0 = acc[ai][bj][m][0] * sc, v1 = acc[ai][bj][m][1] * sc;
            u32x4 o; o.x = pk2(v0[0], v0[1]); o.y = pk2(v0[2], v0[3]); o.z = pk2(v1[0], v1[1]); o.w = pk2(v1[2], v1[3]);
            *(u32x4*)(O + (size_t)r * DM + c) = o;
          }
        }
    }
  }
};

__device__ __forceinline__ void tr_tile(const float* src, int ldn, int k0, int n0, int nv, bf16_t* dst, int ldk, int kofs, int mode, const float* kscale, float* sm) {
  const int tid = threadIdx.x;
  float v[8];
#pragma unroll
  for (int i = 0; i < 8; ++i) {
    const int e = tid + i * NTHR, k = e >> 6, n = e & 63;
    v[i] = (n < nv) ? src[(size_t)(k0 + k) * ldn + n0 + n] : 0.f;
  }
#pragma unroll
  for (int i = 0; i < 8; ++i) {
    const int e = tid + i * NTHR, k = e >> 6, n = e & 63;
    sm[k * 65 + n] = kscale ? v[i] * kscale[k0 + k] : v[i];
  }
  __syncthreads();
  {
    const int n = tid >> 3, kq = tid & 7;
    const int ng = n0 + n;
    int drow = ng;
    if (mode == 1 || mode == 2) {
      const int pn = ng >> 7, rem = ng & 127, wc = rem >> 5, r2 = rem & 31, fq = r2 >> 3, bj = (r2 >> 2) & 1, j = r2 & 3;
      drow = 256 * pn + 128 * bj + 32 * wc + 16 * (mode - 1) + 4 * fq + j;
    } else if (mode == 3) {
      const int o = ng & 31, fq = o >> 3, nn = (o >> 2) & 1, j = o & 3;
      drow = (ng & ~31) + 16 * nn + 4 * fq + j;
    }
    if (n < nv) {
      u32x4 o;
      o.x = pk2(sm[(8 * kq + 0) * 65 + n], sm[(8 * kq + 1) * 65 + n]);
      o.y = pk2(sm[(8 * kq + 2) * 65 + n], sm[(8 * kq + 3) * 65 + n]);
      o.z = pk2(sm[(8 * kq + 4) * 65 + n], sm[(8 * kq + 5) * 65 + n]);
      o.w = pk2(sm[(8 * kq + 6) * 65 + n], sm[(8 * kq + 7) * 65 + n]);
      *(u32x4*)(dst + (size_t)drow * ldk + kofs + k0 + 8 * kq) = o;
    }
  }
  __syncthreads();
}

__device__ void phase_prep(const Params& p, float* sm) {
  const int tid = threadIdx.x;
  int base = 0;
  const int bid = blockIdx.x, G = gridDim.x;
#define TRJOB(SRC, KK, NN, DST, LDK, KOFS, MODE, KS) { const int nk = (KK) / 64, nn = ((NN) + 63) / 64, tot = nk * nn; \
    int first = (bid - base % G + G) % G; \
    for (int t = first; t < tot; t += G) { const int n0_ = (t % nn) * 64; tr_tile((SRC), (NN), (t / nn) * 64, n0_, ((NN) - n0_) < 64 ? ((NN) - n0_) : 64, (DST), (LDK), (KOFS), (MODE), (KS), sm); } \
    base += tot; }
  for (int lj = 0; lj < 4; ++lj) {
    TRJOB(p.ffn_w1 + (size_t)lj * DM * DFF, DM, DFF, p.W13[lj], DM, 0, 1, nullptr);
    TRJOB(p.ffn_w3 + (size_t)lj * DM * DFF, DM, DFF, p.W13[lj], DM, 0, 2, nullptr);
    TRJOB(p.ffn_w2 + (size_t)lj * DFF * DM, DFF, DM, p.W2[lj], DFF, 0, 0, nullptr);
  }
  TRJOB(p.even_w_in, DM, 1952, p.WinE, DM, 0, 3, nullptr);
  TRJOB(p.w_uq, 256, 768, p.Wqkv, 2048, 0, 0, p.q_norm_g);
  TRJOB(p.w_ukv, 128, 1024, p.Wqkv + (size_t)768 * 2048, 2048, 256, 0, p.kv_norm_g);
  TRJOB(p.even_w_out, DM, DM, p.WoutE, DM, 0, 0, nullptr);
  TRJOB(p.odd_w_in, DM, 5120, p.WinO, DM, 0, 3, nullptr);
  TRJOB(p.odd_w_out, DM, DM, p.WoutO, DM, 0, 0, nullptr);
#undef TRJOB
  for (int i = bid * NTHR + tid; i < 96 * 1024; i += G * NTHR) p.WinE[(size_t)1952 * 1024 + i] = 0;
  for (int i = bid * NTHR + tid; i < 768 * 128; i += G * NTHR) p.Wqkv[(size_t)(i >> 7) * 2048 + 256 + (i & 127)] = 0;
  for (int i = bid * NTHR + tid; i < 1024 * 256; i += G * NTHR) p.Wqkv[(size_t)(768 + (i >> 8)) * 2048 + (i & 255)] = 0;
  for (int i = bid * NTHR + tid; i < M_ALL * 2; i += G * NTHR) p.RS[i] = 0.f;
  for (int i = bid * NTHR + tid; i < 8192 * 16; i += G * NTHR) {
    const int t = i >> 4, ax = (i >> 3) & 1, fi = i & 7;
    const float pos = (float)(ax == 0 ? (t >> 6) : (t & 63));
    const float ang = pos * exp2f(-(float)fi * (13.287712379549449f / 8.f));
    p.rope[(size_t)(t * 2 + ax) * 16 + fi] = cosf(ang); p.rope[(size_t)(t * 2 + ax) * 16 + 8 + fi] = sinf(ang);
  }
  {
    float* scond = sm;
    float* red = sm + 5 * 1024;
    for (int i = tid; i < 5 * 1024; i += NTHR) {
      const int mi = i >> 10, k = i & 1023;
      const float cv = mi < 4 ? p.c[mi * 1024 + k] : p.c_ctx[k];
      scond[i] = cv * sigmoidf_(cv);
    }
    __syncthreads();
    const int col = tid & 63, kg = tid >> 6;
    for (int it = G - 1 - bid; it < 2 * 144; it += G) {
      const int l = it / 144, n = (it % 144) * 64 + col;
      const float* w = p.ada_w + (size_t)l * 1024 * 9216 + n;
      float a0 = 0, a1 = 0, a2 = 0, a3 = 0, a4 = 0;
#pragma unroll 16
      for (int k = kg * 128; k < kg * 128 + 128; ++k) {
        const float wv = w[(size_t)k * 9216];
        a0 += scond[k] * wv; a1 += scond[1024 + k] * wv; a2 += scond[2048 + k] * wv; a3 += scond[3072 + k] * wv; a4 += scond[4096 + k] * wv;
      }
      red[(kg * 5 + 0) * 64 + col] = a0; red[(kg * 5 + 1) * 64 + col] = a1; red[(kg * 5 + 2) * 64 + col] = a2;
      red[(kg * 5 + 3) * 64 + col] = a3; red[(kg * 5 + 4) * 64 + col] = a4;
      __syncthreads();
      for (int i = tid; i < 5 * 64; i += NTHR) {
        const int mi = i >> 6, cc = i & 63, nn = (it % 144) * 64 + cc;
        float sacc = 0.f;
#pragma unroll
        for (int q = 0; q < 8; ++q) sacc += red[(q * 5 + mi) * 64 + cc];
        p.mod[((size_t)(l * 5 + mi)) * 9216 + nn] = sacc + p.ada_b[l * 9216 + nn];
      }
      __syncthreads();
    }
  }
}

__device__ __forceinline__ void phase_norm(const Params& p, int l, int j, const float* srcC, const float* srcL, int row0,
                           const float* PART = nullptr, int ksl = 0, float coef = 0.f, const float* pgate = nullptr) {
  constexpr int NR = 2;
  const int wave = threadIdx.x >> 6, lane = threadIdx.x & 63;
  const float* g = p.norm_g + (l * 3 + j) * 1024;
  f32x4 gv[4];
#pragma unroll
  for (int i = 0; i < 4; ++i) gv[i] = *(const f32x4*)(g + (lane + 64 * i) * 4);
  const int stride = gridDim.x * 8;
  for (int rb = row0 + blockIdx.x * 8 + wave; rb < M_ALL; rb += stride * NR) {
    f32x4 v[NR][4], sv[NR][4], hv[NR][4];
#pragma unroll
    for (int q = 0; q < NR; ++q) {
      const int rr = rb + q * stride, r = rr < M_ALL ? rr : M_ALL - 1;
      const float* src = r < NCTX ? srcC + (size_t)r * DM : srcL + (size_t)(r - NCTX) * DM;
      const float* sh = p.mod + ((size_t)(l * 5 + row_mi(r)) * 9 + 3 * j) * 1024;
#pragma unroll
      for (int i = 0; i < 4; ++i) { v[q][i] = ((const f32x4*)src)[lane + 64 * i]; hv[q][i] = ((const f32x4*)sh)[lane + 64 * i]; sv[q][i] = ((const f32x4*)(sh + 1024))[lane + 64 * i]; }
      if (ksl > 0 && r < NCTX) {
#pragma unroll
        for (int i = 0; i < 4; ++i) {
          f32x4 a = {0.f, 0.f, 0.f, 0.f};
          for (int sl = 0; sl < ksl; ++sl) a += ((const f32x4*)(PART + ((size_t)sl * NCTX + r) * DM))[lane + 64 * i];
          v[q][i] += coef * ((const f32x4*)pgate)[lane + 64 * i] * a;
        }
      }
    }
#pragma unroll
    for (int q = 0; q < NR; ++q) {
      const int rr = rb + q * stride, r = rr < M_ALL ? rr : M_ALL - 1;
      const bool live = rr < M_ALL;
      float ss = 0.f;
#pragma unroll
      for (int i = 0; i < 4; ++i) ss += v[q][i][0] * v[q][i][0] + v[q][i][1] * v[q][i][1] + v[q][i][2] * v[q][i][2] + v[q][i][3] * v[q][i][3];
      ss = wave_sum(ss);
      const float rstd = rsqrtf(ss * (1.f / 1024.f) + 1e-6f);
      if (live) {
        if (ksl > 0 && r < NCTX) {
#pragma unroll
          for (int i = 0; i < 4; ++i) ((f32x4*)(p.XC + (size_t)r * DM))[lane + 64 * i] = v[q][i];
        }
#pragma unroll
        for (int i = 0; i < 4; ++i) {
          const f32x4 u = v[q][i] * rstd * gv[i] * (1.f + sv[q][i]) + hv[q][i];
          u32x2 o; o.x = pk2(u[0], u[1]); o.y = pk2(u[2], u[3]);
          *(u32x2*)(p.U + (size_t)r * DM + (lane + 64 * i) * 4) = o;
        }
      }
    }
  }
}

__device__ __forceinline__ void phase_final_norm(const Params& p) {
  constexpr int NR = 4;
  const int wave = threadIdx.x >> 6, lane = threadIdx.x & 63;
  f32x4 gv[4];
#pragma unroll
  for (int i = 0; i < 4; ++i) gv[i] = *(const f32x4*)(p.final_norm_g + (lane + 64 * i) * 4);
  const int stride = gridDim.x * 8;
  for (int rb = blockIdx.x * 8 + wave; rb < 32768; rb += stride * NR) {
    f32x4 v[NR][4];
#pragma unroll
    for (int q = 0; q < NR; ++q) {
      const int rr = rb + q * stride, r = rr < 32768 ? rr : 32767;
#pragma unroll
      for (int i = 0; i < 4; ++i) v[q][i] = ((const f32x4*)(p.out + (size_t)r * DM))[lane + 64 * i];
    }
#pragma unroll
    for (int q = 0; q < NR; ++q) {
      const int rr = rb + q * stride, r = rr < 32768 ? rr : 32767;
      const bool live = rr < 32768;
      float ss = 0.f;
#pragma unroll
      for (int i = 0; i < 4; ++i) ss += v[q][i][0] * v[q][i][0] + v[q][i][1] * v[q][i][1] + v[q][i][2] * v[q][i][2] + v[q][i][3] * v[q][i][3];
      ss = wave_sum(ss);
      const float rstd = rsqrtf(ss * (1.f / 1024.f) + 1e-6f);
#pragma unroll
      for (int i = 0; i < 4; ++i) {
        const int c = (lane + 64 * i) * 4;
        if (live) ((f32x4*)(p.out + (size_t)r * DM))[lane + 64 * i] = v[q][i] * rstd * gv[i];
      }
    }
  }
}

__device__ void phase_even_elem(const Params& p, const bf16_t* P, bf16_t* CAT, bf16_t* Kall) {
  const int wave = threadIdx.x >> 6, lane = threadIdx.x & 63;
  for (int r = blockIdx.x * 8 + wave; r < M_ALL; r += gridDim.x * 8) {
    int b, key; row_bk(r, b, key);
    const bool latent = r >= NCTX;
    const int t = latent ? ((r - NCTX) & 8191) : (r & 255), T = latent ? 8192 : 256;
    const int c0 = lane * 8;
    float cv[3][8];
#pragma unroll
    for (int dt = 0; dt < 3; ++dt) {
      const int tt = t + dt - 1;
      if (tt >= 0 && tt < T) {
        const bf16_t* pr = P + (size_t)(r + dt - 1) * 2048;
        u32x4 gc = *(const u32x4*)(pr + 512 + c0), vv = *(const u32x4*)(pr + 1024 + c0);
#pragma unroll
        for (int e = 0; e < 4; ++e) { cv[dt][2 * e] = lo2f(gc[e]) * lo2f(vv[e]); cv[dt][2 * e + 1] = hi2f(gc[e]) * hi2f(vv[e]); }
      } else {
#pragma unroll
        for (int e = 0; e < 8; ++e) cv[dt][e] = 0.f;
      }
    }
    u32x4 gb = *(const u32x4*)(P + (size_t)r * 2048 + c0);
    float o[8];
#pragma unroll
    for (int e = 0; e < 8; ++e) {
      const float w0 = p.even_conv_w[c0 + e], w1 = p.even_conv_w[512 + c0 + e], w2 = p.even_conv_w[1024 + c0 + e];
      const float g = (e & 1) ? hi2f(gb[e >> 1]) : lo2f(gb[e >> 1]);
      o[e] = g * (cv[0][e] * w0 + cv[1][e] * w1 + cv[2][e] * w2);
    }
    u32x4 ov; ov.x = pk2(o[0], o[1]); ov.y = pk2(o[2], o[3]); ov.z = pk2(o[4], o[5]); ov.w = pk2(o[6], o[7]);
    *(u32x4*)(CAT + (size_t)r * DM + c0) = ov;
    {
      const int d = lane & 31;
      float v = bf2f(P[(size_t)r * 2048 + 1920 + d]);
      const float pv = __shfl_xor(v, 8);
      const int idx = d & 15, fi = idx & 7;
      if (latent) {
        const float* rp = p.rope + ((size_t)t * 2 + (d >> 4)) * 16 + fi;
        const float cs = rp[0], sn = rp[8];
        v = (idx < 8) ? (v * cs - pv * sn) : (pv * sn + v * cs);
      }
      const bf16_t bv = f2bf(v);
      if (lane < 32) {
#pragma unroll
        for (int h = 0; h < 8; ++h) Kall[((size_t)(b * 8 + h) * NKEY + key) * 96 + 64 + d] = bv;
      }
    }
  }
}

__device__ void phase_attn_scalar(const Params& p, const bf16_t* Qall, const bf16_t* Kall, const bf16_t* Vt, bf16_t* CAT) {
  const int ql = threadIdx.x & 255, half = threadIdx.x >> 8;
  for (int it = blockIdx.x; it < 1056; it += gridDim.x) {
    int b, h, q0, nk;
    if (it < 1024) { b = it >> 8; h = (it >> 5) & 7; q0 = 256 + (it & 31) * 256; nk = NKEY; }
    else { const int i2 = it - 1024; b = i2 >> 3; h = i2 & 7; q0 = 0; nk = 256; }
    const int qi = q0 + ql;
    const size_t bh = (size_t)(b * 8 + h);
    float q[96];
    {
      const u32x4* qp = (const u32x4*)(Qall + (bh * NKEY + qi) * 96);
#pragma unroll
      for (int i = 0; i < 12; ++i) { u32x4 v = qp[i];
#pragma unroll
        for (int e = 0; e < 4; ++e) { q[8 * i + 2 * e] = lo2f(v[e]); q[8 * i + 2 * e + 1] = hi2f(v[e]); } }
    }
    float o[32];
#pragma unroll
    for (int i = 0; i < 32; ++i) o[i] = 0.f;
    float mrun = -1e30f, lrun = 0.f;
    for (int k0 = 0; k0 < nk; k0 += 4) {
      float s[4];
#pragma unroll
      for (int kk = 0; kk < 4; ++kk) {
        const u32x4* kp = (const u32x4*)(Kall + (bh * NKEY + k0 + kk) * 96);
        float a = 0.f;
#pragma unroll
        for (int i = 0; i < 12; ++i) { u32x4 v = kp[i];
#pragma unroll
          for (int e = 0; e < 4; ++e) a += q[8 * i + 2 * e] * lo2f(v[e]) + q[8 * i + 2 * e + 1] * hi2f(v[e]); }
        s[kk] = a;
      }
      const float mx = fmaxf(fmaxf(s[0], s[1]), fmaxf(s[2], s[3]));
      const float mnew = fmaxf(mrun, mx);
      const float alpha = exp2f(mrun - mnew);
      const float p0 = exp2f(s[0] - mnew), p1 = exp2f(s[1] - mnew), p2 = exp2f(s[2] - mnew), p3 = exp2f(s[3] - mnew);
      lrun = lrun * alpha + p0 + p1 + p2 + p3;
      mrun = mnew;
#pragma unroll
      for (int dv = 0; dv < 32; ++dv) {
        u32x2 v = *(const u32x2*)(Vt + (bh * 64 + half * 32 + dv) * NKEY + k0);
        o[dv] = o[dv] * alpha + p0 * lo2f(v.x) + p1 * hi2f(v.x) + p2 * lo2f(v.y) + p3 * hi2f(v.y);
      }
    }
    const float il = 1.f / lrun;
    const int r = qi < 256 ? b * 256 + qi : NCTX + b * 8192 + (qi - 256);
    u32x4* op = (u32x4*)(CAT + (size_t)r * DM + 512 + h * 64 + half * 32);
#pragma unroll
    for (int i = 0; i < 4; ++i) {
      u32x4 v; v.x = pk2(o[8 * i] * il, o[8 * i + 1] * il); v.y = pk2(o[8 * i + 2] * il, o[8 * i + 3] * il);
      v.z = pk2(o[8 * i + 4] * il, o[8 * i + 5] * il); v.w = pk2(o[8 * i + 6] * il, o[8 * i + 7] * il);
      op[i] = v;
    }
  }
}

typedef float f32x16 __attribute__((ext_vector_type(16)));
__device__ __forceinline__ float ex2(float x) { return __builtin_amdgcn_exp2f(x); }
__device__ void phase_attn(const Params& p, const bf16_t* Qall, const bf16_t* Kall, const bf16_t* Vt, bf16_t* CAT, LAS unsigned char* lds) {
  const int tid = threadIdx.x, w = __builtin_amdgcn_readfirstlane(tid >> 6), lane = tid & 63, r = lane & 31, hh = lane >> 5;
  constexpr int KROW = 104, VROW = 72;
  constexpr int KBYTES = 64 * KROW * 2, VBYTES = 64 * VROW * 2, BUF = KBYTES + VBYTES;
  unsigned soff[3];
#pragma unroll
  for (int j = 0; j < 3; ++j) {
    const int ci = (3 * w + j) * 64 + lane;
    if (3 * w + j < 13) { const int row = ci / 13, part = ci % 13; soff[j] = (unsigned)(row * 96 + (part < 12 ? part : 0) * 8) * 2u; }
    else { const int c2 = ci - 832, dv = c2 / 9, part = c2 % 9; soff[j] = (unsigned)((dv < 64 ? dv : 0) * NKEY + (part < 8 ? part : 0) * 8) * 2u; }
  }
#define ATT_STAGE(bufi, k0_) do { _Pragma("unroll") for (int j_ = 0; j_ < 3; ++j_) if (j_ == 0 || w < 7) { \
    const char* g_ = (3 * w + j_ < 13) ? (const char*)kbase + soff[j_] + (size_t)(k0_) * 192 : (const char*)vbase + soff[j_] + (size_t)(k0_) * 2; \
    __builtin_amdgcn_global_load_lds((const unsigned*)g_, (LAS unsigned*)(lds + (bufi) * BUF + (3 * w + j_) * 1024), 16, 0, 0); } } while (0)
  for (int it = blockIdx.x; it < 544; it += gridDim.x) {
    int b, h, q0, nk, nq;
    if (it < 512) { b = it >> 7; h = (it >> 4) & 7; q0 = 256 + (it & 15) * 512; nk = NKEY; nq = 512; }
    else { const int i2 = it - 512; b = i2 >> 3; h = i2 & 7; q0 = 0; nk = 256; nq = 256; }
    const size_t bh = (size_t)(b * 8 + h);
    const int qw = 64 * w;
    const bool wact = qw < nq;
    const int qbase = q0 + (wact ? qw : 0) + r;
    bf16x8 qf[2][6];
#pragma unroll
    for (int qb = 0; qb < 2; ++qb) {
      const bf16_t* qp = Qall + (bh * NKEY + qbase + 32 * qb) * 96 + 8 * hh;
#pragma unroll
      for (int c = 0; c < 6; ++c) qf[qb][c] = *(const bf16x8*)(qp + 16 * c);
    }
    f32x16 o[2][2];
#pragma unroll
    for (int qb = 0; qb < 2; ++qb)
#pragma unroll
      for (int i = 0; i < 16; ++i) { o[qb][0][i] = 0.f; o[qb][1][i] = 0.f; }
    float mrun[2] = {0.f, 0.f}, lrun[2] = {0.f, 0.f};
    const bf16_t* kbase = Kall + bh * NKEY * 96;
    const bf16_t* vbase = Vt + bh * 64 * NKEY;
    ATT_STAGE(0, 0);
    asm volatile("s_waitcnt vmcnt(0)" ::: "memory");
    __syncthreads();
    const int ntile = nk >> 6;
    for (int i = 0; i < ntile; ++i) {
      const bool more = (i + 1 < ntile);
      if (more) ATT_STAGE((i + 1) & 1, (i + 1) * 64);
      LAS unsigned char* kb_ = lds + (i & 1) * BUF;
      LAS unsigned char* vb_ = kb_ + KBYTES;
      f32x16 s[2][2];
#pragma unroll
      for (int qb = 0; qb < 2; ++qb)
#pragma unroll
        for (int e = 0; e < 16; ++e) { s[qb][0][e] = 0.f; s[qb][1][e] = 0.f; }
#pragma unroll
      for (int c = 0; c < 6; ++c) {
        const bf16x8 ka = *(const LAS bf16x8*)(kb_ + (r * KROW + 16 * c + 8 * hh) * 2);
        const bf16x8 kb2 = *(const LAS bf16x8*)(kb_ + ((32 + r) * KROW + 16 * c + 8 * hh) * 2);
#pragma unroll
        for (int qb = 0; qb < 2; ++qb) {
          s[qb][0] = __builtin_amdgcn_mfma_f32_32x32x16_bf16(ka, qf[qb][c], s[qb][0], 0, 0, 0);
          s[qb][1] = __builtin_amdgcn_mfma_f32_32x32x16_bf16(kb2, qf[qb][c], s[qb][1], 0, 0, 0);
        }
      }
#pragma unroll
      for (int qb = 0; qb < 2; ++qb) {
        float mx = fmaxf(s[qb][0][0], s[qb][1][0]);
#pragma unroll
        for (int e = 1; e < 16; ++e) mx = fmaxf(mx, fmaxf(s[qb][0][e], s[qb][1][e]));
        mx = fmaxf(mx, __shfl_xor(mx, 32));
        const bool need = (i == 0) || (mx - mrun[qb] > 8.f);
        if (__builtin_amdgcn_ballot_w64(need) != 0ull) {
          const float nm = need ? mx : mrun[qb];
          const float alpha = (i == 0) ? 1.f : ex2(mrun[qb] - nm);
          mrun[qb] = nm; lrun[qb] *= alpha;
#pragma unroll
          for (int e = 0; e < 16; ++e) { o[qb][0][e] *= alpha; o[qb][1][e] *= alpha; }
        }
        f32x2 ps2 = {0.f, 0.f};
        const f32x2 m2 = {mrun[qb], mrun[qb]};
#pragma unroll
        for (int kb = 0; kb < 2; ++kb)
#pragma unroll
          for (int e = 0; e < 16; e += 2) {
            f32x2 t = {s[qb][kb][e], s[qb][kb][e + 1]};
            t = t - m2;
            t.x = ex2(t.x); t.y = ex2(t.y);
            ps2 += t;
            s[qb][kb][e] = t.x; s[qb][kb][e + 1] = t.y;
          }
        lrun[qb] += ps2.x + ps2.y;
      }
#pragma unroll
      for (int kb = 0; kb < 2; ++kb)
#pragma unroll
        for (int t = 0; t < 2; ++t) {
          const int kofs = 32 * kb + 16 * t + 4 * hh;
          u32x4 va, vb2;
          { const u32x2 lo = *(const LAS u32x2*)(vb_ + (r * VROW + kofs) * 2), hi = *(const LAS u32x2*)(vb_ + (r * VROW + kofs + 8) * 2); va.x = lo.x; va.y = lo.y; va.z = hi.x; va.w = hi.y; }
          { const u32x2 lo = *(const LAS u32x2*)(vb_ + ((32 + r) * VROW + kofs) * 2), hi = *(const LAS u32x2*)(vb_ + ((32 + r) * VROW + kofs + 8) * 2); vb2.x = lo.x; vb2.y = lo.y; vb2.z = hi.x; vb2.w = hi.y; }
#pragma unroll
          for (int qb = 0; qb < 2; ++qb) {
            u32x4 pw;
            pw.x = pk2(s[qb][kb][8 * t], s[qb][kb][8 * t + 1]); pw.y = pk2(s[qb][kb][8 * t + 2], s[qb][kb][8 * t + 3]);
            pw.z = pk2(s[qb][kb][8 * t + 4], s[qb][kb][8 * t + 5]); pw.w = pk2(s[qb][kb][8 * t + 6], s[qb][kb][8 * t + 7]);
            const bf16x8 pf = __builtin_bit_cast(bf16x8, pw);
            o[qb][0] = __builtin_amdgcn_mfma_f32_32x32x16_bf16(__builtin_bit_cast(bf16x8, va), pf, o[qb][0], 0, 0, 0);
            o[qb][1] = __builtin_amdgcn_mfma_f32_32x32x16_bf16(__builtin_bit_cast(bf16x8, vb2), pf, o[qb][1], 0, 0, 0);
          }
        }
      asm volatile("s_waitcnt vmcnt(0)" ::: "memory");
      __syncthreads();
    }
    if (wact) {
#pragma unroll
      for (int qb = 0; qb < 2; ++qb) {
        float l = lrun[qb]; l += __shfl_xor(l, 32);
        const float il = 1.f / l;
        const int qi = qbase + 32 * qb;
        const int row = qi < 256 ? b * 256 + qi : NCTX + b * 8192 + (qi - 256);
        bf16_t* op = CAT + (size_t)row * DM + 512 + h * 64 + 4 * hh;
#pragma unroll
        for (int g = 0; g < 4; ++g) {
          u32x2 a; a.x = pk2(o[qb][0][4 * g] * il, o[qb][0][4 * g + 1] * il); a.y = pk2(o[qb][0][4 * g + 2] * il, o[qb][0][4 * g + 3] * il);
          *(u32x2*)(op + 8 * g) = a;
          u32x2 c; c.x = pk2(o[qb][1][4 * g] * il, o[qb][1][4 * g + 1] * il); c.y = pk2(o[qb][1][4 * g + 2] * il, o[qb][1][4 * g + 3] * il);
          *(u32x2*)(op + 32 + 8 * g) = c;
        }
      }
    }
  }
}
#undef ATT_STAGE

__device__ void phase_hgrn_scalar(const Params& p, int dir, const bf16_t* Qh, const bf16_t* Vv, const bf16_t* Gg, const _Float16* Lx, bf16_t* O, float* sm) {
  float* sf = sm; float* sk = sm + 128; float* sq = sm + 256; float* part = sm + 384;   float* red = sm + 896;
  const int tid = threadIdx.x, dv = tid & 127, kg = tid >> 7;
  for (int it = blockIdx.x; it < 32; it += gridDim.x) {
    const int b = it >> 3, h = it & 7;
    float S[32];
#pragma unroll
    for (int i = 0; i < 32; ++i) S[i] = 0.f;
    for (int n = 0; n < NKEY; ++n) {
      int r; bool latent = n >= 256;
      if (!latent) r = b * 256 + (dir == 0 ? n : 255 - n);
      else r = NCTX + b * 8192 + (dir == 0 ? (n - 256) : (8191 - (n - 256)));
      const size_t off = (size_t)r * DM + h * 128;
      if (tid < 128) {
        const float f = __expf((float)Lx[off + tid]);
        sf[tid] = f; sk[tid] = 1.f - f; sq[tid] = bf2f(Qh[off + tid]);
      }
      __syncthreads();
      const float v = bf2f(Vv[off + dv]);
      float po = 0.f;
#pragma unroll
      for (int i = 0; i < 32; ++i) { const int dk = kg * 32 + i; S[i] = sf[dk] * S[i] + sk[dk] * v; po += S[i] * sq[dk]; }
      if (latent) {
        part[kg * 128 + dv] = po;
        __syncthreads();
        if (tid < 128) {
          float o = part[tid] + part[128 + tid] + part[256 + tid] + part[384 + tid];
          if (dir == 0) O[off + tid] = f2bf(o);
          else {
            o += bf2f(O[off + tid]);
            float ss = wave_sum(o * o);
            if ((tid & 63) == 0) red[tid >> 6] = ss;
            part[tid] = o;
          }
        }
        __syncthreads();
        if (dir == 1 && tid < 128) {
          const float o = part[tid];
          const float rstd = rsqrtf((red[0] + red[1]) * (1.f / 128.f) + 1e-6f);
          const float g = bf2f(Gg[off + tid]);
          O[off + tid] = f2bf(o * rstd * p.g_norm_g[tid] * g * sigmoidf_(g));
        }
      }
      __syncthreads();
    }
  }
}

template <bool OUT>
__device__ void phase_hgrn(const Params& p, const bf16_t* Qh, const bf16_t* Vv, const _Float16* Lfb, bf16_t* Of, bf16_t* Ob, float* Sseg, float* Dlog, LAS unsigned char* lds) {
  constexpr int NSEG = 4, CPS = 33, NIT = OUT ? 64 * NSEG : 64 * (NSEG - 1);
  constexpr int QT = 0, KT = QT + 64 * 136 * 2, KE = KT + 64 * 136 * 2, VT = KE + 128 * 72 * 2, AT = VT + 128 * 72 * 2,
                ST = AT + 64 * 72 * 2, DC = ST + 128 * 136 * 2, TOT = DC + 512;
  const int tid = threadIdx.x, w = tid >> 6, lane = tid & 63, r = lane & 31, hh = lane >> 5;
  const int dk = tid & 127, tq = tid >> 7;
  const int dvb = w & 3, wh = w >> 2;
  for (int it = blockIdx.x; it < NIT; it += gridDim.x) {
    const int bhd = OUT ? it >> 2 : it / 3, sg = OUT ? it & 3 : it % 3;
    const int b = bhd >> 4, h = (bhd >> 1) & 7, dir = bhd & 1;
    const int c_begin = sg * CPS, c_end = c_begin + CPS;
    const _Float16* Lx = Lfb + (size_t)dir * ((size_t)M_ALL * DM);
    const int sgn = dir ? -1 : 1;
    f32x16 S0, S1;
#pragma unroll
    for (int e = 0; e < 16; ++e) { S0[e] = 0.f; S1[e] = 0.f; }
    if constexpr (OUT) {
      for (int sp = 0; sp < sg; ++sp) {
        const float* sp_ = Sseg + ((size_t)(bhd * 3 + sp) * 8 + w) * 2048;
        const float* dl = Dlog + (size_t)(bhd * 3 + sp) * 128;
#pragma unroll
        for (int g = 0; g < 4; ++g) {
          const f32x4 d0 = *(const f32x4*)(dl + 32 * (2 * wh) + 8 * g + 4 * hh), d1 = *(const f32x4*)(dl + 32 * (2 * wh + 1) + 8 * g + 4 * hh);
#pragma unroll
          for (int j = 0; j < 4; ++j) {
            S0[4 * g + j] = S0[4 * g + j] * __expf(d0[j]) + sp_[(4 * g + j) * 64 + lane];
            S1[4 * g + j] = S1[4 * g + j] * __expf(d1[j]) + sp_[1024 + (4 * g + j) * 64 + lane];
          }
        }
      }
#pragma unroll
      for (int g = 0; g < 4; ++g) {
        u32x2 a0; a0.x = pk2(S0[4 * g], S0[4 * g + 1]); a0.y = pk2(S0[4 * g + 2], S0[4 * g + 3]);
        *(LAS u32x2*)(lds + ST + ((32 * dvb + r) * 136 + 32 * (2 * wh) + 8 * g + 4 * hh) * 2) = a0;
        u32x2 a1; a1.x = pk2(S1[4 * g], S1[4 * g + 1]); a1.y = pk2(S1[4 * g + 2], S1[4 * g + 3]);
        *(LAS u32x2*)(lds + ST + ((32 * dvb + r) * 136 + 32 * (2 * wh + 1) + 8 * g + 4 * hh) * 2) = a1;
      }
    }
    float dsum = 0.f;
    _Float16 lfr[16]; bf16_t qr[16], vr[16];
    {
      const int cn = c_begin;
      const int rb0 = (cn < 4) ? b * 256 + (dir ? 255 - 64 * cn : 64 * cn) : NCTX + b * 8192 + (dir ? 8191 - 64 * (cn - 4) : 64 * (cn - 4));
      const size_t o0 = (size_t)(rb0 + sgn * 16 * tq) * DM + h * 128 + dk;
#pragma unroll
      for (int i = 0; i < 16; ++i) { const size_t o = o0 + (ptrdiff_t)(sgn * i) * DM; lfr[i] = Lx[o]; if constexpr (OUT) qr[i] = Qh[o]; else qr[i] = 0; vr[i] = Vv[o]; }
    }
    __syncthreads();
    for (int c = c_begin; c < c_end; ++c) {
      const int rbase = (c < 4) ? b * 256 + (dir ? 255 - 64 * c : 64 * c) : NCTX + b * 8192 + (dir ? 8191 - 64 * (c - 4) : 64 * (c - 4));
      float lf[16], cs[16];
      float run = 0.f;
#pragma unroll
      for (int i = 0; i < 16; ++i) { lf[i] = (float)lfr[i]; run += lf[i]; cs[i] = run; }
      *(LAS float*)(lds + TOT + (tq * 128 + dk) * 4) = run;
      __syncthreads();
      float offs = 0.f, blast = 0.f;
#pragma unroll
      for (int g = 0; g < 4; ++g) { const float t = *(const LAS float*)(lds + TOT + (g * 128 + dk) * 4); blast += t; if (g < tq) offs += t; }
      {
        unsigned kew[8], vw[8];
#pragma unroll
        for (int i = 0; i < 16; i += 2) {
          float qt[2], kt[2], ke[2];
#pragma unroll
          for (int e = 0; e < 2; ++e) {
            const float bb = offs + cs[i + e];
            const float k = 1.f - __expf(lf[i + e]);
            if constexpr (OUT) { qt[e] = bf2f(qr[i + e]) * __expf(bb); kt[e] = k * __expf(-bb); }
            ke[e] = k * __expf(blast - bb);
          }
          if constexpr (OUT) {
            const unsigned qp = pk2(qt[0], qt[1]), kp = pk2(kt[0], kt[1]);
            const int s = 16 * tq + i;
            *(LAS bf16_t*)(lds + QT + (s * 136 + dk) * 2) = (bf16_t)(qp & 0xffffu);
            *(LAS bf16_t*)(lds + QT + ((s + 1) * 136 + dk) * 2) = (bf16_t)(qp >> 16);
            *(LAS bf16_t*)(lds + KT + (s * 136 + dk) * 2) = (bf16_t)(kp & 0xffffu);
            *(LAS bf16_t*)(lds + KT + ((s + 1) * 136 + dk) * 2) = (bf16_t)(kp >> 16);
          }
          kew[i >> 1] = pk2(ke[0], ke[1]);
          vw[i >> 1] = (unsigned)vr[i] | ((unsigned)vr[i + 1] << 16);
        }
        *(LAS u32x4*)(lds + KE + (dk * 72 + 16 * tq) * 2) = (u32x4){kew[0], kew[1], kew[2], kew[3]};
        *(LAS u32x4*)(lds + KE + (dk * 72 + 16 * tq + 8) * 2) = (u32x4){kew[4], kew[5], kew[6], kew[7]};
        *(LAS u32x4*)(lds + VT + (dk * 72 + 16 * tq) * 2) = (u32x4){vw[0], vw[1], vw[2], vw[3]};
        *(LAS u32x4*)(lds + VT + (dk * 72 + 16 * tq + 8) * 2) = (u32x4){vw[4], vw[5], vw[6], vw[7]};
        if (tq == 0) *(LAS float*)(lds + DC + dk * 4) = __expf(blast);
        dsum += blast;
      }
      __syncthreads();
      if (c + 1 < c_end) {
        const int cn = c + 1;
        const int rb = (cn < 4) ? b * 256 + (dir ? 255 - 64 * cn : 64 * cn) : NCTX + b * 8192 + (dir ? 8191 - 64 * (cn - 4) : 64 * (cn - 4));
        const size_t o0 = (size_t)(rb + sgn * 16 * tq) * DM + h * 128 + dk;
#pragma unroll
        for (int i = 0; i < 16; ++i) { const size_t o = o0 + (ptrdiff_t)(sgn * i) * DM; lfr[i] = Lx[o]; if constexpr (OUT) qr[i] = Qh[o]; else qr[i] = 0; vr[i] = Vv[o]; }
      }
      if (OUT && w < 3) {
        const int sb = (w == 2) ? 1 : 0, tb = (w == 0) ? 0 : 1;
        f32x16 a;
#pragma unroll
        for (int e = 0; e < 16; ++e) a[e] = 0.f;
#pragma unroll
        for (int ks = 0; ks < 8; ++ks) {
          const bf16x8 ka = *(const LAS bf16x8*)(lds + KT + ((32 * sb + r) * 136 + 16 * ks + 8 * hh) * 2);
          const bf16x8 qb = *(const LAS bf16x8*)(lds + QT + ((32 * tb + r) * 136 + 16 * ks + 8 * hh) * 2);
          a = __builtin_amdgcn_mfma_f32_32x32x16_bf16(ka, qb, a, 0, 0, 0);
        }
        const int tok = 32 * tb + r;
#pragma unroll
        for (int g = 0; g < 4; ++g) {
          const int s0 = 32 * sb + 8 * g + 4 * hh;
          const float v0 = (s0 + 0 <= tok) ? a[4 * g + 0] : 0.f, v1 = (s0 + 1 <= tok) ? a[4 * g + 1] : 0.f;
          const float v2 = (s0 + 2 <= tok) ? a[4 * g + 2] : 0.f, v3 = (s0 + 3 <= tok) ? a[4 * g + 3] : 0.f;
          u32x2 o; o.x = pk2(v0, v1); o.y = pk2(v2, v3);
          *(LAS u32x2*)(lds + AT + (tok * 72 + s0) * 2) = o;
        }
      }
      {
#pragma unroll
        for (int g = 0; g < 4; ++g) {
          const f32x4 d0 = *(const LAS f32x4*)(lds + DC + (32 * (2 * wh) + 8 * g + 4 * hh) * 4);
          const f32x4 d1 = *(const LAS f32x4*)(lds + DC + (32 * (2 * wh + 1) + 8 * g + 4 * hh) * 4);
#pragma unroll
          for (int j = 0; j < 4; ++j) { S0[4 * g + j] *= d0[j]; S1[4 * g + j] *= d1[j]; }
        }
#pragma unroll
        for (int ks = 0; ks < 4; ++ks) {
          const bf16x8 vb = *(const LAS bf16x8*)(lds + VT + ((32 * dvb + r) * 72 + 16 * ks + 8 * hh) * 2);
          const bf16x8 k0 = *(const LAS bf16x8*)(lds + KE + ((32 * (2 * wh) + r) * 72 + 16 * ks + 8 * hh) * 2);
          const bf16x8 k1 = *(const LAS bf16x8*)(lds + KE + ((32 * (2 * wh + 1) + r) * 72 + 16 * ks + 8 * hh) * 2);
          S0 = __builtin_amdgcn_mfma_f32_32x32x16_bf16(k0, vb, S0, 0, 0, 0);
          S1 = __builtin_amdgcn_mfma_f32_32x32x16_bf16(k1, vb, S1, 0, 0, 0);
        }
      }
      if constexpr (OUT) {
      __syncthreads();
      {
        const int tb = wh;
        f32x16 o;
#pragma unroll
        for (int e = 0; e < 16; ++e) o[e] = 0.f;
#pragma unroll
        for (int ks = 0; ks < 4; ++ks) {
          if (ks < 2 * (tb + 1)) {
            const bf16x8 va = *(const LAS bf16x8*)(lds + VT + ((32 * dvb + r) * 72 + 16 * ks + 8 * hh) * 2);
            const bf16x8 ab = *(const LAS bf16x8*)(lds + AT + ((32 * tb + r) * 72 + 16 * ks + 8 * hh) * 2);
            o = __builtin_amdgcn_mfma_f32_32x32x16_bf16(va, ab, o, 0, 0, 0);
          }
        }
#pragma unroll
        for (int ks = 0; ks < 8; ++ks) {
          const bf16x8 sa = *(const LAS bf16x8*)(lds + ST + ((32 * dvb + r) * 136 + 16 * ks + 8 * hh) * 2);
          const bf16x8 qb = *(const LAS bf16x8*)(lds + QT + ((32 * tb + r) * 136 + 16 * ks + 8 * hh) * 2);
          o = __builtin_amdgcn_mfma_f32_32x32x16_bf16(sa, qb, o, 0, 0, 0);
        }
        if (c >= 4) {
          const int row = rbase + sgn * (32 * tb + r);
          bf16_t* op = (dir ? Ob + (size_t)(row - NCTX) * DM : Of + (size_t)row * DM) + h * 128 + 32 * dvb + 4 * hh;
#pragma unroll
          for (int g = 0; g < 4; ++g) {
            u32x2 ov; ov.x = pk2(o[4 * g], o[4 * g + 1]); ov.y = pk2(o[4 * g + 2], o[4 * g + 3]);
            *(u32x2*)(op + 8 * g) = ov;
          }
        }
      }
      __syncthreads();
#pragma unroll
      for (int g = 0; g < 4; ++g) {
        u32x2 a0; a0.x = pk2(S0[4 * g], S0[4 * g + 1]); a0.y = pk2(S0[4 * g + 2], S0[4 * g + 3]);
        *(LAS u32x2*)(lds + ST + ((32 * dvb + r) * 136 + 32 * (2 * wh) + 8 * g + 4 * hh) * 2) = a0;
        u32x2 a1; a1.x = pk2(S1[4 * g], S1[4 * g + 1]); a1.y = pk2(S1[4 * g + 2], S1[4 * g + 3]);
        *(LAS u32x2*)(lds + ST + ((32 * dvb + r) * 136 + 32 * (2 * wh + 1) + 8 * g + 4 * hh) * 2) = a1;
      }
      }
    }
    if constexpr (!OUT) {
      float* sp_ = Sseg + ((size_t)(bhd * 3 + sg) * 8 + w) * 2048;
#pragma unroll
      for (int e = 0; e < 16; ++e) { sp_[e * 64 + lane] = S0[e]; sp_[1024 + e * 64 + lane] = S1[e]; }
      if (tq == 0) Dlog[(size_t)(bhd * 3 + sg) * 128 + dk] = dsum;
    }
    __syncthreads();
  }
}

__device__ void phase_hgrn_readout(const Params& p, bf16_t* Of, const bf16_t* Ob, const bf16_t* Gg) {
  const int wave = threadIdx.x >> 6, lane = threadIdx.x & 63;
  for (int r = NCTX + blockIdx.x * 8 + wave; r < M_ALL; r += gridDim.x * 8) {
    const int c0 = lane * 16;
    float o[16];
#pragma unroll
    for (int i = 0; i < 2; ++i) {
      const u32x4 a = *(const u32x4*)(Of + (size_t)r * DM + c0 + 8 * i), bq = *(const u32x4*)(Ob + (size_t)(r - NCTX) * DM + c0 + 8 * i);
#pragma unroll
      for (int e = 0; e < 4; ++e) { o[8 * i + 2 * e] = lo2f(a[e]) + lo2f(bq[e]); o[8 * i + 2 * e + 1] = hi2f(a[e]) + hi2f(bq[e]); }
    }
    float ss = 0.f;
#pragma unroll
    for (int i = 0; i < 16; ++i) ss += o[i] * o[i];
    ss += __shfl_xor(ss, 1); ss += __shfl_xor(ss, 2); ss += __shfl_xor(ss, 4);
    const float rstd = rsqrtf(ss * (1.f / 128.f) + 1e-6f);
    const int cg = c0 & 127;
#pragma unroll
    for (int i = 0; i < 2; ++i) {
      const u32x4 gq = *(const u32x4*)(Gg + (size_t)r * DM + c0 + 8 * i);
      float y[8];
#pragma unroll
      for (int e = 0; e < 8; ++e) {
        const float g = (e & 1) ? hi2f(gq[e >> 1]) : lo2f(gq[e >> 1]);
        y[e] = o[8 * i + e] * rstd * p.g_norm_g[cg + 8 * i + e] * g * sigmoidf_(g);
      }
      u32x4 ov; ov.x = pk2(y[0], y[1]); ov.y = pk2(y[2], y[3]); ov.z = pk2(y[4], y[5]); ov.w = pk2(y[6], y[7]);
      *(u32x4*)(Of + (size_t)r * DM + c0 + 8 * i) = ov;
    }
  }
}

#define XB_TMO      128
#define XB_XCNT(j)  (256  + 64 * (j))
#define XB_XSUB(j)  (1280 + 64 * (j))
#define XB_XGEN(j)  (2304 + 64 * (j))
#define XB_TOP      3328
#define XB_TOPGEN   3392
#define XCD_BAR_WORDS 3456
#define XB_SPIN_CAP (1u << 22)
__device__ __forceinline__ unsigned xb_ld(unsigned* p)              { return __hip_atomic_load(p, __ATOMIC_RELAXED, __HIP_MEMORY_SCOPE_AGENT); }
__device__ __forceinline__ unsigned xb_add(unsigned* p, unsigned v) { return __hip_atomic_fetch_add(p, v, __ATOMIC_RELAXED, __HIP_MEMORY_SCOPE_AGENT); }
__device__ __forceinline__ unsigned xb_xcc_id() { return (unsigned)__builtin_amdgcn_s_getreg((3 << 11) | 20) & 0xFu; }
#define XB_SPIN(cond, bar) do { unsigned _sp = 0; while (cond) { __builtin_amdgcn_s_sleep(1); \
    if ((++_sp & 255u) == 0u) { if (xb_ld(&(bar)[XB_TMO])) break; if (_sp > XB_SPIN_CAP) { atomicAdd(&(bar)[XB_TMO], 1u); break; } } } } while (0)
__device__ __forceinline__ void xcd_barrier_complete(unsigned* bar, unsigned x, unsigned& nloc, unsigned& nx) {
  const unsigned G = gridDim.x * gridDim.y * gridDim.z;
  unsigned sum, cnt, mine, sp = 0u;
  for (;;) {
    sum = 0u; cnt = 0u; mine = 0u;
#pragma unroll
    for (unsigned j = 0; j < 16; ++j) { const unsigned c = xb_ld(&bar[XB_XCNT(j)]); sum += c; cnt += (c > 0u) ? 1u : 0u; mine = (j == x) ? c : mine; }
    if (sum == G) break;
    __builtin_amdgcn_s_sleep(1);
    if ((++sp & 255u) == 0u) { if (xb_ld(&bar[XB_TMO])) break; if (sp > XB_SPIN_CAP) { atomicAdd(&bar[XB_TMO], 1u); break; } }
  }
  nloc = mine > 0u ? mine : 1u; nx = cnt > 0u ? cnt : 1u;
}
__device__ __forceinline__ void xcd_barrier(unsigned* bar, volatile LAS unsigned* st) {
  asm volatile("s_waitcnt vmcnt(0)" ::: "memory");
  __syncthreads();
  if (threadIdx.x == 0) {
    const unsigned x = xb_xcc_id();
    __builtin_amdgcn_s_waitcnt(0);
    unsigned nloc = st[0], nx = st[1];
    if (nloc == 0u) { xcd_barrier_complete(bar, x, nloc, nx); st[0] = nloc; st[1] = nx; }
    const unsigned old = xb_add(&bar[XB_XSUB(x)], 1u);
    const unsigned gen = old / nloc;
    if (old + 1u == (gen + 1u) * nloc) {
      __builtin_amdgcn_fence(__ATOMIC_RELEASE, "agent");
      asm volatile("s_waitcnt vmcnt(0)" ::: "memory");
      const unsigned og = xb_add(&bar[XB_TOP], 1u);
      const unsigned tg = og / nx;
      if (og + 1u == (tg + 1u) * nx) xb_add(&bar[XB_TOPGEN], 1u);
      else XB_SPIN(xb_ld(&bar[XB_TOPGEN]) == tg, bar);
      __builtin_amdgcn_fence(__ATOMIC_ACQUIRE, "agent");
      xb_add(&bar[XB_XGEN(x)], 1u);
      asm volatile("s_waitcnt vmcnt(0)" ::: "memory");
    } else {
      XB_SPIN(xb_ld(&bar[XB_XGEN(x)]) == gen, bar);
      __builtin_amdgcn_fence(__ATOMIC_ACQUIRE, "agent");
      asm volatile("s_waitcnt vmcnt(0)" ::: "memory");
    }
  }
  __syncthreads();
}


template <int PH>
__device__ __forceinline__ void run_phase(const Params& p, bf16_t* shm_) {
  float* smf = (float*)shm_;
  LAS unsigned char* shm = (LAS unsigned char*)shm_;
  const size_t MR = (size_t)M_ALL;
  bf16_t* G = (bf16_t*)p.R;
  bf16_t* P = (bf16_t*)p.R;
  bf16_t* Qall = P + MR * 2048;
  bf16_t* Kall = Qall + (size_t)32 * NKEY * 96;
  bf16_t* Vt = Kall + (size_t)32 * NKEY * 96;
  bf16_t* Qh = (bf16_t*)p.R;
  bf16_t* Vv = Qh + MR * DM;
  bf16_t* Gg = Vv + MR * DM;
  _Float16* Lf = (_Float16*)(Gg + MR * DM);
  _Float16* Lb = Lf + MR * DM;
  const size_t MODL = (size_t)5 * 9216;
  float* PARTF = (float*)(G + MR * DFF);
  float* PARTE = (float*)(Vt + (size_t)32 * 64 * NKEY);
  const float* CG = p.mod + (size_t)4 * 9 * 1024;
  if constexpr (PH == 0) phase_prep(p, smf);
  if constexpr (PH == 1) phase_norm(p, 0, 0, p.ctx, p.x, 0);
  if constexpr (PH == 2) gemm_phase(p.U, DM, p.W13[0], DM, DM, 0, 132, 0, 22, EpiSwiglu{G}, shm);
  if constexpr (PH == 3) gemm_phase(G, DFF, p.W2[0], DFF, DFF, 4, 128, 0, 4, EpiResid{p.ctx, p.x, p.XC, p.out, p.mod + 2 * 1024, 0.5f}, shm, 4, 11, EpiPart{PARTF});
  if constexpr (PH == 4) phase_norm(p, 0, 1, p.ctx, p.out, 0, PARTF, 11, 0.5f, CG + 2 * 1024);
  if constexpr (PH == 5) gemm_phase(p.U, DM, p.WinE, DM, DM, 0, 132, 0, 8, EpiP{P, p.RS}, shm);
  if constexpr (PH == 6) { gemm_phase(P + 1536, 2048, p.Wqkv, 2048, 384, 0, 132, 0, 7, EpiQKV{EpiQ{p.RS, p.rope, Qall}, EpiKV{p.RS, Kall, Vt}}, shm);
                           phase_even_elem(p, P, p.U, Kall); }
  if constexpr (PH == 7) phase_attn(p, Qall, Kall, Vt, p.U, shm);
  if constexpr (PH == 8) gemm_phase(p.U, DM, p.WoutE, DM, DM, 4, 128, 0, 4, EpiResid{p.XC, p.out, p.XC, p.out, p.mod + 5 * 1024, 1.0f}, shm, 4, 4, EpiPart{PARTE});
  if constexpr (PH == 9) phase_norm(p, 0, 2, p.XC, p.out, 0, PARTE, 4, 1.0f, CG + 5 * 1024);
  if constexpr (PH == 10) gemm_phase(p.U, DM, p.W13[1], DM, DM, 0, 132, 0, 22, EpiSwiglu{G}, shm);
  if constexpr (PH == 11) gemm_phase(G, DFF, p.W2[1], DFF, DFF, 4, 128, 0, 4, EpiResid{p.XC, p.out, p.XC, p.out, p.mod + 8 * 1024, 0.5f}, shm, 4, 11, EpiPart{PARTF});
  if constexpr (PH == 12) phase_norm(p, 1, 0, p.XC, p.out, 0, PARTF, 11, 0.5f, CG + 8 * 1024);
  if constexpr (PH == 13) gemm_phase(p.U, DM, p.W13[2], DM, DM, 0, 132, 0, 22, EpiSwiglu{G}, shm);
  if constexpr (PH == 14) gemm_phase(G, DFF, p.W2[2], DFF, DFF, 4, 128, 0, 4, EpiResid{p.XC, p.out, p.XC, p.out, p.mod + MODL + 2 * 1024, 0.5f}, shm, 4, 11, EpiPart{PARTF});
  if constexpr (PH == 15) phase_norm(p, 1, 1, p.XC, p.out, 0, PARTF, 11, 0.5f, CG + MODL + 2 * 1024);
  if constexpr (PH == 16) gemm_phase(p.U, DM, p.WinO, DM, DM, 0, 132, 0, 20, EpiOdd{Qh, Vv, Gg, Lf, Lb, p.lb_logits}, shm);
  bf16_t* Ob = (bf16_t*)(Lb + MR * DM);
  float* Sseg = (float*)(Ob + (size_t)32768 * DM);
  float* Dlg = Sseg + (size_t)192 * 16384;
  if constexpr (PH == 17) phase_hgrn<false>(p, Qh, Vv, Lf, p.U, Ob, Sseg, Dlg, shm);
  if constexpr (PH == 18) phase_hgrn<true>(p, Qh, Vv, Lf, p.U, Ob, Sseg, Dlg, shm);
  if constexpr (PH == 24) phase_hgrn_readout(p, p.U, Ob, Gg);
  if constexpr (PH == 19) gemm_phase(p.U, DM, p.WoutO, DM, DM, 4, 128, 0, 4, EpiResid{p.XC, p.out, p.XC, p.out, p.mod + MODL + 5 * 1024, 1.0f}, shm);
  if constexpr (PH == 20) phase_norm(p, 1, 2, p.XC, p.out, NCTX);
  if constexpr (PH == 21) gemm_phase(p.U, DM, p.W13[3], DM, DM, 4, 128, 0, 22, EpiSwiglu{G}, shm);
  if constexpr (PH == 22) gemm_phase(G, DFF, p.W2[3], DFF, DFF, 4, 128, 0, 4, EpiResid{p.XC, p.out, p.XC, p.out, p.mod + MODL + 8 * 1024, 0.5f}, shm);
  if constexpr (PH == 23) phase_final_norm(p);
}

constexpr int N_PHASES = 24;

#define PROBE_DUP -1
template <int PH>
__device__ __forceinline__ void step(const Params& p, int ph0, int ph1, bf16_t* shm) {
  if ((ph0 <= PH && PH < ph1) || (PH == 24 && ph1 - ph0 > 1)) {
    run_phase<PH>(p, shm);
    if constexpr (PH == PROBE_DUP) { xcd_barrier(p.bar, (volatile LAS unsigned*)((LAS unsigned char*)shm + SHM_B)); run_phase<PH>(p, shm); }
    if (PH != 23 && ph1 - ph0 > 1) xcd_barrier(p.bar, (volatile LAS unsigned*)((LAS unsigned char*)shm + SHM_B));
  }
}

__global__ void __launch_bounds__(NTHR, 2) mega(Params p, int ph0, int ph1) {
  extern __shared__ __attribute__((aligned(16))) bf16_t shm[];
  if (ph1 < 0) cg::this_grid().sync();
  {
    volatile LAS unsigned* st = (volatile LAS unsigned*)((LAS unsigned char*)shm + SHM_B);
    if (threadIdx.x == 0) { st[0] = 0u; st[1] = 0u; }
    __syncthreads();
    if (threadIdx.x == 0) (void)xb_add(&p.bar[XB_XCNT(xb_xcc_id())], 1u);
  }
  step<0>(p, ph0, ph1, shm); step<1>(p, ph0, ph1, shm); step<2>(p, ph0, ph1, shm); step<3>(p, ph0, ph1, shm);
  step<4>(p, ph0, ph1, shm); step<5>(p, ph0, ph1, shm); step<6>(p, ph0, ph1, shm); step<7>(p, ph0, ph1, shm);
  step<8>(p, ph0, ph1, shm); step<9>(p, ph0, ph1, shm); step<10>(p, ph0, ph1, shm); step<11>(p, ph0, ph1, shm);
  step<12>(p, ph0, ph1, shm); step<13>(p, ph0, ph1, shm); step<14>(p, ph0, ph1, shm); step<15>(p, ph0, ph1, shm);
  step<16>(p, ph0, ph1, shm); step<17>(p, ph0, ph1, shm); step<18>(p, ph0, ph1, shm); step<24>(p, ph0, ph1, shm); step<19>(p, ph0, ph1, shm);
  step<20>(p, ph0, ph1, shm); step<21>(p, ph0, ph1, shm); step<22>(p, ph0, ph1, shm); step<23>(p, ph0, ph1, shm);
}

extern "C" void kernel_launch(void* const* d_in, const int* in_sizes, int n_in, void* d_out, int out_size, void* d_ws, size_t ws_size,
                              hipStream_t stream) {
  Params p{};
  const float** f = (const float**)&p;
  for (int i = 0; i < 22; ++i) f[i] = (const float*)d_in[i];
  p.out = (float*)d_out;
  char* w = (char*)d_ws; size_t off = 0;
  auto take = [&](size_t bytes) { char* r = w + off; off += (bytes + 255) & ~(size_t)255; return r; };
  p.W13[3] = (bf16_t*)take((size_t)2 * DFF * DM * 2);
  p.W2[3] = (bf16_t*)take((size_t)DM * DFF * 2);
  p.WinO = (bf16_t*)take((size_t)5120 * 1024 * 2);
  p.WoutO = (bf16_t*)take((size_t)1024 * 1024 * 2);
  p.mod = (float*)take((size_t)2 * 5 * 9216 * 4);
  p.XC = (float*)take((size_t)NCTX * DM * 4);
  p.RS = (float*)take((size_t)M_ALL * 2 * 4);
  p.rope = (float*)take((size_t)8192 * 32 * 4);
  p.bar = (unsigned*)take((size_t)XCD_BAR_WORDS * 4);
  p.U = (bf16_t*)take((size_t)M_ALL * DM * 2);
  p.R = take(0);
  {
    const size_t early = (size_t)3 * (2 * DFF * DM * 2) + (size_t)3 * (DM * DFF * 2) + (size_t)2048 * 1024 * 2 + (size_t)1792 * 2048 * 2 + (size_t)1024 * 1024 * 2;
    size_t e0 = (ws_size - early) & ~(size_t)255;
    const size_t rbytes = e0 - off;
    if (rbytes < (size_t)M_ALL * DM * 2 * 5 || ws_size - off < (size_t)M_ALL * DM * 2 * 5 + (size_t)32768 * DM * 2)
      fprintf(stderr, "workspace too small: R=%zu ws=%zu\n", rbytes, ws_size);
    if (ws_size - off < (size_t)M_ALL * DM * 2 * 5 + (size_t)32768 * DM * 2 + (size_t)192 * 16384 * 4 + 192 * 128 * 4) fprintf(stderr, "workspace too small for Sseg\n");
    off = e0;
    for (int i = 0; i < 3; ++i) p.W13[i] = (bf16_t*)take((size_t)2 * DFF * DM * 2);
    for (int i = 0; i < 3; ++i) p.W2[i] = (bf16_t*)take((size_t)DM * DFF * 2);
    p.WinE = (bf16_t*)take((size_t)2048 * 1024 * 2);
    p.Wqkv = (bf16_t*)take((size_t)1792 * 2048 * 2);
    p.WoutE = (bf16_t*)take((size_t)1024 * 1024 * 2);
  }
  static bool attr_done = false;
  if (!attr_done) { (void)hipFuncSetAttribute((const void*)mega, hipFuncAttributeMaxDynamicSharedMemorySize, SHM_B + 256); attr_done = true; }
#if 0
  for (int ph = 0; ph < N_PHASES; ++ph) {
    hipLaunchKernelGGL(mega, dim3(256), dim3(NTHR), SHM_B, stream, p, ph, ph + 1);
  }
#else
  static int grid_blocks = 0;
  if (!grid_blocks) {
    int dev = 0, cus = 0, per_cu = 0;
    hipGetDevice(&dev);
    hipDeviceGetAttribute(&cus, hipDeviceAttributeMultiprocessorCount, dev);
    hipOccupancyMaxActiveBlocksPerMultiprocessor(&per_cu, mega, NTHR, SHM_B + 256);
    if (per_cu > 1) per_cu = 1;
    grid_blocks = cus * per_cu;
  }
  int ph0 = 0, ph1 = N_PHASES;
  void* args[] = {&p, &ph0, &ph1};
  (void)hipMemsetAsync(p.bar, 0, (size_t)XCD_BAR_WORDS * 4, stream);
  hipError_t e = hipLaunchCooperativeKernel((void*)mega, dim3(grid_blocks), dim3(NTHR), args, SHM_B + 256, stream);
  if (e != hipSuccess) fprintf(stderr, "cooperative launch failed: %s (grid %d)\n", hipGetErrorString(e), grid_blocks);
#endif
}
```

```cpp
#include <hip/hip_runtime.h>
#include <hip/hip_cooperative_groups.h>
#include <cstdio>
namespace cg = cooperative_groups;

typedef unsigned short bf16_t;
typedef short bf16x8 __attribute__((ext_vector_type(8)));
typedef float f32x4 __attribute__((ext_vector_type(4)));
typedef unsigned u32x2 __attribute__((ext_vector_type(2)));
typedef unsigned u32x4 __attribute__((ext_vector_type(4)));
typedef _Float16 h16x4 __attribute__((ext_vector_type(4)));
typedef _Float16 h16x8 __attribute__((ext_vector_type(8)));

constexpr int M_ALL = 33792;
constexpr int NCTX = 1024;
constexpr int DM = 1024;
constexpr int DFF = 2816;
constexpr int NKEY = 8448;
constexpr int NTHR = 512;
constexpr float QSCALE = 0.10206207261596577f * 1.4426950408889634f;
constexpr float HSCALE = 0.08838834764831845f;

struct Params {
  const float *x, *c, *ctx, *c_ctx, *ada_w, *ada_b, *norm_g, *ffn_w1, *ffn_w3, *ffn_w2, *even_w_in, *even_conv_w,
      *q_norm_g, *w_uq, *kv_norm_g, *w_ukv, *even_w_out, *odd_w_in, *lb_logits, *g_norm_g, *odd_w_out, *final_norm_g;
  float* out;
  bf16_t *W13[4], *W2[4], *WinE, *Wqkv, *WoutE, *WinO, *WoutO;
  float *mod, *XC, *RS, *rope;
  unsigned* bar;
  bf16_t* U;
  char* R;
};

__device__ __forceinline__ float bf2f(bf16_t v) { return __uint_as_float(((unsigned)v) << 16); }
typedef float f32x2 __attribute__((ext_vector_type(2)));
typedef __bf16 bf16v2 __attribute__((ext_vector_type(2)));
__device__ __forceinline__ unsigned pk2(float lo, float hi) { f32x2 v = {lo, hi}; return __builtin_bit_cast(unsigned, __builtin_convertvector(v, bf16v2)); }
__device__ __forceinline__ bf16_t f2bf(float f) { return (bf16_t)(pk2(f, 0.f) & 0xffffu); }
__device__ __forceinline__ float lo2f(unsigned u) { return __uint_as_float(u << 16); }
__device__ __forceinline__ float hi2f(unsigned u) { return __uint_as_float(u & 0xffff0000u); }
__device__ __forceinline__ float wave_sum(float v) {
#pragma unroll
  for (int o = 32; o > 0; o >>= 1) v += __shfl_xor(v, o);
  return v;
}
__device__ __forceinline__ float sigmoidf_(float a) { return __builtin_amdgcn_rcpf(1.f + __expf(-a)); }
__device__ __forceinline__ int row_mi(int r) { return r < NCTX ? 4 : ((r - NCTX) >> 13); }
__device__ __forceinline__ void row_bk(int r, int& b, int& key) {
  if (r < NCTX) { b = r >> 8; key = r & 255; } else { int rr = r - NCTX; b = rr >> 13; key = 256 + (rr & 8191); }
}

constexpr int BM = 256, BK = 64, HALF = 128, NXCD = 8, WGM = 8, HT = HALF * BK, SHM_B = 8 * HT * 2;

__device__ __forceinline__ int lds_byte(int r, int c) {
  int st = (r >> 4) * 2 + (c >> 5), rr = r & 15, cc = c & 31, ob = rr * 64 + cc * 2;
  return st * 1024 + (ob ^ (((ob >> 9) & 1) << 5));
}
__device__ __forceinline__ void stage_rc(int b, int& R, int& C) {
  int st = b / 1024, sb = b % 1024, swz = sb ^ (((sb >> 9) & 1) << 5);
  R = (st >> 1) * 16 + swz / 64; C = (st & 1) * 32 + (swz % 64) / 2;
}

#define LAS __attribute__((address_space(3)))
struct EpiNone { static constexpr bool HALFOK = false; __device__ __forceinline__ void operator()(const f32x4 (&)[2][2][4][2], int, int, int, int, int, int, int) const {} };
template <class Epi, class Epi2 = EpiNone>
__device__ __forceinline__ void gemm_phase(const bf16_t* A, int lda, const bf16_t* Bt, int ldb, int K, int pm0, int nM, int pn0, int nN,
                                           const Epi& epi, LAS unsigned char* lds, int nsm = 0, int ksl = 1, const Epi2& epi2 = Epi2()) {
  const int tid = threadIdx.x, wid = __builtin_amdgcn_readfirstlane(tid >> 6), lane = tid & 63, wr = wid >> 2, wc = wid & 3, fr = lane & 15, fq = lane >> 4;
  const int nt = K / BK;
  const int nwg = nM * nN, G = gridDim.x;
  const int nsplit = nsm * nN * ksl, nts = nt / ksl;
  if ((int)blockIdx.x >= nwg + nsplit) return;
  const int Rfull = nwg / G, Lleft = nwg - Rfull * G;
  const bool tail_split = Epi::HALFOK && nsm == 0 && Lleft > 0 && 2 * Lleft <= G;
  unsigned voffA[2], voffB[2];
#pragma unroll
  for (int i = 0; i < 2; ++i) { int R, C; stage_rc(tid * 16 + i * 8192, R, C); voffA[i] = (unsigned)(R * lda + C) * 2u; voffB[i] = (unsigned)(R * ldb + C) * 2u; }
  const size_t kstep = (size_t)(BK * 2);
  const size_t hstepA = (size_t)HALF * lda * 2, hstepB = (size_t)HALF * ldb * 2;
  const unsigned ldsw = (unsigned)wid * 1024u;
  const int aoff = lds_byte(wr * 64 + fr, fq * 8), boff = lds_byte(wc * 32 + fr, fq * 8);
#define G_SA(b, h) (((b) * 2 + (h)) * (HT * 2))
#define G_SB(b, h) ((4 + (b) * 2 + (h)) * (HT * 2))
#define G_STAGE(bufoff, gbase, voff) do { _Pragma("unroll") for (int _i = 0; _i < 2; ++_i) \
    __builtin_amdgcn_global_load_lds((const unsigned*)((const char*)(gbase) + (voff)[_i]), (LAS unsigned*)(lds + (bufoff) + ldsw + _i * 8192), 16, 0, 0); } while (0)
#define G_LDA(dst, b, h) do { _Pragma("unroll") for (int m = 0; m < 4; ++m) _Pragma("unroll") for (int k = 0; k < 2; ++k) dst[m][k] = *(const LAS bf16x8*)(lds + G_SA(b, h) + aoff + m * 2048 + k * 1024); } while (0)
#define G_LDB(dst, b, h) do { _Pragma("unroll") for (int n = 0; n < 2; ++n) _Pragma("unroll") for (int k = 0; k < 2; ++k) dst[n][k] = *(const LAS bf16x8*)(lds + G_SB(b, h) + boff + n * 2048 + k * 1024); } while (0)
#define G_MMA(ai, bj, At, Bx) do { __builtin_amdgcn_s_setprio(1); _Pragma("unroll") for (int m = 0; m < 4; ++m) _Pragma("unroll") for (int n = 0; n < 2; ++n) _Pragma("unroll") for (int k = 0; k < 2; ++k) \
    acc[ai][bj][m][n] = __builtin_amdgcn_mfma_f32_16x16x32_bf16(Bx[n][k], At[m][k], acc[ai][bj][m][n], 0, 0, 0); __builtin_amdgcn_s_setprio(0); } while (0)
#define WAIT_V(n) asm volatile("s_waitcnt vmcnt(" #n ")" ::: "memory")
#define WAIT_L(n) asm volatile("s_waitcnt lgkmcnt(" #n ")" ::: "memory")
#define BAR __builtin_amdgcn_s_barrier()
#define SCHED __builtin_amdgcn_sched_barrier(0)
  auto unit = [&](int i, int& pm, int& pn, int& sl, int& hf) -> bool {
    long L = (long)i * G + blockIdx.x; sl = -1; hf = -1;
    if (tail_split && i >= Rfull) { if (i > Rfull || (int)blockIdx.x >= 2 * Lleft) return false; L = (long)Rfull * G + (blockIdx.x >> 1); hf = blockIdx.x & 1; }
    if (L >= nwg) { const int j = (int)(L - nwg); if (j >= nsplit) return false; sl = j % ksl; const int tile = j / ksl; pm = tile / nN; pn = pn0 + tile % nN; return true; }
    int wgid = (int)L; { const int q = nwg / NXCD, r = nwg % NXCD, xcd = wgid % NXCD, off = wgid / NXCD; wgid = (xcd < r ? xcd * (q + 1) : r * (q + 1) + (xcd - r) * q) + off; }
    const int nig = WGM * nN, gid = wgid / nig, fm = gid * WGM, gsz = (nM - fm) < WGM ? (nM - fm) : WGM;
    pm = pm0 + fm + ((wgid % nig) % gsz); pn = pn0 + (wgid % nig) / gsz; return true;
  };
  int cpm, cpn, csl, chf, npm = 0, npn = 0, nsl = -1, nhf = -1, ui = 0;
  unit(0, cpm, cpn, csl, chf);
  f32x4 acc[2][2][4][2];
#pragma unroll
  for (int a = 0; a < 2; ++a)
#pragma unroll
    for (int b = 0; b < 2; ++b)
#pragma unroll
      for (int m = 0; m < 4; ++m)
#pragma unroll
        for (int n = 0; n < 2; ++n) acc[a][b][m][n] = (f32x4){0.f, 0.f, 0.f, 0.f};
  bf16x8 At[4][2], B0[2][2], B1[2][2];
  const char* cA = (const char*)A + (size_t)cpm * 2 * hstepA + (csl < 0 ? 0 : (size_t)csl * nts * kstep) + (chf > 0 ? hstepA : 0);
  size_t chA = chf < 0 ? hstepA : 0, nhA = hstepA;
  const char* cB = (const char*)Bt + (size_t)cpn * 2 * hstepB + (csl < 0 ? 0 : (size_t)csl * nts * kstep);
  G_STAGE(G_SB(0, 0), cB, voffB); G_STAGE(G_SA(0, 0), cA, voffA); G_STAGE(G_SB(0, 1), cB + hstepB, voffB); G_STAGE(G_SA(0, 1), cA + chA, voffA);
  if (wr == 1) BAR;
  WAIT_V(4); BAR;
  G_STAGE(G_SB(1, 0), cB + kstep, voffB); G_STAGE(G_SA(1, 0), cA + kstep, voffA); G_STAGE(G_SB(1, 1), cB + hstepB + kstep, voffB);
  WAIT_V(6); BAR;
#define G_KLOOP(AI1) \
    _Pragma("nounroll") \
    for (int t = 0; t < cnt; t += 2) { \
      const bool last = (t == cnt - 2); \
      const char* a1 = cA + (size_t)(t + 1) * kstep; \
      const char* a2 = last ? nA : cA + (size_t)(t + 2) * kstep; const char* b2 = last ? nB : cB + (size_t)(t + 2) * kstep; \
      const char* a3 = a2 + kstep; const char* b3 = b2 + kstep; \
      G_LDB(B0, 0, 0); SCHED; G_LDA(At, 0, 0); G_STAGE(G_SA(1, 1), a1 + chA, voffA); \
      WAIT_L(8); BAR; WAIT_L(0); G_MMA(0, 0, At, B0); BAR; SCHED; \
      G_LDB(B1, 0, 1); G_STAGE(G_SB(0, 0), b2, voffB); \
      BAR; WAIT_L(0); G_MMA(0, 1, At, B1); BAR; \
      G_LDA(At, 0, 1); G_STAGE(G_SA(0, 0), a2, voffA); \
      BAR; WAIT_L(0); if (AI1) G_MMA(1, 0, At, B0); BAR; SCHED; \
      G_STAGE(G_SB(0, 1), b2 + hstepB, voffB); \
      WAIT_V(6); BAR; if (AI1) G_MMA(1, 1, At, B1); BAR; \
      G_LDB(B0, 1, 0); SCHED; G_LDA(At, 1, 0); G_STAGE(G_SA(0, 1), a2 + (last ? nhA : chA), voffA); \
      WAIT_L(8); BAR; WAIT_L(0); G_MMA(0, 0, At, B0); BAR; SCHED; \
      G_LDB(B1, 1, 1); G_STAGE(G_SB(1, 0), b3, voffB); \
      BAR; WAIT_L(0); G_MMA(0, 1, At, B1); BAR; \
      G_LDA(At, 1, 1); G_STAGE(G_SA(1, 0), a3, voffA); \
      BAR; WAIT_L(0); if (AI1) G_MMA(1, 0, At, B0); BAR; SCHED; \
      G_STAGE(G_SB(1, 1), b3 + hstepB, voffB); \
      WAIT_V(6); BAR; if (AI1) G_MMA(1, 1, At, B1); BAR; \
    }
  bool pending_half = false;
  for (;;) {
    const bool has_next = unit(ui + 1, npm, npn, nsl, nhf);
    const char* nA = has_next ? (const char*)A + (size_t)npm * 2 * hstepA + (nsl < 0 ? 0 : (size_t)nsl * nts * kstep) + (nhf > 0 ? hstepA : 0) : cA;
    const char* nB = has_next ? (const char*)Bt + (size_t)npn * 2 * hstepB + (nsl < 0 ? 0 : (size_t)nsl * nts * kstep) : cB;
    nhA = has_next ? (nhf < 0 ? hstepA : 0) : chA;
    const int cnt = csl < 0 ? nt : nts;
    G_KLOOP(1)
    if (csl < 0) {
      if constexpr (Epi::HALFOK) epi(acc, cpm * BM, cpn * BM, wr, wc, fr, fq, 2);
      else epi(acc, cpm * BM, cpn * BM, wr, wc, fr, fq);
    } else epi2(acc, cpm * BM, cpn * BM, wr, wc, fr, fq, csl);
#ifndef NO_EPI_DRAIN
    WAIT_V(0);
#endif
    if (!has_next) break;
#pragma unroll
    for (int a = 0; a < 2; ++a)
#pragma unroll
      for (int b = 0; b < 2; ++b)
#pragma unroll
        for (int m = 0; m < 4; ++m)
#pragma unroll
          for (int n = 0; n < 2; ++n) acc[a][b][m][n] = (f32x4){0.f, 0.f, 0.f, 0.f};
    cpm = npm; cpn = npn; csl = nsl; chf = nhf; chA = nhA; cA = nA; cB = nB; ++ui;
    if (chf >= 0) { pending_half = true; break; }
  }
  if constexpr (Epi::HALFOK) {
    if (pending_half) {
      const char* nA = cA; const char* nB = cB; nhA = chA;
      const int cnt = nt;
      G_KLOOP(0)
      epi(acc, cpm * BM + (chf > 0 ? HALF : 0), cpn * BM, wr, wc, fr, fq, 1);
    }
  }
#undef G_KLOOP
  WAIT_V(0);
  if (wr == 0) BAR;
  BAR;
}

typedef f32x4 Acc[2][2][4][2];

struct EpiSwiglu { static constexpr bool HALFOK = true;
  bf16_t* G;
  __device__ __forceinline__ void operator()(const Acc& acc, int brow, int bcol, int wr, int wc, int fr, int fq, int nai) const {
    const int f0 = (bcol >> 1) + 32 * wc + 8 * fq;
    asm volatile("s_waitcnt vmcnt(14)" ::: "memory");
#pragma unroll
    for (int ai = 0; ai < 2; ++ai)
#pragma unroll
      for (int m = 0; m < 4; ++m) if (ai < nai) {
        const int r = brow + 128 * ai + 64 * wr + 16 * m + fr;
        u32x4 o;
#pragma unroll
        for (int bj = 0; bj < 2; ++bj) {
          const f32x4 a = acc[ai][bj][m][0], b = acc[ai][bj][m][1];
          const float g0 = a[0] * sigmoidf_(a[0]) * b[0], g1 = a[1] * sigmoidf_(a[1]) * b[1];
          const float g2 = a[2] * sigmoidf_(a[2]) * b[2], g3 = a[3] * sigmoidf_(a[3]) * b[3];
          if (bj == 0) { o.x = pk2(g0, g1); o.y = pk2(g2, g3); } else { o.z = pk2(g0, g1); o.w = pk2(g2, g3); }
        }
        *(u32x4*)(G + (size_t)r * DFF + f0) = o;
      }
  }
};

struct EpiResid { static constexpr bool HALFOK = false;
  const float *srcC, *srcL; float *dstC, *dstL; const float* gate;   float coef;
  __device__ __forceinline__ void operator()(const Acc& acc, int brow, int bcol, int wr, int wc, int fr, int fq) const {
    const float* g = gate + (size_t)row_mi(brow) * 9 * DM + bcol + 32 * wc + 4 * fq;
    f32x4 gv[2][2];
#pragma unroll
    for (int bj = 0; bj < 2; ++bj)
#pragma unroll
      for (int n = 0; n < 2; ++n) gv[bj][n] = coef * *(const f32x4*)(g + 128 * bj + 16 * n);
    const size_t rb = (size_t)(brow - NCTX + 64 * wr + fr) * DM + bcol + 32 * wc + 4 * fq;
#pragma unroll
    for (int ai = 0; ai < 2; ++ai)
#pragma unroll
      for (int mp = 0; mp < 2; ++mp) {
        f32x4 xv[2][2][2];
#pragma unroll
        for (int mm = 0; mm < 2; ++mm)
#pragma unroll
          for (int bj = 0; bj < 2; ++bj)
#pragma unroll
            for (int n = 0; n < 2; ++n)
              xv[mm][bj][n] = *(const f32x4*)(srcL + rb + (size_t)(128 * ai + 16 * (2 * mp + mm)) * DM + 128 * bj + 16 * n);
#pragma unroll
        for (int mm = 0; mm < 2; ++mm)
#pragma unroll
          for (int bj = 0; bj < 2; ++bj)
#pragma unroll
            for (int n = 0; n < 2; ++n)
              *(f32x4*)(dstL + rb + (size_t)(128 * ai + 16 * (2 * mp + mm)) * DM + 128 * bj + 16 * n) = xv[mm][bj][n] + gv[bj][n] * acc[ai][bj][2 * mp + mm][n];
      }
  }
};

struct EpiPart { static constexpr bool HALFOK = false;
  float* PART;
  __device__ __forceinline__ void operator()(const Acc& acc, int brow, int bcol, int wr, int wc, int fr, int fq, int sl) const {
#pragma unroll
    for (int ai = 0; ai < 2; ++ai)
#pragma unroll
      for (int m = 0; m < 4; ++m) {
        const int r = brow + 128 * ai + 64 * wr + 16 * m + fr;
        float* d = PART + ((size_t)sl * NCTX + r) * DM;
#pragma unroll
        for (int bj = 0; bj < 2; ++bj)
#pragma unroll
          for (int n = 0; n < 2; ++n) *(f32x4*)(d + bcol + 128 * bj + 32 * wc + 16 * n + 4 * fq) = acc[ai][bj][m][n];
      }
  }
};

struct EpiBf16 { static constexpr bool HALFOK = false;
  bf16_t* O; int ldc;
  __device__ __forceinline__ void operator()(const Acc& acc, int brow, int bcol, int wr, int wc, int fr, int fq) const {
#pragma unroll
    for (int ai = 0; ai < 2; ++ai)
#pragma unroll
      for (int m = 0; m < 4; ++m) {
        const int r = brow + 128 * ai + 64 * wr + 16 * m + fr;
#pragma unroll
        for (int bj = 0; bj < 2; ++bj)
#pragma unroll
          for (int n = 0; n < 2; ++n) {
            const int c = bcol + 128 * bj + 32 * wc + 16 * n + 4 * fq;
            f32x4 v = acc[ai][bj][m][n];
            u32x2 o; o.x = pk2(v[0], v[1]); o.y = pk2(v[2], v[3]);
            *(u32x2*)(O + (size_t)r * ldc + c) = o;
          }
      }
  }
};

struct EpiP { static constexpr bool HALFOK = true;
  bf16_t* O; float* RS;
  __device__ __forceinline__ void operator()(const Acc& acc, int brow, int bcol, int wr, int wc, int fr, int fq, int nai) const {
    asm volatile("s_waitcnt vmcnt(14)" ::: "memory");
#pragma unroll
    for (int ai = 0; ai < 2; ++ai)
#pragma unroll
      for (int m = 0; m < 4; ++m) if (ai < nai) {
        const int r = brow + 128 * ai + 64 * wr + 16 * m + fr;
        float ss0 = 0.f, ss1 = 0.f;
#pragma unroll
        for (int bj = 0; bj < 2; ++bj) {
          const int c = bcol + 128 * bj + 32 * wc + 8 * fq;
          const f32x4 v0 = acc[ai][bj][m][0], v1 = acc[ai][bj][m][1];
          const float q = v0[0] * v0[0] + v0[1] * v0[1] + v0[2] * v0[2] + v0[3] * v0[3] + v1[0] * v1[0] + v1[1] * v1[1] + v1[2] * v1[2] + v1[3] * v1[3];
          if (bj == 0) ss0 += q; else ss1 += q;
          u32x4 o; o.x = pk2(v0[0], v0[1]); o.y = pk2(v0[2], v0[3]); o.z = pk2(v1[0], v1[1]); o.w = pk2(v1[2], v1[3]);
          *(u32x4*)(O + (size_t)r * 2048 + c) = o;
        }
        if (bcol == 1536) {
          float ss = ss0 + ss1; ss += __shfl_xor(ss, 16); ss += __shfl_xor(ss, 32);
          if (fq == 0) atomicAdd(RS + 2 * r, ss);
        } else if (bcol == 1792) {
          float ss = ss0; ss += __shfl_xor(ss, 16); ss += __shfl_xor(ss, 32);
          if (fq == 0) atomicAdd(RS + 2 * r + 1, ss);
        }
      }
  }
};

struct EpiQ { static constexpr bool HALFOK = false;
  const float* RS; const float* rope;   bf16_t* Qall;
  __device__ __forceinline__ void operator()(const Acc& acc, int brow, int bcol, int wr, int wc, int fr, int fq) const {
#pragma unroll
    for (int ai = 0; ai < 2; ++ai)
#pragma unroll
      for (int m = 0; m < 4; ++m) {
        const int r = brow + 128 * ai + 64 * wr + 16 * m + fr;
        const float rstd = rsqrtf(RS[2 * r] * (1.f / 256.f) + 1e-6f) * QSCALE;
        int b, key; row_bk(r, b, key);
        const bool latent = r >= NCTX;
        const int t = (r - NCTX) & 8191;
        bf16_t* qrow = Qall + ((size_t)(b * 8) * NKEY + key) * 96 + 4 * fq;
#pragma unroll
        for (int bj = 0; bj < 2; ++bj) {
          const int c32 = bcol + 128 * bj + 32 * wc;
          const int h = c32 / 96, d32 = c32 - 96 * h;
#pragma unroll
          for (int n = 0; n < 2; ++n) {
            f32x4 v = acc[ai][bj][m][n] * rstd;
            if (d32 == 64) {
              f32x4 pv;
#pragma unroll
              for (int j = 0; j < 4; ++j) pv[j] = __shfl_xor(v[j], 32);
              if (latent) {
                const float* rp = rope + ((size_t)t * 2 + n) * 16 + 4 * (fq & 1);
                const f32x4 cs = *(const f32x4*)rp, sn = *(const f32x4*)(rp + 8);
                v = (fq < 2) ? (v * cs - pv * sn) : (pv * sn + v * cs);
              }
            }
            u32x2 o; o.x = pk2(v[0], v[1]); o.y = pk2(v[2], v[3]);
            *(u32x2*)(qrow + (size_t)h * (NKEY * 96) + d32 + 16 * n) = o;
          }
        }
      }
  }
};
struct EpiKV { static constexpr bool HALFOK = false;
  const float* RS; bf16_t *Kall, *Vt;
  __device__ __forceinline__ void operator()(const Acc& acc, int brow, int bcol, int wr, int wc, int fr, int fq) const {
#pragma unroll
    for (int ai = 0; ai < 2; ++ai)
#pragma unroll
      for (int m = 0; m < 4; ++m) {
        const int r = brow + 128 * ai + 64 * wr + 16 * m + fr;
        const float rstd = rsqrtf(RS[2 * r + 1] * (1.f / 128.f) + 1e-6f);
        int b, key; row_bk(r, b, key);
        bf16_t* krow = Kall + ((size_t)(b * 8) * NKEY + key) * 96 + 4 * fq;
        bf16_t* vrow = Vt + (size_t)(b * 8) * 64 * NKEY + key + (size_t)(4 * fq) * NKEY;
#pragma unroll
        for (int bj = 0; bj < 2; ++bj) {
          const int cc = bcol - 768 + 128 * bj + 32 * wc, h = cc >> 7, e32 = cc & 127;
#pragma unroll
          for (int n = 0; n < 2; ++n) {
            const f32x4 v = acc[ai][bj][m][n] * rstd;
            if (e32 < 64) {
              u32x2 o; o.x = pk2(v[0], v[1]); o.y = pk2(v[2], v[3]);
              *(u32x2*)(krow + (size_t)h * (NKEY * 96) + e32 + 16 * n) = o;
            } else {
              bf16_t* vp = vrow + (size_t)(h * 64 + e32 - 64 + 16 * n) * NKEY;
#pragma unroll
              for (int j = 0; j < 4; ++j) vp[(size_t)j * NKEY] = f2bf(v[j]);
            }
          }
        }
      }
  }
};

struct EpiQKV { static constexpr bool HALFOK = false;
  EpiQ q; EpiKV kv;
  __device__ __forceinline__ void operator()(const Acc& acc, int brow, int bcol, int wr, int wc, int fr, int fq) const {
    if (bcol < 768) q(acc, brow, bcol, wr, wc, fr, fq); else kv(acc, brow, bcol, wr, wc, fr, fq);
  }
};

struct EpiOdd { static constexpr bool HALFOK = true;
  bf16_t *Qh, *Vv, *Gg; _Float16 *Lf, *Lb; const float* lbl;
  __device__ __forceinline__ void operator()(const Acc& acc, int brow, int bcol, int wr, int wc, int fr, int fq, int nai) const {
    const int sec = bcol >> 10;
    const int cb = (bcol & 1023) + 32 * wc + 8 * fq;
    asm volatile("s_waitcnt vmcnt(14)" ::: "memory");
    if (sec == 2 || sec == 3) {
      const int dir = sec - 2;
      _Float16* O = Lf + (size_t)dir * ((size_t)M_ALL * DM);
#pragma unroll
      for (int bj = 0; bj < 2; ++bj) {
        const int c = cb + 128 * bj;
        f32x4 lb[2];
#pragma unroll
        for (int n = 0; n < 2; ++n) {
          const f32x4 z0 = *(const f32x4*)(lbl + dir * 1024 + c + 4 * n), z1 = *(const f32x4*)(lbl + 2048 + dir * 1024 + c + 4 * n);
#pragma unroll
          for (int j = 0; j < 4; ++j) lb[n][j] = __builtin_amdgcn_rcpf(1.f + __expf(z0[j] - z1[j]));
        }
#pragma unroll
        for (int ai = 0; ai < 2; ++ai)
#pragma unroll
          for (int m = 0; m < 4; ++m) if (ai < nai) {
            const int r = brow + 128 * ai + 64 * wr + 16 * m + fr;
            h16x8 hv;
#pragma unroll
            for (int n = 0; n < 2; ++n) {
              const f32x4 v = acc[ai][bj][m][n];
#pragma unroll
              for (int j = 0; j < 4; ++j) hv[4 * n + j] = (_Float16)__logf(lb[n][j] + (1.f - lb[n][j]) * sigmoidf_(v[j]));
            }
            *(h16x8*)(O + (size_t)r * DM + c) = hv;
          }
      }
    } else {
      bf16_t* O = Qh + (size_t)(sec == 4 ? 2 : sec) * ((size_t)M_ALL * DM);
      const float sc = sec == 0 ? HSCALE : 1.f;
#pragma unroll
      for (int ai = 0; ai < 2; ++ai)
#pragma unroll
        for (int m = 0; m < 4; ++m) if (ai < nai) {
          const int r = brow + 128 * ai + 64 * wr + 16 * m + fr;
#pragma unroll
          for (int bj = 0; bj < 2; ++bj) {
            const int c = cb + 128 * bj;
            const f32x4 v0 = acc[ai][bj][m][0] * sc, v1 = acc[ai][bj][m][1] * sc;
            u32x4 o; o.x = pk2(v0[0], v0[1]); o.y = pk2(v0[2], v0[3]); o.z = pk2(v1[0], v1[1]); o.w = pk2(v1[2], v1[3]);
            *(u32x4*)(O + (size_t)r * DM + c) = o;
          }
        }
    }
  }
};

__device__ __forceinline__ void tr_tile(const float* src, int ldn, int k0, int n0, int nv, bf16_t* dst, int ldk, int kofs, int mode, const float* kscale, float* sm) {
  const int tid = threadIdx.x;
  float v[8];
#pragma unroll
  for (int i = 0; i < 8; ++i) {
    const int e = tid + i * NTHR, k = e >> 6, n = e & 63;
    v[i] = (n < nv) ? src[(size_t)(k0 + k) * ldn + n0 + n] : 0.f;
  }
#pragma unroll
  for (int i = 0; i < 8; ++i) {
    const int e = tid + i * NTHR, k = e >> 6, n = e & 63;
    sm[k * 65 + n] = kscale ? v[i] * kscale[k0 + k] : v[i];
  }
  __syncthreads();
  {
    const int n = tid >> 3, kq = tid & 7;
    const int ng = n0 + n;
    int drow = ng;
    if (mode == 1 || mode == 2) {
      const int pn = ng >> 7, rem = ng & 127, wc = rem >> 5, r2 = rem & 31, fq = r2 >> 3, bj = (r2 >> 2) & 1, j = r2 & 3;
      drow = 256 * pn + 128 * bj + 32 * wc + 16 * (mode - 1) + 4 * fq + j;
    } else if (mode == 3) {
      const int o = ng & 31, fq = o >> 3, nn = (o >> 2) & 1, j = o & 3;
      drow = (ng & ~31) + 16 * nn + 4 * fq + j;
    }
    if (n < nv) {
      u32x4 o;
      o.x = pk2(sm[(8 * kq + 0) * 65 + n], sm[(8 * kq + 1) * 65 + n]);
      o.y = pk2(sm[(8 * kq + 2) * 65 + n], sm[(8 * kq + 3) * 65 + n]);
      o.z = pk2(sm[(8 * kq + 4) * 65 + n], sm[(8 * kq + 5) * 65 + n]);
      o.w = pk2(sm[(8 * kq + 6) * 65 + n], sm[(8 * kq + 7) * 65 + n]);
      *(u32x4*)(dst + (size_t)drow * ldk + kofs + k0 + 8 * kq) = o;
    }
  }
  __syncthreads();
}

__device__ void phase_prep(const Params& p, float* sm) {
  const int tid = threadIdx.x;
  int base = 0;
  const int bid = blockIdx.x, G = gridDim.x;
#define TRJOB(SRC, KK, NN, DST, LDK, KOFS, MODE, KS) { const int nk = (KK) / 64, nn = ((NN) + 63) / 64, tot = nk * nn; \
    int first = (bid - base % G + G) % G; \
    for (int t = first; t < tot; t += G) { const int n0_ = (t % nn) * 64; tr_tile((SRC), (NN), (t / nn) * 64, n0_, ((NN) - n0_) < 64 ? ((NN) - n0_) : 64, (DST), (LDK), (KOFS), (MODE), (KS), sm); } \
    base += tot; }
  for (int lj = 0; lj < 4; ++lj) {
    TRJOB(p.ffn_w1 + (size_t)lj * DM * DFF, DM, DFF, p.W13[lj], DM, 0, 1, nullptr);
    TRJOB(p.ffn_w3 + (size_t)lj * DM * DFF, DM, DFF, p.W13[lj], DM, 0, 2, nullptr);
    TRJOB(p.ffn_w2 + (size_t)lj * DFF * DM, DFF, DM, p.W2[lj], DFF, 0, 0, nullptr);
  }
  TRJOB(p.even_w_in, DM, 1952, p.WinE, DM, 0, 3, nullptr);
  TRJOB(p.w_uq, 256, 768, p.Wqkv, 2048, 0, 0, p.q_norm_g);
  TRJOB(p.w_ukv, 128, 1024, p.Wqkv + (size_t)768 * 2048, 2048, 256, 0, p.kv_norm_g);
  TRJOB(p.even_w_out, DM, DM, p.WoutE, DM, 0, 0, nullptr);
  TRJOB(p.odd_w_in, DM, 5120, p.WinO, DM, 0, 3, nullptr);
  TRJOB(p.odd_w_out, DM, DM, p.WoutO, DM, 0, 0, nullptr);
#undef TRJOB
  for (int i = bid * NTHR + tid; i < 96 * 1024; i += G * NTHR) p.WinE[(size_t)1952 * 1024 + i] = 0;
  for (int i = bid * NTHR + tid; i < 768 * 128; i += G * NTHR) p.Wqkv[(size_t)(i >> 7) * 2048 + 256 + (i & 127)] = 0;
  for (int i = bid * NTHR + tid; i < 1024 * 256; i += G * NTHR) p.Wqkv[(size_t)(768 + (i >> 8)) * 2048 + (i & 255)] = 0;
  for (int i = bid * NTHR + tid; i < M_ALL * 2; i += G * NTHR) p.RS[i] = 0.f;
  for (int i = bid * NTHR + tid; i < 8192 * 16; i += G * NTHR) {
    const int t = i >> 4, ax = (i >> 3) & 1, fi = i & 7;
    const float pos = (float)(ax == 0 ? (t >> 6) : (t & 63));
    const float ang = pos * exp2f(-(float)fi * (13.287712379549449f / 8.f));
    p.rope[(size_t)(t * 2 + ax) * 16 + fi] = cosf(ang); p.rope[(size_t)(t * 2 + ax) * 16 + 8 + fi] = sinf(ang);
  }
  {
    float* scond = sm;
    float* red = sm + 5 * 1024;
    for (int i = tid; i < 5 * 1024; i += NTHR) {
      const int mi = i >> 10, k = i & 1023;
      const float cv = mi < 4 ? p.c[mi * 1024 + k] : p.c_ctx[k];
      scond[i] = cv * sigmoidf_(cv);
    }
    __syncthreads();
    const int col = tid & 63, kg = tid >> 6;
    for (int it = G - 1 - bid; it < 2 * 144; it += G) {
      const int l = it / 144, n = (it % 144) * 64 + col;
      const float* w = p.ada_w + (size_t)l * 1024 * 9216 + n;
      float a0 = 0, a1 = 0, a2 = 0, a3 = 0, a4 = 0;
#pragma unroll 16
      for (int k = kg * 128; k < kg * 128 + 128; ++k) {
        const float wv = w[(size_t)k * 9216];
        a0 += scond[k] * wv; a1 += scond[1024 + k] * wv; a2 += scond[2048 + k] * wv; a3 += scond[3072 + k] * wv; a4 += scond[4096 + k] * wv;
      }
      red[(kg * 5 + 0) * 64 + col] = a0; red[(kg * 5 + 1) * 64 + col] = a1; red[(kg * 5 + 2) * 64 + col] = a2;
      red[(kg * 5 + 3) * 64 + col] = a3; red[(kg * 5 + 4) * 64 + col] = a4;
      __syncthreads();
      for (int i = tid; i < 5 * 64; i += NTHR) {
        const int mi = i >> 6, cc = i & 63, nn = (it % 144) * 64 + cc;
        float sacc = 0.f;
#pragma unroll
        for (int q = 0; q < 8; ++q) sacc += red[(q * 5 + mi) * 64 + cc];
        p.mod[((size_t)(l * 5 + mi)) * 9216 + nn] = sacc + p.ada_b[l * 9216 + nn];
      }
      __syncthreads();
    }
  }
}

__device__ __forceinline__ void phase_norm(const Params& p, int l, int j, const float* srcC, const float* srcL, int row0,
                           const float* PART = nullptr, int ksl = 0, float coef = 0.f, const float* pgate = nullptr) {
  constexpr int NR = 2;
  const int wave = threadIdx.x >> 6, lane = threadIdx.x & 63;
  const float* g = p.norm_g + (l * 3 + j) * 1024;
  f32x4 gv[4];
#pragma unroll
  for (int i = 0; i < 4; ++i) gv[i] = *(const f32x4*)(g + (lane + 64 * i) * 4);
  const int stride = gridDim.x * 8;
  for (int rb = row0 + blockIdx.x * 8 + wave; rb < M_ALL; rb += stride * NR) {
    f32x4 v[NR][4], sv[NR][4], hv[NR][4];
#pragma unroll
    for (int q = 0; q < NR; ++q) {
      const int rr = rb + q * stride, r = rr < M_ALL ? rr : M_ALL - 1;
      const float* src = r < NCTX ? srcC + (size_t)r * DM : srcL + (size_t)(r - NCTX) * DM;
      const float* sh = p.mod + ((size_t)(l * 5 + row_mi(r)) * 9 + 3 * j) * 1024;
#pragma unroll
      for (int i = 0; i < 4; ++i) { v[q][i] = ((const f32x4*)src)[lane + 64 * i]; hv[q][i] = ((const f32x4*)sh)[lane + 64 * i]; sv[q][i] = ((const f32x4*)(sh + 1024))[lane + 64 * i]; }
      if (ksl > 0 && r < NCTX) {
#pragma unroll
        for (int i = 0; i < 4; ++i) {
          f32x4 a = {0.f, 0.f, 0.f, 0.f};
          for (int sl = 0; sl < ksl; ++sl) a += ((const f32x4*)(PART + ((size_t)sl * NCTX + r) * DM))[lane + 64 * i];
          v[q][i] += coef * ((const f32x4*)pgate)[lane + 64 * i] * a;
        }
      }
    }
#pragma unroll
    for (int q = 0; q < NR; ++q) {
      const int rr = rb + q * stride, r = rr < M_ALL ? rr : M_ALL - 1;
      const bool live = rr < M_ALL;
      float ss = 0.f;
#pragma unroll
      for (int i = 0; i < 4; ++i) ss += v[q][i][0] * v[q][i][0] + v[q][i][1] * v[q][i][1] + v[q][i][2] * v[q][i][2] + v[q][i][3] * v[q][i][3];
      ss = wave_sum(ss);
      const float rstd = rsqrtf(ss * (1.f / 1024.f) + 1e-6f);
      if (live) {
        if (ksl > 0 && r < NCTX) {
#pragma unroll
          for (int i = 0; i < 4; ++i) ((f32x4*)(p.XC + (size_t)r * DM))[lane + 64 * i] = v[q][i];
        }
#pragma unroll
        for (int i = 0; i < 4; ++i) {
          const f32x4 u = v[q][i] * rstd * gv[i] * (1.f + sv[q][i]) + hv[q][i];
          u32x2 o; o.x = pk2(u[0], u[1]); o.y = pk2(u[2], u[3]);
          *(u32x2*)(p.U + (size_t)r * DM + (lane + 64 * i) * 4) = o;
        }
      }
    }
  }
}

__device__ __forceinline__ void phase_final_norm(const Params& p) {
  constexpr int NR = 4;
  const int wave = threadIdx.x >> 6, lane = threadIdx.x & 63;
  f32x4 gv[4];
#pragma unroll
  for (int i = 0; i < 4; ++i) gv[i] = *(const f32x4*)(p.final_norm_g + (lane + 64 * i) * 4);
  const int stride = gridDim.x * 8;
  for (int rb = blockIdx.x * 8 + wave; rb < 32768; rb += stride * NR) {
    f32x4 v[NR][4];
#pragma unroll
    for (int q = 0; q < NR; ++q) {
      const int rr = rb + q * stride, r = rr < 32768 ? rr : 32767;
#pragma unroll
      for (int i = 0; i < 4; ++i) v[q][i] = ((const f32x4*)(p.out + (size_t)r * DM))[lane + 64 * i];
    }
#pragma unroll
    for (int q = 0; q < NR; ++q) {
      const int rr = rb + q * stride, r = rr < 32768 ? rr : 32767;
      const bool live = rr < 32768;
      float ss = 0.f;
#pragma unroll
      for (int i = 0; i < 4; ++i) ss += v[q][i][0] * v[q][i][0] + v[q][i][1] * v[q][i][1] + v[q][i][2] * v[q][i][2] + v[q][i][3] * v[q][i][3];
      ss = wave_sum(ss);
      const float rstd = rsqrtf(ss * (1.f / 1024.f) + 1e-6f);
#pragma unroll
      for (int i = 0; i < 4; ++i) {
        const int c = (lane + 64 * i) * 4;
        if (live) ((f32x4*)(p.out + (size_t)r * DM))[lane + 64 * i] = v[q][i] * rstd * gv[i];
      }
    }
  }
}

__device__ void phase_even_elem(const Params& p, const bf16_t* P, bf16_t* CAT, bf16_t* Kall) {
  const int wave = threadIdx.x >> 6, lane = threadIdx.x & 63;
  for (int r = blockIdx.x * 8 + wave; r < M_ALL; r += gridDim.x * 8) {
    int b, key; row_bk(r, b, key);
    const bool latent = r >= NCTX;
    const int t = latent ? ((r - NCTX) & 8191) : (r & 255), T = latent ? 8192 : 256;
    const int c0 = lane * 8;
    float cv[3][8];
#pragma unroll
    for (int dt = 0; dt < 3; ++dt) {
      const int tt = t + dt - 1;
      if (tt >= 0 && tt < T) {
        const bf16_t* pr = P + (size_t)(r + dt - 1) * 2048;
        u32x4 gc = *(const u32x4*)(pr + 512 + c0), vv = *(const u32x4*)(pr + 1024 + c0);
#pragma unroll
        for (int e = 0; e < 4; ++e) { cv[dt][2 * e] = lo2f(gc[e]) * lo2f(vv[e]); cv[dt][2 * e + 1] = hi2f(gc[e]) * hi2f(vv[e]); }
      } else {
#pragma unroll
        for (int e = 0; e < 8; ++e) cv[dt][e] = 0.f;
      }
    }
    u32x4 gb = *(const u32x4*)(P + (size_t)r * 2048 + c0);
    float o[8];
#pragma unroll
    for (int e = 0; e < 8; ++e) {
      const float w0 = p.even_conv_w[c0 + e], w1 = p.even_conv_w[512 + c0 + e], w2 = p.even_conv_w[1024 + c0 + e];
      const float g = (e & 1) ? hi2f(gb[e >> 1]) : lo2f(gb[e >> 1]);
      o[e] = g * (cv[0][e] * w0 + cv[1][e] * w1 + cv[2][e] * w2);
    }
    u32x4 ov; ov.x = pk2(o[0], o[1]); ov.y = pk2(o[2], o[3]); ov.z = pk2(o[4], o[5]); ov.w = pk2(o[6], o[7]);
    *(u32x4*)(CAT + (size_t)r * DM + c0) = ov;
    {
      const int d = lane & 31;
      float v = bf2f(P[(size_t)r * 2048 + 1920 + d]);
      const float pv = __shfl_xor(v, 8);
      const int idx = d & 15, fi = idx & 7;
      if (latent) {
        const float* rp = p.rope + ((size_t)t * 2 + (d >> 4)) * 16 + fi;
        const float cs = rp[0], sn = rp[8];
        v = (idx < 8) ? (v * cs - pv * sn) : (pv * sn + v * cs);
      }
      const bf16_t bv = f2bf(v);
      if (lane < 32) {
#pragma unroll
        for (int h = 0; h < 8; ++h) Kall[((size_t)(b * 8 + h) * NKEY + key) * 96 + 64 + d] = bv;
      }
    }
  }
}

__device__ void phase_attn_scalar(const Params& p, const bf16_t* Qall, const bf16_t* Kall, const bf16_t* Vt, bf16_t* CAT) {
  const int ql = threadIdx.x & 255, half = threadIdx.x >> 8;
  for (int it = blockIdx.x; it < 1056; it += gridDim.x) {
    int b, h, q0, nk;
    if (it < 1024) { b = it >> 8; h = (it >> 5) & 7; q0 = 256 + (it & 31) * 256; nk = NKEY; }
    else { const int i2 = it - 1024; b = i2 >> 3; h = i2 & 7; q0 = 0; nk = 256; }
    const int qi = q0 + ql;
    const size_t bh = (size_t)(b * 8 + h);
    float q[96];
    {
      const u32x4* qp = (const u32x4*)(Qall + (bh * NKEY + qi) * 96);
#pragma unroll
      for (int i = 0; i < 12; ++i) { u32x4 v = qp[i];
#pragma unroll
        for (int e = 0; e < 4; ++e) { q[8 * i + 2 * e] = lo2f(v[e]); q[8 * i + 2 * e + 1] = hi2f(v[e]); } }
    }
    float o[32];
#pragma unroll
    for (int i = 0; i < 32; ++i) o[i] = 0.f;
    float mrun = -1e30f, lrun = 0.f;
    for (int k0 = 0; k0 < nk; k0 += 4) {
      float s[4];
#pragma unroll
      for (int kk = 0; kk < 4; ++kk) {
        const u32x4* kp = (const u32x4*)(Kall + (bh * NKEY + k0 + kk) * 96);
        float a = 0.f;
#pragma unroll
        for (int i = 0; i < 12; ++i) { u32x4 v = kp[i];
#pragma unroll
          for (int e = 0; e < 4; ++e) a += q[8 * i + 2 * e] * lo2f(v[e]) + q[8 * i + 2 * e + 1] * hi2f(v[e]); }
        s[kk] = a;
      }
      const float mx = fmaxf(fmaxf(s[0], s[1]), fmaxf(s[2], s[3]));
      const float mnew = fmaxf(mrun, mx);
      const float alpha = exp2f(mrun - mnew);
      const float p0 = exp2f(s[0] - mnew), p1 = exp2f(s[1] - mnew), p2 = exp2f(s[2] - mnew), p3 = exp2f(s[3] - mnew);
      lrun = lrun * alpha + p0 + p1 + p2 + p3;
      mrun = mnew;
#pragma unroll
      for (int dv = 0; dv < 32; ++dv) {
        u32x2 v = *(const u32x2*)(Vt + (bh * 64 + half * 32 + dv) * NKEY + k0);
        o[dv] = o[dv] * alpha + p0 * lo2f(v.x) + p1 * hi2f(v.x) + p2 * lo2f(v.y) + p3 * hi2f(v.y);
      }
    }
    const float il = 1.f / lrun;
    const int r = qi < 256 ? b * 256 + qi : NCTX + b * 8192 + (qi - 256);
    u32x4* op = (u32x4*)(CAT + (size_t)r * DM + 512 + h * 64 + half * 32);
#pragma unroll
    for (int i = 0; i < 4; ++i) {
      u32x4 v; v.x = pk2(o[8 * i] * il, o[8 * i + 1] * il); v.y = pk2(o[8 * i + 2] * il, o[8 * i + 3] * il);
      v.z = pk2(o[8 * i + 4] * il, o[8 * i + 5] * il); v.w = pk2(o[8 * i + 6] * il, o[8 * i + 7] * il);
      op[i] = v;
    }
  }
}

typedef float f32x16 __attribute__((ext_vector_type(16)));
__device__ __forceinline__ float ex2(float x) { return __builtin_amdgcn_exp2f(x); }
__device__ void phase_attn(const Params& p, const bf16_t* Qall, const bf16_t* Kall, const bf16_t* Vt, bf16_t* CAT, LAS unsigned char* lds) {
  const int tid = threadIdx.x, w = __builtin_amdgcn_readfirstlane(tid >> 6), lane = tid & 63, r = lane & 31, hh = lane >> 5;
  constexpr int KROW = 104, VROW = 72;
  constexpr int KBYTES = 64 * KROW * 2, VBYTES = 64 * VROW * 2, BUF = KBYTES + VBYTES;
  unsigned soff[3];
#pragma unroll
  for (int j = 0; j < 3; ++j) {
    const int ci = (3 * w + j) * 64 + lane;
    if (3 * w + j < 13) { const int row = ci / 13, part = ci % 13; soff[j] = (unsigned)(row * 96 + (part < 12 ? part : 0) * 8) * 2u; }
    else { const int c2 = ci - 832, dv = c2 / 9, part = c2 % 9; soff[j] = (unsigned)((dv < 64 ? dv : 0) * NKEY + (part < 8 ? part : 0) * 8) * 2u; }
  }
#define ATT_STAGE(bufi, k0_) do { _Pragma("unroll") for (int j_ = 0; j_ < 3; ++j_) if (j_ == 0 || w < 7) { \
    const char* g_ = (3 * w + j_ < 13) ? (const char*)kbase + soff[j_] + (size_t)(k0_) * 192 : (const char*)vbase + soff[j_] + (size_t)(k0_) * 2; \
    __builtin_amdgcn_global_load_lds((const unsigned*)g_, (LAS unsigned*)(lds + (bufi) * BUF + (3 * w + j_) * 1024), 16, 0, 0); } } while (0)
  for (int it = blockIdx.x; it < 544; it += gridDim.x) {
    int b, h, q0, nk, nq;
    if (it < 512) { b = it >> 7; h = (it >> 4) & 7; q0 = 256 + (it & 15) * 512; nk = NKEY; nq = 512; }
    else { const int i2 = it - 512; b = i2 >> 3; h = i2 & 7; q0 = 0; nk = 256; nq = 256; }
    const size_t bh = (size_t)(b * 8 + h);
    const int qw = 64 * w;
    const bool wact = qw < nq;
    const int qbase = q0 + (wact ? qw : 0) + r;
    bf16x8 qf[2][6];
#pragma unroll
    for (int qb = 0; qb < 2; ++qb) {
      const bf16_t* qp = Qall + (bh * NKEY + qbase + 32 * qb) * 96 + 8 * hh;
#pragma unroll
      for (int c = 0; c < 6; ++c) qf[qb][c] = *(const bf16x8*)(qp + 16 * c);
    }
    f32x16 o[2][2];
#pragma unroll
    for (int qb = 0; qb < 2; ++qb)
#pragma unroll
      for (int i = 0; i < 16; ++i) { o[qb][0][i] = 0.f; o[qb][1][i] = 0.f; }
    float mrun[2] = {0.f, 0.f}, lrun[2] = {0.f, 0.f};
    const bf16_t* kbase = Kall + bh * NKEY * 96;
    const bf16_t* vbase = Vt + bh * 64 * NKEY;
    ATT_STAGE(0, 0);
    asm volatile("s_waitcnt vmcnt(0)" ::: "memory");
    __syncthreads();
    const int ntile = nk >> 6;
    for (int i = 0; i < ntile; ++i) {
      const bool more = (i + 1 < ntile);
      if (more) ATT_STAGE((i + 1) & 1, (i + 1) * 64);
      LAS unsigned char* kb_ = lds + (i & 1) * BUF;
      LAS unsigned char* vb_ = kb_ + KBYTES;
      f32x16 s[2][2];
#pragma unroll
      for (int qb = 0; qb < 2; ++qb)
#pragma unroll
        for (int e = 0; e < 16; ++e) { s[qb][0][e] = 0.f; s[qb][1][e] = 0.f; }
#pragma unroll
      for (int c = 0; c < 6; ++c) {
        const bf16x8 ka = *(const LAS bf16x8*)(kb_ + (r * KROW + 16 * c + 8 * hh) * 2);
        const bf16x8 kb2 = *(const LAS bf16x8*)(kb_ + ((32 + r) * KROW + 16 * c + 8 * hh) * 2);
#pragma unroll
        for (int qb = 0; qb < 2; ++qb) {
          s[qb][0] = __builtin_amdgcn_mfma_f32_32x32x16_bf16(ka, qf[qb][c], s[qb][0], 0, 0, 0);
          s[qb][1] = __builtin_amdgcn_mfma_f32_32x32x16_bf16(kb2, qf[qb][c], s[qb][1], 0, 0, 0);
        }
      }
#pragma unroll
      for (int qb = 0; qb < 2; ++qb) {
        float mx = fmaxf(s[qb][0][0], s[qb][1][0]);
#pragma unroll
        for (int e = 1; e < 16; ++e) mx = fmaxf(mx, fmaxf(s[qb][0][e], s[qb][1][e]));
        mx = fmaxf(mx, __shfl_xor(mx, 32));
        const bool need = (i == 0) || (mx - mrun[qb] > 8.f);
        if (__builtin_amdgcn_ballot_w64(need) != 0ull) {
          const float nm = need ? mx : mrun[qb];
          const float alpha = (i == 0) ? 1.f : ex2(mrun[qb] - nm);
          mrun[qb] = nm; lrun[qb] *= alpha;
#pragma unroll
          for (int e = 0; e < 16; ++e) { o[qb][0][e] *= alpha; o[qb][1][e] *= alpha; }
        }
        f32x2 ps2 = {0.f, 0.f};
        const f32x2 m2 = {mrun[qb], mrun[qb]};
#pragma unroll
        for (int kb = 0; kb < 2; ++kb)
#pragma unroll
          for (int e = 0; e < 16; e += 2) {
            f32x2 t = {s[qb][kb][e], s[qb][kb][e + 1]};
            t = t - m2;
            t.x = ex2(t.x); t.y = ex2(t.y);
            ps2 += t;
            s[qb][kb][e] = t.x; s[qb][kb][e + 1] = t.y;
          }
        lrun[qb] += ps2.x + ps2.y;
      }
#pragma unroll
      for (int kb = 0; kb < 2; ++kb)
#pragma unroll
        for (int t = 0; t < 2; ++t) {
          const int kofs = 32 * kb + 16 * t + 4 * hh;
          u32x4 va, vb2;
          { const u32x2 lo = *(const LAS u32x2*)(vb_ + (r * VROW + kofs) * 2), hi = *(const LAS u32x2*)(vb_ + (r * VROW + kofs + 8) * 2); va.x = lo.x; va.y = lo.y; va.z = hi.x; va.w = hi.y; }
          { const u32x2 lo = *(const LAS u32x2*)(vb_ + ((32 + r) * VROW + kofs) * 2), hi = *(const LAS u32x2*)(vb_ + ((32 + r) * VROW + kofs + 8) * 2); vb2.x = lo.x; vb2.y = lo.y; vb2.z = hi.x; vb2.w = hi.y; }
#pragma unroll
          for (int qb = 0; qb < 2; ++qb) {
            u32x4 pw;
            pw.x = pk2(s[qb][kb][8 * t], s[qb][kb][8 * t + 1]); pw.y = pk2(s[qb][kb][8 * t + 2], s[qb][kb][8 * t + 3]);
            pw.z = pk2(s[qb][kb][8 * t + 4], s[qb][kb][8 * t + 5]); pw.w = pk2(s[qb][kb][8 * t + 6], s[qb][kb][8 * t + 7]);
            const bf16x8 pf = __builtin_bit_cast(bf16x8, pw);
            o[qb][0] = __builtin_amdgcn_mfma_f32_32x32x16_bf16(__builtin_bit_cast(bf16x8, va), pf, o[qb][0], 0, 0, 0);
            o[qb][1] = __builtin_amdgcn_mfma_f32_32x32x16_bf16(__builtin_bit_cast(bf16x8, vb2), pf, o[qb][1], 0, 0, 0);
          }
        }
      asm volatile("s_waitcnt vmcnt(0)" ::: "memory");
      __syncthreads();
    }
    if (wact) {
#pragma unroll
      for (int qb = 0; qb < 2; ++qb) {
        float l = lrun[qb]; l += __shfl_xor(l, 32);
        const float il = 1.f / l;
        const int qi = qbase + 32 * qb;
        const int row = qi < 256 ? b * 256 + qi : NCTX + b * 8192 + (qi - 256);
        bf16_t* op = CAT + (size_t)row * DM + 512 + h * 64 + 4 * hh;
#pragma unroll
        for (int g = 0; g < 4; ++g) {
          u32x2 a; a.x = pk2(o[qb][0][4 * g] * il, o[qb][0][4 * g + 1] * il); a.y = pk2(o[qb][0][4 * g + 2] * il, o[qb][0][4 * g + 3] * il);
          *(u32x2*)(op + 8 * g) = a;
          u32x2 c; c.x = pk2(o[qb][1][4 * g] * il, o[qb][1][4 * g + 1] * il); c.y = pk2(o[qb][1][4 * g + 2] * il, o[qb][1][4 * g + 3] * il);
          *(u32x2*)(op + 32 + 8 * g) = c;
        }
      }
    }
  }
}
#undef ATT_STAGE

__device__ void phase_hgrn_scalar(const Params& p, int dir, const bf16_t* Qh, const bf16_t* Vv, const bf16_t* Gg, const _Float16* Lx, bf16_t* O, float* sm) {
  float* sf = sm; float* sk = sm + 128; float* sq = sm + 256; float* part = sm + 384;   float* red = sm + 896;
  const int tid = threadIdx.x, dv = tid & 127, kg = tid >> 7;
  for (int it = blockIdx.x; it < 32; it += gridDim.x) {
    const int b = it >> 3, h = it & 7;
    float S[32];
#pragma unroll
    for (int i = 0; i < 32; ++i) S[i] = 0.f;
    for (int n = 0; n < NKEY; ++n) {
      int r; bool latent = n >= 256;
      if (!latent) r = b * 256 + (dir == 0 ? n : 255 - n);
      else r = NCTX + b * 8192 + (dir == 0 ? (n - 256) : (8191 - (n - 256)));
      const size_t off = (size_t)r * DM + h * 128;
      if (tid < 128) {
        const float f = __expf((float)Lx[off + tid]);
        sf[tid] = f; sk[tid] = 1.f - f; sq[tid] = bf2f(Qh[off + tid]);
      }
      __syncthreads();
      const float v = bf2f(Vv[off + dv]);
      float po = 0.f;
#pragma unroll
      for (int i = 0; i < 32; ++i) { const int dk = kg * 32 + i; S[i] = sf[dk] * S[i] + sk[dk] * v; po += S[i] * sq[dk]; }
      if (latent) {
        part[kg * 128 + dv] = po;
        __syncthreads();
        if (tid < 128) {
          float o = part[tid] + part[128 + tid] + part[256 + tid] + part[384 + tid];
          if (dir == 0) O[off + tid] = f2bf(o);
          else {
            o += bf2f(O[off + tid]);
            float ss = wave_sum(o * o);
            if ((tid & 63) == 0) red[tid >> 6] = ss;
            part[tid] = o;
          }
        }
        __syncthreads();
        if (dir == 1 && tid < 128) {
          const float o = part[tid];
          const float rstd = rsqrtf((red[0] + red[1]) * (1.f / 128.f) + 1e-6f);
          const float g = bf2f(Gg[off + tid]);
          O[off + tid] = f2bf(o * rstd * p.g_norm_g[tid] * g * sigmoidf_(g));
        }
      }
      __syncthreads();
    }
  }
}

template <bool OUT>
__device__ void phase_hgrn(const Params& p, const bf16_t* Qh, const bf16_t* Vv, const _Float16* Lfb, bf16_t* Of, bf16_t* Ob, float* Sseg, float* Dlog, LAS unsigned char* lds) {
  constexpr int NSEG = 4, CPS = 33, NIT = OUT ? 64 * NSEG : 64 * (NSEG - 1);
  constexpr int QT = 0, KT = QT + 64 * 136 * 2, KE = KT + 64 * 136 * 2, VT = KE + 128 * 72 * 2, AT = VT + 128 * 72 * 2,
                ST = AT + 64 * 72 * 2, DC = ST + 128 * 136 * 2, TOT = DC + 512;
  const int tid = threadIdx.x, w = tid >> 6, lane = tid & 63, r = lane & 31, hh = lane >> 5;
  const int dk = tid & 127, tq = tid >> 7;
  const int dvb = w & 3, wh = w >> 2;
  for (int it = blockIdx.x; it < NIT; it += gridDim.x) {
    const int bhd = OUT ? it >> 2 : it / 3, sg = OUT ? it & 3 : it % 3;
    const int b = bhd >> 4, h = (bhd >> 1) & 7, dir = bhd & 1;
    const int c_begin = sg * CPS, c_end = c_begin + CPS;
    const _Float16* Lx = Lfb + (size_t)dir * ((size_t)M_ALL * DM);
    const int sgn = dir ? -1 : 1;
    f32x16 S0, S1;
#pragma unroll
    for (int e = 0; e < 16; ++e) { S0[e] = 0.f; S1[e] = 0.f; }
    if constexpr (OUT) {
      for (int sp = 0; sp < sg; ++sp) {
        const float* sp_ = Sseg + ((size_t)(bhd * 3 + sp) * 8 + w) * 2048;
        const float* dl = Dlog + (size_t)(bhd * 3 + sp) * 128;
#pragma unroll
        for (int g = 0; g < 4; ++g) {
          const f32x4 d0 = *(const f32x4*)(dl + 32 * (2 * wh) + 8 * g + 4 * hh), d1 = *(const f32x4*)(dl + 32 * (2 * wh + 1) + 8 * g + 4 * hh);
#pragma unroll
          for (int j = 0; j < 4; ++j) {
            S0[4 * g + j] = S0[4 * g + j] * __expf(d0[j]) + sp_[(4 * g + j) * 64 + lane];
            S1[4 * g + j] = S1[4 * g + j] * __expf(d1[j]) + sp_[1024 + (4 * g + j) * 64 + lane];
          }
        }
      }
#pragma unroll
      for (int g = 0; g < 4; ++g) {
        u32x2 a0; a0.x = pk2(S0[4 * g], S0[4 * g + 1]); a0.y = pk2(S0[4 * g + 2], S0[4 * g + 3]);
        *(LAS u32x2*)(lds + ST + ((32 * dvb + r) * 136 + 32 * (2 * wh) + 8 * g + 4 * hh) * 2) = a0;
        u32x2 a1; a1.x = pk2(S1[4 * g], S1[4 * g + 1]); a1.y = pk2(S1[4 * g + 2], S1[4 * g + 3]);
        *(LAS u32x2*)(lds + ST + ((32 * dvb + r) * 136 + 32 * (2 * wh + 1) + 8 * g + 4 * hh) * 2) = a1;
      }
    }
    float dsum = 0.f;
    _Float16 lfr[16]; bf16_t qr[16], vr[16];
    {
      const int cn = c_begin;
      const int rb0 = (cn < 4) ? b * 256 + (dir ? 255 - 64 * cn : 64 * cn) : NCTX + b * 8192 + (dir ? 8191 - 64 * (cn - 4) : 64 * (cn - 4));
      const size_t o0 = (size_t)(rb0 + sgn * 16 * tq) * DM + h * 128 + dk;
#pragma unroll
      for (int i = 0; i < 16; ++i) { const size_t o = o0 + (ptrdiff_t)(sgn * i) * DM; lfr[i] = Lx[o]; if constexpr (OUT) qr[i] = Qh[o]; else qr[i] = 0; vr[i] = Vv[o]; }
    }
    __syncthreads();
    for (int c = c_begin; c < c_end; ++c) {
      const int rbase = (c < 4) ? b * 256 + (dir ? 255 - 64 * c : 64 * c) : NCTX + b * 8192 + (dir ? 8191 - 64 * (c - 4) : 64 * (c - 4));
      float lf[16], cs[16];
      float run = 0.f;
#pragma unroll
      for (int i = 0; i < 16; ++i) { lf[i] = (float)lfr[i]; run += lf[i]; cs[i] = run; }
      *(LAS float*)(lds + TOT + (tq * 128 + dk) * 4) = run;
      __syncthreads();
      float offs = 0.f, blast = 0.f;
#pragma unroll
      for (int g = 0; g < 4; ++g) { const float t = *(const LAS float*)(lds + TOT + (g * 128 + dk) * 4); blast += t; if (g < tq) offs += t; }
      {
        const float eblast = __expf(blast);
        unsigned kew[8], vw[8];
#pragma unroll
        for (int i = 0; i < 16; i += 2) {
          float qt[2], kt[2], ke[2];
#pragma unroll
          for (int e = 0; e < 2; ++e) {
            const float bb = offs + cs[i + e];
            const float k = 1.f - __expf(lf[i + e]);
            const float ken = k * __expf(-bb);
            if constexpr (OUT) { qt[e] = bf2f(qr[i + e]) * __expf(bb); kt[e] = ken; }
            ke[e] = ken * eblast;
          }
          if constexpr (OUT) {
            const unsigned qp = pk2(qt[0], qt[1]), kp = pk2(kt[0], kt[1]);
            const int s = 16 * tq + i;
            *(LAS bf16_t*)(lds + QT + (s * 136 + dk) * 2) = (bf16_t)(qp & 0xffffu);
            *(LAS bf16_t*)(lds + QT + ((s + 1) * 136 + dk) * 2) = (bf16_t)(qp >> 16);
            *(LAS bf16_t*)(lds + KT + (s * 136 + dk) * 2) = (bf16_t)(kp & 0xffffu);
            *(LAS bf16_t*)(lds + KT + ((s + 1) * 136 + dk) * 2) = (bf16_t)(kp >> 16);
          }
          kew[i >> 1] = pk2(ke[0], ke[1]);
          vw[i >> 1] = (unsigned)vr[i] | ((unsigned)vr[i + 1] << 16);
        }
        *(LAS u32x4*)(lds + KE + (dk * 72 + 16 * tq) * 2) = (u32x4){kew[0], kew[1], kew[2], kew[3]};
        *(LAS u32x4*)(lds + KE + (dk * 72 + 16 * tq + 8) * 2) = (u32x4){kew[4], kew[5], kew[6], kew[7]};
        *(LAS u32x4*)(lds + VT + (dk * 72 + 16 * tq) * 2) = (u32x4){vw[0], vw[1], vw[2], vw[3]};
        *(LAS u32x4*)(lds + VT + (dk * 72 + 16 * tq + 8) * 2) = (u32x4){vw[4], vw[5], vw[6], vw[7]};
        if (tq == 0) *(LAS float*)(lds + DC + dk * 4) = eblast;
        dsum += blast;
      }
      __syncthreads();
      if (c + 1 < c_end) {
        const int cn = c + 1;
        const int rb = (cn < 4) ? b * 256 + (dir ? 255 - 64 * cn : 64 * cn) : NCTX + b * 8192 + (dir ? 8191 - 64 * (cn - 4) : 64 * (cn - 4));
        const size_t o0 = (size_t)(rb + sgn * 16 * tq) * DM + h * 128 + dk;
#pragma unroll
        for (int i = 0; i < 16; ++i) { const size_t o = o0 + (ptrdiff_t)(sgn * i) * DM; lfr[i] = Lx[o]; if constexpr (OUT) qr[i] = Qh[o]; else qr[i] = 0; vr[i] = Vv[o]; }
      }
      if (OUT && w < 3) {
        const int sb = (w == 2) ? 1 : 0, tb = (w == 0) ? 0 : 1;
        f32x16 a;
#pragma unroll
        for (int e = 0; e < 16; ++e) a[e] = 0.f;
#pragma unroll
        for (int ks = 0; ks < 8; ++ks) {
          const bf16x8 ka = *(const LAS bf16x8*)(lds + KT + ((32 * sb + r) * 136 + 16 * ks + 8 * hh) * 2);
          const bf16x8 qb = *(const LAS bf16x8*)(lds + QT + ((32 * tb + r) * 136 + 16 * ks + 8 * hh) * 2);
          a = __builtin_amdgcn_mfma_f32_32x32x16_bf16(ka, qb, a, 0, 0, 0);
        }
        const int tok = 32 * tb + r;
#pragma unroll
        for (int g = 0; g < 4; ++g) {
          const int s0 = 32 * sb + 8 * g + 4 * hh;
          const float v0 = (s0 + 0 <= tok) ? a[4 * g + 0] : 0.f, v1 = (s0 + 1 <= tok) ? a[4 * g + 1] : 0.f;
          const float v2 = (s0 + 2 <= tok) ? a[4 * g + 2] : 0.f, v3 = (s0 + 3 <= tok) ? a[4 * g + 3] : 0.f;
          u32x2 o; o.x = pk2(v0, v1); o.y = pk2(v2, v3);
          *(LAS u32x2*)(lds + AT + (tok * 72 + s0) * 2) = o;
        }
      }
      {
#pragma unroll
        for (int g = 0; g < 4; ++g) {
          const f32x4 d0 = *(const LAS f32x4*)(lds + DC + (32 * (2 * wh) + 8 * g + 4 * hh) * 4);
          const f32x4 d1 = *(const LAS f32x4*)(lds + DC + (32 * (2 * wh + 1) + 8 * g + 4 * hh) * 4);
#pragma unroll
          for (int j = 0; j < 4; ++j) { S0[4 * g + j] *= d0[j]; S1[4 * g + j] *= d1[j]; }
        }
#pragma unroll
        for (int ks = 0; ks < 4; ++ks) {
          const bf16x8 vb = *(const LAS bf16x8*)(lds + VT + ((32 * dvb + r) * 72 + 16 * ks + 8 * hh) * 2);
          const bf16x8 k0 = *(const LAS bf16x8*)(lds + KE + ((32 * (2 * wh) + r) * 72 + 16 * ks + 8 * hh) * 2);
          const bf16x8 k1 = *(const LAS bf16x8*)(lds + KE + ((32 * (2 * wh + 1) + r) * 72 + 16 * ks + 8 * hh) * 2);
          S0 = __builtin_amdgcn_mfma_f32_32x32x16_bf16(k0, vb, S0, 0, 0, 0);
          S1 = __builtin_amdgcn_mfma_f32_32x32x16_bf16(k1, vb, S1, 0, 0, 0);
        }
      }
      if constexpr (OUT) {
      __syncthreads();
      {
        const int tb = wh;
        f32x16 o;
#pragma unroll
        for (int e = 0; e < 16; ++e) o[e] = 0.f;
#pragma unroll
        for (int ks = 0; ks < 4; ++ks) {
          if (ks < 2 * (tb + 1)) {
            const bf16x8 va = *(const LAS bf16x8*)(lds + VT + ((32 * dvb + r) * 72 + 16 * ks + 8 * hh) * 2);
            const bf16x8 ab = *(const LAS bf16x8*)(lds + AT + ((32 * tb + r) * 72 + 16 * ks + 8 * hh) * 2);
            o = __builtin_amdgcn_mfma_f32_32x32x16_bf16(va, ab, o, 0, 0, 0);
          }
        }
#pragma unroll
        for (int ks = 0; ks < 8; ++ks) {
          const bf16x8 sa = *(const LAS bf16x8*)(lds + ST + ((32 * dvb + r) * 136 + 16 * ks + 8 * hh) * 2);
          const bf16x8 qb = *(const LAS bf16x8*)(lds + QT + ((32 * tb + r) * 136 + 16 * ks + 8 * hh) * 2);
          o = __builtin_amdgcn_mfma_f32_32x32x16_bf16(sa, qb, o, 0, 0, 0);
        }
        if (c >= 4) {
          const int row = rbase + sgn * (32 * tb + r);
          bf16_t* op = (dir ? Ob + (size_t)(row - NCTX) * DM : Of + (size_t)row * DM) + h * 128 + 32 * dvb + 4 * hh;
#pragma unroll
          for (int g = 0; g < 4; ++g) {
            u32x2 ov; ov.x = pk2(o[4 * g], o[4 * g + 1]); ov.y = pk2(o[4 * g + 2], o[4 * g + 3]);
            *(u32x2*)(op + 8 * g) = ov;
          }
        }
      }
      __syncthreads();
#pragma unroll
      for (int g = 0; g < 4; ++g) {
        u32x2 a0; a0.x = pk2(S0[4 * g], S0[4 * g + 1]); a0.y = pk2(S0[4 * g + 2], S0[4 * g + 3]);
        *(LAS u32x2*)(lds + ST + ((32 * dvb + r) * 136 + 32 * (2 * wh) + 8 * g + 4 * hh) * 2) = a0;
        u32x2 a1; a1.x = pk2(S1[4 * g], S1[4 * g + 1]); a1.y = pk2(S1[4 * g + 2], S1[4 * g + 3]);
        *(LAS u32x2*)(lds + ST + ((32 * dvb + r) * 136 + 32 * (2 * wh + 1) + 8 * g + 4 * hh) * 2) = a1;
      }
      }
    }
    if constexpr (!OUT) {
      float* sp_ = Sseg + ((size_t)(bhd * 3 + sg) * 8 + w) * 2048;
#pragma unroll
      for (int e = 0; e < 16; ++e) { sp_[e * 64 + lane] = S0[e]; sp_[1024 + e * 64 + lane] = S1[e]; }
      if (tq == 0) Dlog[(size_t)(bhd * 3 + sg) * 128 + dk] = dsum;
    }
    __syncthreads();
  }
}

__device__ void phase_hgrn_readout(const Params& p, bf16_t* Of, const bf16_t* Ob, const bf16_t* Gg) {
  const int wave = threadIdx.x >> 6, lane = threadIdx.x & 63;
  for (int r = NCTX + blockIdx.x * 8 + wave; r < M_ALL; r += gridDim.x * 8) {
    const int c0 = lane * 16;
    float o[16];
#pragma unroll
    for (int i = 0; i < 2; ++i) {
      const u32x4 a = *(const u32x4*)(Of + (size_t)r * DM + c0 + 8 * i), bq = *(const u32x4*)(Ob + (size_t)(r - NCTX) * DM + c0 + 8 * i);
#pragma unroll
      for (int e = 0; e < 4; ++e) { o[8 * i + 2 * e] = lo2f(a[e]) + lo2f(bq[e]); o[8 * i + 2 * e + 1] = hi2f(a[e]) + hi2f(bq[e]); }
    }
    float ss = 0.f;
#pragma unroll
    for (int i = 0; i < 16; ++i) ss += o[i] * o[i];
    ss += __shfl_xor(ss, 1); ss += __shfl_xor(ss, 2); ss += __shfl_xor(ss, 4);
    const float rstd = rsqrtf(ss * (1.f / 128.f) + 1e-6f);
    const int cg = c0 & 127;
#pragma unroll
    for (int i = 0; i < 2; ++i) {
      const u32x4 gq = *(const u32x4*)(Gg + (size_t)r * DM + c0 + 8 * i);
      float y[8];
#pragma unroll
      for (int e = 0; e < 8; ++e) {
        const float g = (e & 1) ? hi2f(gq[e >> 1]) : lo2f(gq[e >> 1]);
        y[e] = o[8 * i + e] * rstd * p.g_norm_g[cg + 8 * i + e] * g * sigmoidf_(g);
      }
      u32x4 ov; ov.x = pk2(y[0], y[1]); ov.y = pk2(y[2], y[3]); ov.z = pk2(y[4], y[5]); ov.w = pk2(y[6], y[7]);
      *(u32x4*)(Of + (size_t)r * DM + c0 + 8 * i) = ov;
    }
  }
}

#define XB_TMO      128
#define XB_XCNT(j)  (256  + 64 * (j))
#define XB_XSUB(j)  (1280 + 64 * (j))
#define XB_XGEN(j)  (2304 + 64 * (j))
#define XB_TOP      3328
#define XB_TOPGEN   3392
#define XCD_BAR_WORDS 3456
#define XB_SPIN_CAP (1u << 22)
__device__ __forceinline__ unsigned xb_ld(unsigned* p)              { return __hip_atomic_load(p, __ATOMIC_RELAXED, __HIP_MEMORY_SCOPE_AGENT); }
__device__ __forceinline__ unsigned xb_add(unsigned* p, unsigned v) { return __hip_atomic_fetch_add(p, v, __ATOMIC_RELAXED, __HIP_MEMORY_SCOPE_AGENT); }
__device__ __forceinline__ unsigned xb_xcc_id() { return (unsigned)__builtin_amdgcn_s_getreg((3 << 11) | 20) & 0xFu; }
#define XB_SPIN(cond, bar) do { unsigned _sp = 0; while (cond) { __builtin_amdgcn_s_sleep(1); \
    if ((++_sp & 255u) == 0u) { if (xb_ld(&(bar)[XB_TMO])) break; if (_sp > XB_SPIN_CAP) { atomicAdd(&(bar)[XB_TMO], 1u); break; } } } } while (0)
__device__ __forceinline__ void xcd_barrier_complete(unsigned* bar, unsigned x, unsigned& nloc, unsigned& nx) {
  const unsigned G = gridDim.x * gridDim.y * gridDim.z;
  unsigned sum, cnt, mine, sp = 0u;
  for (;;) {
    sum = 0u; cnt = 0u; mine = 0u;
#pragma unroll
    for (unsigned j = 0; j < 16; ++j) { const unsigned c = xb_ld(&bar[XB_XCNT(j)]); sum += c; cnt += (c > 0u) ? 1u : 0u; mine = (j == x) ? c : mine; }
    if (sum == G) break;
    __builtin_amdgcn_s_sleep(1);
    if ((++sp & 255u) == 0u) { if (xb_ld(&bar[XB_TMO])) break; if (sp > XB_SPIN_CAP) { atomicAdd(&bar[XB_TMO], 1u); break; } }
  }
  nloc = mine > 0u ? mine : 1u; nx = cnt > 0u ? cnt : 1u;
}
__device__ __forceinline__ void xcd_barrier(unsigned* bar, volatile LAS unsigned* st) {
  asm volatile("s_waitcnt vmcnt(0)" ::: "memory");
  __syncthreads();
  if (threadIdx.x == 0) {
    const unsigned x = xb_xcc_id();
    __builtin_amdgcn_s_waitcnt(0);
    unsigned nloc = st[0], nx = st[1];
    if (nloc == 0u) { xcd_barrier_complete(bar, x, nloc, nx); st[0] = nloc; st[1] = nx; }
    const unsigned old = xb_add(&bar[XB_XSUB(x)], 1u);
    const unsigned gen = old / nloc;
    if (old + 1u == (gen + 1u) * nloc) {
      __builtin_amdgcn_fence(__ATOMIC_RELEASE, "agent");
      asm volatile("s_waitcnt vmcnt(0)" ::: "memory");
      const unsigned og = xb_add(&bar[XB_TOP], 1u);
      const unsigned tg = og / nx;
      if (og + 1u == (tg + 1u) * nx) xb_add(&bar[XB_TOPGEN], 1u);
      else XB_SPIN(xb_ld(&bar[XB_TOPGEN]) == tg, bar);
      __builtin_amdgcn_fence(__ATOMIC_ACQUIRE, "agent");
      xb_add(&bar[XB_XGEN(x)], 1u);
      asm volatile("s_waitcnt vmcnt(0)" ::: "memory");
    } else {
      XB_SPIN(xb_ld(&bar[XB_XGEN(x)]) == gen, bar);
      __builtin_amdgcn_fence(__ATOMIC_ACQUIRE, "agent");
      asm volatile("s_waitcnt vmcnt(0)" ::: "memory");
    }
  }
  __syncthreads();
}


template <int PH>
__device__ __forceinline__ void run_phase(const Params& p, bf16_t* shm_) {
  float* smf = (float*)shm_;
  LAS unsigned char* shm = (LAS unsigned char*)shm_;
  const size_t MR = (size_t)M_ALL;
  bf16_t* G = (bf16_t*)p.R;
  bf16_t* P = (bf16_t*)p.R;
  bf16_t* Qall = P + MR * 2048;
  bf16_t* Kall = Qall + (size_t)32 * NKEY * 96;
  bf16_t* Vt = Kall + (size_t)32 * NKEY * 96;
  bf16_t* Qh = (bf16_t*)p.R;
  bf16_t* Vv = Qh + MR * DM;
  bf16_t* Gg = Vv + MR * DM;
  _Float16* Lf = (_Float16*)(Gg + MR * DM);
  _Float16* Lb = Lf + MR * DM;
  const size_t MODL = (size_t)5 * 9216;
  float* PARTF = (float*)(G + MR * DFF);
  float* PARTE = (float*)(Vt + (size_t)32 * 64 * NKEY);
  const float* CG = p.mod + (size_t)4 * 9 * 1024;
  if constexpr (PH == 0) phase_prep(p, smf);
  if constexpr (PH == 1) phase_norm(p, 0, 0, p.ctx, p.x, 0);
  if constexpr (PH == 2) gemm_phase(p.U, DM, p.W13[0], DM, DM, 0, 132, 0, 22, EpiSwiglu{G}, shm);
  if constexpr (PH == 3) gemm_phase(G, DFF, p.W2[0], DFF, DFF, 4, 128, 0, 4, EpiResid{p.ctx, p.x, p.XC, p.out, p.mod + 2 * 1024, 0.5f}, shm, 4, 11, EpiPart{PARTF});
  if constexpr (PH == 4) phase_norm(p, 0, 1, p.ctx, p.out, 0, PARTF, 11, 0.5f, CG + 2 * 1024);
  if constexpr (PH == 5) gemm_phase(p.U, DM, p.WinE, DM, DM, 0, 132, 0, 8, EpiP{P, p.RS}, shm);
  if constexpr (PH == 6) { gemm_phase(P + 1536, 2048, p.Wqkv, 2048, 384, 0, 132, 0, 7, EpiQKV{EpiQ{p.RS, p.rope, Qall}, EpiKV{p.RS, Kall, Vt}}, shm);
                           phase_even_elem(p, P, p.U, Kall); }
  if constexpr (PH == 7) phase_attn(p, Qall, Kall, Vt, p.U, shm);
  if constexpr (PH == 8) gemm_phase(p.U, DM, p.WoutE, DM, DM, 4, 128, 0, 4, EpiResid{p.XC, p.out, p.XC, p.out, p.mod + 5 * 1024, 1.0f}, shm, 4, 4, EpiPart{PARTE});
  if constexpr (PH == 9) phase_norm(p, 0, 2, p.XC, p.out, 0, PARTE, 4, 1.0f, CG + 5 * 1024);
  if constexpr (PH == 10) gemm_phase(p.U, DM, p.W13[1], DM, DM, 0, 132, 0, 22, EpiSwiglu{G}, shm);
  if constexpr (PH == 11) gemm_phase(G, DFF, p.W2[1], DFF, DFF, 4, 128, 0, 4, EpiResid{p.XC, p.out, p.XC, p.out, p.mod + 8 * 1024, 0.5f}, shm, 4, 11, EpiPart{PARTF});
  if constexpr (PH == 12) phase_norm(p, 1, 0, p.XC, p.out, 0, PARTF, 11, 0.5f, CG + 8 * 1024);
  if constexpr (PH == 13) gemm_phase(p.U, DM, p.W13[2], DM, DM, 0, 132, 0, 22, EpiSwiglu{G}, shm);
  if constexpr (PH == 14) gemm_phase(G, DFF, p.W2[2], DFF, DFF, 4, 128, 0, 4, EpiResid{p.XC, p.out, p.XC, p.out, p.mod + MODL + 2 * 1024, 0.5f}, shm, 4, 11, EpiPart{PARTF});
  if constexpr (PH == 15) phase_norm(p, 1, 1, p.XC, p.out, 0, PARTF, 11, 0.5f, CG + MODL + 2 * 1024);
  if constexpr (PH == 16) gemm_phase(p.U, DM, p.WinO, DM, DM, 0, 132, 0, 20, EpiOdd{Qh, Vv, Gg, Lf, Lb, p.lb_logits}, shm);
  bf16_t* Ob = (bf16_t*)(Lb + MR * DM);
  float* Sseg = (float*)(Ob + (size_t)32768 * DM);
  float* Dlg = Sseg + (size_t)192 * 16384;
  if constexpr (PH == 17) phase_hgrn<false>(p, Qh, Vv, Lf, p.U, Ob, Sseg, Dlg, shm);
  if constexpr (PH == 18) phase_hgrn<true>(p, Qh, Vv, Lf, p.U, Ob, Sseg, Dlg, shm);
  if constexpr (PH == 24) phase_hgrn_readout(p, p.U, Ob, Gg);
  if constexpr (PH == 19) gemm_phase(p.U, DM, p.WoutO, DM, DM, 4, 128, 0, 4, EpiResid{p.XC, p.out, p.XC, p.out, p.mod + MODL + 5 * 1024, 1.0f}, shm);
  if constexpr (PH == 20) phase_norm(p, 1, 2, p.XC, p.out, NCTX);
  if constexpr (PH == 21) gemm_phase(p.U, DM, p.W13[3], DM, DM, 4, 128, 0, 22, EpiSwiglu{G}, shm);
  if constexpr (PH == 22) gemm_phase(G, DFF, p.W2[3], DFF, DFF, 4, 128, 0, 4, EpiResid{p.XC, p.out, p.XC, p.out, p.mod + MODL + 8 * 1024, 0.5f}, shm);
  if constexpr (PH == 23) phase_final_norm(p);
}

constexpr int N_PHASES = 24;

#define PROBE_DUP -1
template <int PH>
__device__ __forceinline__ void step(const Params& p, int ph0, int ph1, bf16_t* shm) {
  if ((ph0 <= PH && PH < ph1) || (PH == 24 && ph1 - ph0 > 1)) {
    run_phase<PH>(p, shm);
    if constexpr (PH == PROBE_DUP) { xcd_barrier(p.bar, (volatile LAS unsigned*)((LAS unsigned char*)shm + SHM_B)); run_phase<PH>(p, shm); }
    if (PH != 23 && ph1 - ph0 > 1) xcd_barrier(p.bar, (volatile LAS unsigned*)((LAS unsigned char*)shm + SHM_B));
  }
}

__global__ void __launch_bounds__(NTHR, 2) mega(Params p, int ph0, int ph1) {
  extern __shared__ __attribute__((aligned(16))) bf16_t shm[];
  if (ph1 < 0) cg::this_grid().sync();
  {
    volatile LAS unsigned* st = (volatile LAS unsigned*)((LAS unsigned char*)shm + SHM_B);
    if (threadIdx.x == 0) { st[0] = 0u; st[1] = 0u; }
    __syncthreads();
    if (threadIdx.x == 0) (void)xb_add(&p.bar[XB_XCNT(xb_xcc_id())], 1u);
  }
  step<0>(p, ph0, ph1, shm); step<1>(p, ph0, ph1, shm); step<2>(p, ph0, ph1, shm); step<3>(p, ph0, ph1, shm);
  step<4>(p, ph0, ph1, shm); step<5>(p, ph0, ph1, shm); step<6>(p, ph0, ph1, shm); step<7>(p, ph0, ph1, shm);
  step<8>(p, ph0, ph1, shm); step<9>(p, ph0, ph1, shm); step<10>(p, ph0, ph1, shm); step<11>(p, ph0, ph1, shm);
  step<12>(p, ph0, ph1, shm); step<13>(p, ph0, ph1, shm); step<14>(p, ph0, ph1, shm); step<15>(p, ph0, ph1, shm);
  step<16>(p, ph0, ph1, shm); step<17>(p, ph0, ph1, shm); step<18>(p, ph0, ph1, shm); step<24>(p, ph0, ph1, shm); step<19>(p, ph0, ph1, shm);
  step<20>(p, ph0, ph1, shm); step<21>(p, ph0, ph1, shm); step<22>(p, ph0, ph1, shm); step<23>(p, ph0, ph1, shm);
}

extern "C" void kernel_launch(void* const* d_in, const int* in_sizes, int n_in, void* d_out, int out_size, void* d_ws, size_t ws_size,
                              hipStream_t stream) {
  Params p{};
  const float** f = (const float**)&p;
  for (int i = 0; i < 22; ++i) f[i] = (const float*)d_in[i];
  p.out = (float*)d_out;
  char* w = (char*)d_ws; size_t off = 0;
  auto take = [&](size_t bytes) { char* r = w + off; off += (bytes + 255) & ~(size_t)255; return r; };
  p.W13[3] = (bf16_t*)take((size_t)2 * DFF * DM * 2);
  p.W2[3] = (bf16_t*)take((size_t)DM * DFF * 2);
  p.WinO = (bf16_t*)take((size_t)5120 * 1024 * 2);
  p.WoutO = (bf16_t*)take((size_t)1024 * 1024 * 2);
  p.mod = (float*)take((size_t)2 * 5 * 9216 * 4);
  p.XC = (float*)take((size_t)NCTX * DM * 4);
  p.RS = (float*)take((size_t)M_ALL * 2 * 4);
  p.rope = (float*)take((size_t)8192 * 32 * 4);
  p.bar = (unsigned*)take((size_t)XCD_BAR_WORDS * 4);
  p.U = (bf16_t*)take((size_t)M_ALL * DM * 2);
  p.R = take(0);
  {
    const size_t early = (size_t)3 * (2 * DFF * DM * 2) + (size_t)3 * (DM * DFF * 2) + (size_t)2048 * 1024 * 2 + (size_t)1792 * 2048 * 2 + (size_t)1024 * 1024 * 2;
    size_t e0 = (ws_size - early) & ~(size_t)255;
    const size_t rbytes = e0 - off;
    if (rbytes < (size_t)M_ALL * DM * 2 * 5 || ws_size - off < (size_t)M_ALL * DM * 2 * 5 + (size_t)32768 * DM * 2)
      fprintf(stderr, "workspace too small: R=%zu ws=%zu\n", rbytes, ws_size);
    if (ws_size - off < (size_t)M_ALL * DM * 2 * 5 + (size_t)32768 * DM * 2 + (size_t)192 * 16384 * 4 + 192 * 128 * 4) fprintf(stderr, "workspace too small for Sseg\n");
    off = e0;
    for (int i = 0; i < 3; ++i) p.W13[i] = (bf16_t*)take((size_t)2 * DFF * DM * 2);
    for (int i = 0; i < 3; ++i) p.W2[i] = (bf16_t*)take((size_t)DM * DFF * 2);
    p.WinE = (bf16_t*)take((size_t)2048 * 1024 * 2);
    p.Wqkv = (bf16_t*)take((size_t)1792 * 2048 * 2);
    p.WoutE = (bf16_t*)take((size_t)1024 * 1024 * 2);
  }
  static bool attr_done = false;
  if (!attr_done) { (void)hipFuncSetAttribute((const void*)mega, hipFuncAttributeMaxDynamicSharedMemorySize, SHM_B + 256); attr_done = true; }
#if 0
  for (int ph = 0; ph < N_PHASES; ++ph) {
    hipLaunchKernelGGL(mega, dim3(256), dim3(NTHR), SHM_B, stream, p, ph, ph + 1);
  }
#else
  static int grid_blocks = 0;
  if (!grid_blocks) {
    int dev = 0, cus = 0, per_cu = 0;
    hipGetDevice(&dev);
    hipDeviceGetAttribute(&cus, hipDeviceAttributeMultiprocessorCount, dev);
    hipOccupancyMaxActiveBlocksPerMultiprocessor(&per_cu, mega, NTHR, SHM_B + 256);
    if (per_cu > 1) per_cu = 1;
    grid_blocks = cus * per_cu;
  }
  int ph0 = 0, ph1 = N_PHASES;
  void* args[] = {&p, &ph0, &ph1};
  (void)hipMemsetAsync(p.bar, 0, (size_t)XCD_BAR_WORDS * 4, stream);
  hipError_t e = hipLaunchCooperativeKernel((void*)mega, dim3(grid_blocks), dim3(NTHR), args, SHM_B + 256, stream);
  if (e != hipSuccess) fprintf(stderr, "cooperative launch failed: %s (grid %d)\n", hipGetErrorString(e), grid_blocks);
#endif
}
```

```cpp
#include <hip/hip_runtime.h>
#include <hip/hip_cooperative_groups.h>
#include <cstdio>
namespace cg = cooperative_groups;

typedef unsigned short bf16_t;
typedef short bf16x8 __attribute__((ext_vector_type(8)));
typedef float f32x4 __attribute__((ext_vector_type(4)));
typedef unsigned u32x2 __attribute__((ext_vector_type(2)));
typedef unsigned u32x4 __attribute__((ext_vector_type(4)));
typedef _Float16 h16x4 __attribute__((ext_vector_type(4)));
typedef _Float16 h16x8 __attribute__((ext_vector_type(8)));

constexpr int M_ALL = 33792;
constexpr int NCTX = 1024;
constexpr int DM = 1024;
constexpr int DFF = 2816;
constexpr int NKEY = 8448;
constexpr int NTHR = 512;
constexpr float QSCALE = 0.10206207261596577f * 1.4426950408889634f;
constexpr float HSCALE = 0.08838834764831845f;

struct Params {
  const float *x, *c, *ctx, *c_ctx, *ada_w, *ada_b, *norm_g, *ffn_w1, *ffn_w3, *ffn_w2, *even_w_in, *even_conv_w,
      *q_norm_g, *w_uq, *kv_norm_g, *w_ukv, *even_w_out, *odd_w_in, *lb_logits, *g_norm_g, *odd_w_out, *final_norm_g;
  float* out;
  bf16_t *W13[4], *W2[4], *WinE, *Wqkv, *WoutE, *WinO, *WoutO;
  float *mod, *XC, *RS, *rope;
  unsigned* bar;
  unsigned* aflag;
  bf16_t* U;
  char* R;
};

__device__ __forceinline__ float bf2f(bf16_t v) { return __uint_as_float(((unsigned)v) << 16); }
typedef float f32x2 __attribute__((ext_vector_type(2)));
typedef __bf16 bf16v2 __attribute__((ext_vector_type(2)));
__device__ __forceinline__ unsigned pk2(float lo, float hi) { f32x2 v = {lo, hi}; return __builtin_bit_cast(unsigned, __builtin_convertvector(v, bf16v2)); }
__device__ __forceinline__ bf16_t f2bf(float f) { return (bf16_t)(pk2(f, 0.f) & 0xffffu); }
__device__ __forceinline__ float lo2f(unsigned u) { return __uint_as_float(u << 16); }
__device__ __forceinline__ float hi2f(unsigned u) { return __uint_as_float(u & 0xffff0000u); }
__device__ __forceinline__ float wave_sum(float v) {
#pragma unroll
  for (int o = 32; o > 0; o >>= 1) v += __shfl_xor(v, o);
  return v;
}
__device__ __forceinline__ float sigmoidf_(float a) { return __builtin_amdgcn_rcpf(1.f + __expf(-a)); }
__device__ __forceinline__ int row_mi(int r) { return r < NCTX ? 4 : ((r - NCTX) >> 13); }
__device__ __forceinline__ void row_bk(int r, int& b, int& key) {
  if (r < NCTX) { b = r >> 8; key = r & 255; } else { int rr = r - NCTX; b = rr >> 13; key = 256 + (rr & 8191); }
}

constexpr int BM = 256, BK = 64, HALF = 128, NXCD = 8, WGM = 8, HT = HALF * BK, SHM_B = 8 * HT * 2;

__device__ __forceinline__ int lds_byte(int r, int c) {
  int st = (r >> 4) * 2 + (c >> 5), rr = r & 15, cc = c & 31, ob = rr * 64 + cc * 2;
  return st * 1024 + (ob ^ (((ob >> 9) & 1) << 5));
}
__device__ __forceinline__ void stage_rc(int b, int& R, int& C) {
  int st = b / 1024, sb = b % 1024, swz = sb ^ (((sb >> 9) & 1) << 5);
  R = (st >> 1) * 16 + swz / 64; C = (st & 1) * 32 + (swz % 64) / 2;
}

#define LAS __attribute__((address_space(3)))
struct EpiNone { static constexpr bool HALFOK = false; __device__ __forceinline__ void operator()(const f32x4 (&)[2][2][4][2], int, int, int, int, int, int, int) const {} };
template <class Epi, class Epi2 = EpiNone>
__device__ __forceinline__ void gemm_phase(const bf16_t* A, int lda, const bf16_t* Bt, int ldb, int K, int pm0, int nM, int pn0, int nN,
                                           const Epi& epi, LAS unsigned char* lds, int nsm = 0, int ksl = 1, const Epi2& epi2 = Epi2()) {
  const int tid = threadIdx.x, wid = __builtin_amdgcn_readfirstlane(tid >> 6), lane = tid & 63, wr = wid >> 2, wc = wid & 3, fr = lane & 15, fq = lane >> 4;
  const int nt = K / BK;
  const int nwg = nM * nN, G = gridDim.x;
  const int nsplit = nsm * nN * ksl, nts = nt / ksl;
  if ((int)blockIdx.x >= nwg + nsplit) return;
  const int Rfull = nwg / G, Lleft = nwg - Rfull * G;
  const bool tail_split = Epi::HALFOK && nsm == 0 && Lleft > 0 && 2 * Lleft <= G;
  unsigned voffA[2], voffB[2];
#pragma unroll
  for (int i = 0; i < 2; ++i) { int R, C; stage_rc(tid * 16 + i * 8192, R, C); voffA[i] = (unsigned)(R * lda + C) * 2u; voffB[i] = (unsigned)(R * ldb + C) * 2u; }
  const size_t kstep = (size_t)(BK * 2);
  const size_t hstepA = (size_t)HALF * lda * 2, hstepB = (size_t)HALF * ldb * 2;
  const unsigned ldsw = (unsigned)wid * 1024u;
  const int aoff = lds_byte(wr * 64 + fr, fq * 8), boff = lds_byte(wc * 32 + fr, fq * 8);
#define G_SA(b, h) (((b) * 2 + (h)) * (HT * 2))
#define G_SB(b, h) ((4 + (b) * 2 + (h)) * (HT * 2))
#define G_STAGE(bufoff, gbase, voff) do { _Pragma("unroll") for (int _i = 0; _i < 2; ++_i) \
    __builtin_amdgcn_global_load_lds((const unsigned*)((const char*)(gbase) + (voff)[_i]), (LAS unsigned*)(lds + (bufoff) + ldsw + _i * 8192), 16, 0, 0); } while (0)
#define G_LDA(dst, b, h) do { _Pragma("unroll") for (int m = 0; m < 4; ++m) _Pragma("unroll") for (int k = 0; k < 2; ++k) dst[m][k] = *(const LAS bf16x8*)(lds + G_SA(b, h) + aoff + m * 2048 + k * 1024); } while (0)
#define G_LDB(dst, b, h) do { _Pragma("unroll") for (int n = 0; n < 2; ++n) _Pragma("unroll") for (int k = 0; k < 2; ++k) dst[n][k] = *(const LAS bf16x8*)(lds + G_SB(b, h) + boff + n * 2048 + k * 1024); } while (0)
#define G_MMA(ai, bj, At, Bx) do { __builtin_amdgcn_s_setprio(1); _Pragma("unroll") for (int m = 0; m < 4; ++m) _Pragma("unroll") for (int n = 0; n < 2; ++n) _Pragma("unroll") for (int k = 0; k < 2; ++k) \
    acc[ai][bj][m][n] = __builtin_amdgcn_mfma_f32_16x16x32_bf16(Bx[n][k], At[m][k], acc[ai][bj][m][n], 0, 0, 0); __builtin_amdgcn_s_setprio(0); } while (0)
#define WAIT_V(n) asm volatile("s_waitcnt vmcnt(" #n ")" ::: "memory")
#define WAIT_L(n) asm volatile("s_waitcnt lgkmcnt(" #n ")" ::: "memory")
#define BAR __builtin_amdgcn_s_barrier()
#define SCHED __builtin_amdgcn_sched_barrier(0)
  auto unit = [&](int i, int& pm, int& pn, int& sl, int& hf) -> bool {
    long L = (long)i * G + blockIdx.x; sl = -1; hf = -1;
    if (tail_split && i >= Rfull) { if (i > Rfull || (int)blockIdx.x >= 2 * Lleft) return false; L = (long)Rfull * G + (blockIdx.x >> 1); hf = blockIdx.x & 1; }
    if (L >= nwg) { const int j = (int)(L - nwg); if (j >= nsplit) return false; sl = j % ksl; const int tile = j / ksl; pm = tile / nN; pn = pn0 + tile % nN; return true; }
    int wgid = (int)L; { const int q = nwg / NXCD, r = nwg % NXCD, xcd = wgid % NXCD, off = wgid / NXCD; wgid = (xcd < r ? xcd * (q + 1) : r * (q + 1) + (xcd - r) * q) + off; }
    const int nig = WGM * nN, gid = wgid / nig, fm = gid * WGM, gsz = (nM - fm) < WGM ? (nM - fm) : WGM;
    pm = pm0 + fm + ((wgid % nig) % gsz); pn = pn0 + (wgid % nig) / gsz; return true;
  };
  int cpm, cpn, csl, chf, npm = 0, npn = 0, nsl = -1, nhf = -1, ui = 0;
  unit(0, cpm, cpn, csl, chf);
  f32x4 acc[2][2][4][2];
#pragma unroll
  for (int a = 0; a < 2; ++a)
#pragma unroll
    for (int b = 0; b < 2; ++b)
#pragma unroll
      for (int m = 0; m < 4; ++m)
#pragma unroll
        for (int n = 0; n < 2; ++n) acc[a][b][m][n] = (f32x4){0.f, 0.f, 0.f, 0.f};
  bf16x8 At[4][2], B0[2][2], B1[2][2];
  const char* cA = (const char*)A + (size_t)cpm * 2 * hstepA + (csl < 0 ? 0 : (size_t)csl * nts * kstep) + (chf > 0 ? hstepA : 0);
  size_t chA = chf < 0 ? hstepA : 0, nhA = hstepA;
  const char* cB = (const char*)Bt + (size_t)cpn * 2 * hstepB + (csl < 0 ? 0 : (size_t)csl * nts * kstep);
  G_STAGE(G_SB(0, 0), cB, voffB); G_STAGE(G_SA(0, 0), cA, voffA); G_STAGE(G_SB(0, 1), cB + hstepB, voffB); G_STAGE(G_SA(0, 1), cA + chA, voffA);
  if (wr == 1) BAR;
  WAIT_V(4); BAR;
  G_STAGE(G_SB(1, 0), cB + kstep, voffB); G_STAGE(G_SA(1, 0), cA + kstep, voffA); G_STAGE(G_SB(1, 1), cB + hstepB + kstep, voffB);
  WAIT_V(6); BAR;
#define G_KLOOP(AI1) \
    _Pragma("nounroll") \
    for (int t = 0; t < cnt; t += 2) { \
      const bool last = (t == cnt - 2); \
      const char* a1 = cA + (size_t)(t + 1) * kstep; \
      const char* a2 = last ? nA : cA + (size_t)(t + 2) * kstep; const char* b2 = last ? nB : cB + (size_t)(t + 2) * kstep; \
      const char* a3 = a2 + kstep; const char* b3 = b2 + kstep; \
      G_LDB(B0, 0, 0); SCHED; G_LDA(At, 0, 0); G_STAGE(G_SA(1, 1), a1 + chA, voffA); \
      WAIT_L(8); BAR; WAIT_L(0); G_MMA(0, 0, At, B0); BAR; SCHED; \
      G_LDB(B1, 0, 1); G_STAGE(G_SB(0, 0), b2, voffB); \
      BAR; WAIT_L(0); G_MMA(0, 1, At, B1); BAR; \
      G_LDA(At, 0, 1); G_STAGE(G_SA(0, 0), a2, voffA); \
      BAR; WAIT_L(0); if (AI1) G_MMA(1, 0, At, B0); BAR; SCHED; \
      G_STAGE(G_SB(0, 1), b2 + hstepB, voffB); \
      WAIT_V(6); BAR; if (AI1) G_MMA(1, 1, At, B1); BAR; \
      G_LDB(B0, 1, 0); SCHED; G_LDA(At, 1, 0); G_STAGE(G_SA(0, 1), a2 + (last ? nhA : chA), voffA); \
      WAIT_L(8); BAR; WAIT_L(0); G_MMA(0, 0, At, B0); BAR; SCHED; \
      G_LDB(B1, 1, 1); G_STAGE(G_SB(1, 0), b3, voffB); \
      BAR; WAIT_L(0); G_MMA(0, 1, At, B1); BAR; \
      G_LDA(At, 1, 1); G_STAGE(G_SA(1, 0), a3, voffA); \
      BAR; WAIT_L(0); if (AI1) G_MMA(1, 0, At, B0); BAR; SCHED; \
      G_STAGE(G_SB(1, 1), b3 + hstepB, voffB); \
      WAIT_V(6); BAR; if (AI1) G_MMA(1, 1, At, B1); BAR; \
    }
  bool pending_half = false;
  for (;;) {
    const bool has_next = unit(ui + 1, npm, npn, nsl, nhf);
    const char* nA = has_next ? (const char*)A + (size_t)npm * 2 * hstepA + (nsl < 0 ? 0 : (size_t)nsl * nts * kstep) + (nhf > 0 ? hstepA : 0) : cA;
    const char* nB = has_next ? (const char*)Bt + (size_t)npn * 2 * hstepB + (nsl < 0 ? 0 : (size_t)nsl * nts * kstep) : cB;
    nhA = has_next ? (nhf < 0 ? hstepA : 0) : chA;
    const int cnt = csl < 0 ? nt : nts;
    G_KLOOP(1)
    if (csl < 0) {
      if constexpr (Epi::HALFOK) epi(acc, cpm * BM, cpn * BM, wr, wc, fr, fq, 2);
      else epi(acc, cpm * BM, cpn * BM, wr, wc, fr, fq);
    } else epi2(acc, cpm * BM, cpn * BM, wr, wc, fr, fq, csl);
#ifndef NO_EPI_DRAIN
    WAIT_V(0);
#endif
    if (!has_next) break;
#pragma unroll
    for (int a = 0; a < 2; ++a)
#pragma unroll
      for (int b = 0; b < 2; ++b)
#pragma unroll
        for (int m = 0; m < 4; ++m)
#pragma unroll
          for (int n = 0; n < 2; ++n) acc[a][b][m][n] = (f32x4){0.f, 0.f, 0.f, 0.f};
    cpm = npm; cpn = npn; csl = nsl; chf = nhf; chA = nhA; cA = nA; cB = nB; ++ui;
    if (chf >= 0) { pending_half = true; break; }
  }
  if constexpr (Epi::HALFOK) {
    if (pending_half) {
      const char* nA = cA; const char* nB = cB; nhA = chA;
      const int cnt = nt;
      G_KLOOP(0)
      epi(acc, cpm * BM + (chf > 0 ? HALF : 0), cpn * BM, wr, wc, fr, fq, 1);
    }
  }
#undef G_KLOOP
  WAIT_V(0);
  if (wr == 0) BAR;
  BAR;
}

typedef f32x4 Acc[2][2][4][2];

struct EpiSwiglu { static constexpr bool HALFOK = true;
  bf16_t* G;
  __device__ __forceinline__ void operator()(const Acc& acc, int brow, int bcol, int wr, int wc, int fr, int fq, int nai) const {
    const int f0 = (bcol >> 1) + 32 * wc + 8 * fq;
    asm volatile("s_waitcnt vmcnt(14)" ::: "memory");
#pragma unroll
    for (int ai = 0; ai < 2; ++ai)
#pragma unroll
      for (int m = 0; m < 4; ++m) if (ai < nai) {
        const int r = brow + 128 * ai + 64 * wr + 16 * m + fr;
        u32x4 o;
#pragma unroll
        for (int bj = 0; bj < 2; ++bj) {
          const f32x4 a = acc[ai][bj][m][0], b = acc[ai][bj][m][1];
          const float g0 = a[0] * sigmoidf_(a[0]) * b[0], g1 = a[1] * sigmoidf_(a[1]) * b[1];
          const float g2 = a[2] * sigmoidf_(a[2]) * b[2], g3 = a[3] * sigmoidf_(a[3]) * b[3];
          if (bj == 0) { o.x = pk2(g0, g1); o.y = pk2(g2, g3); } else { o.z = pk2(g0, g1); o.w = pk2(g2, g3); }
        }
        *(u32x4*)(G + (size_t)r * DFF + f0) = o;
      }
  }
};

struct EpiResid { static constexpr bool HALFOK = false;
  const float *srcC, *srcL; float *dstC, *dstL; const float* gate;   float coef;
  __device__ __forceinline__ void operator()(const Acc& acc, int brow, int bcol, int wr, int wc, int fr, int fq) const {
    const float* g = gate + (size_t)row_mi(brow) * 9 * DM + bcol + 32 * wc + 4 * fq;
    f32x4 gv[2][2];
#pragma unroll
    for (int bj = 0; bj < 2; ++bj)
#pragma unroll
      for (int n = 0; n < 2; ++n) gv[bj][n] = coef * *(const f32x4*)(g + 128 * bj + 16 * n);
    const size_t rb = (size_t)(brow - NCTX + 64 * wr + fr) * DM + bcol + 32 * wc + 4 * fq;
#pragma unroll
    for (int ai = 0; ai < 2; ++ai)
#pragma unroll
      for (int mp = 0; mp < 2; ++mp) {
        f32x4 xv[2][2][2];
#pragma unroll
        for (int mm = 0; mm < 2; ++mm)
#pragma unroll
          for (int bj = 0; bj < 2; ++bj)
#pragma unroll
            for (int n = 0; n < 2; ++n)
              xv[mm][bj][n] = *(const f32x4*)(srcL + rb + (size_t)(128 * ai + 16 * (2 * mp + mm)) * DM + 128 * bj + 16 * n);
#pragma unroll
        for (int mm = 0; mm < 2; ++mm)
#pragma unroll
          for (int bj = 0; bj < 2; ++bj)
#pragma unroll
            for (int n = 0; n < 2; ++n)
              *(f32x4*)(dstL + rb + (size_t)(128 * ai + 16 * (2 * mp + mm)) * DM + 128 * bj + 16 * n) = xv[mm][bj][n] + gv[bj][n] * acc[ai][bj][2 * mp + mm][n];
      }
  }
};

struct EpiPart { static constexpr bool HALFOK = false;
  float* PART;
  __device__ __forceinline__ void operator()(const Acc& acc, int brow, int bcol, int wr, int wc, int fr, int fq, int sl) const {
#pragma unroll
    for (int ai = 0; ai < 2; ++ai)
#pragma unroll
      for (int m = 0; m < 4; ++m) {
        const int r = brow + 128 * ai + 64 * wr + 16 * m + fr;
        float* d = PART + ((size_t)sl * NCTX + r) * DM;
#pragma unroll
        for (int bj = 0; bj < 2; ++bj)
#pragma unroll
          for (int n = 0; n < 2; ++n) *(f32x4*)(d + bcol + 128 * bj + 32 * wc + 16 * n + 4 * fq) = acc[ai][bj][m][n];
      }
  }
};

struct EpiBf16 { static constexpr bool HALFOK = false;
  bf16_t* O; int ldc;
  __device__ __forceinline__ void operator()(const Acc& acc, int brow, int bcol, int wr, int wc, int fr, int fq) const {
#pragma unroll
    for (int ai = 0; ai < 2; ++ai)
#pragma unroll
      for (int m = 0; m < 4; ++m) {
        const int r = brow + 128 * ai + 64 * wr + 16 * m + fr;
#pragma unroll
        for (int bj = 0; bj < 2; ++bj)
#pragma unroll
          for (int n = 0; n < 2; ++n) {
            const int c = bcol + 128 * bj + 32 * wc + 16 * n + 4 * fq;
            f32x4 v = acc[ai][bj][m][n];
            u32x2 o; o.x = pk2(v[0], v[1]); o.y = pk2(v[2], v[3]);
            *(u32x2*)(O + (size_t)r * ldc + c) = o;
          }
      }
  }
};

struct EpiP { static constexpr bool HALFOK = true;
  bf16_t* O; float* RS;
  __device__ __forceinline__ void operator()(const Acc& acc, int brow, int bcol, int wr, int wc, int fr, int fq, int nai) const {
    asm volatile("s_waitcnt vmcnt(14)" ::: "memory");
#pragma unroll
    for (int ai = 0; ai < 2; ++ai)
#pragma unroll
      for (int m = 0; m < 4; ++m) if (ai < nai) {
        const int r = brow + 128 * ai + 64 * wr + 16 * m + fr;
        float ss0 = 0.f, ss1 = 0.f;
#pragma unroll
        for (int bj = 0; bj < 2; ++bj) {
          const int c = bcol + 128 * bj + 32 * wc + 8 * fq;
          const f32x4 v0 = acc[ai][bj][m][0], v1 = acc[ai][bj][m][1];
          const float q = v0[0] * v0[0] + v0[1] * v0[1] + v0[2] * v0[2] + v0[3] * v0[3] + v1[0] * v1[0] + v1[1] * v1[1] + v1[2] * v1[2] + v1[3] * v1[3];
          if (bj == 0) ss0 += q; else ss1 += q;
          u32x4 o; o.x = pk2(v0[0], v0[1]); o.y = pk2(v0[2], v0[3]); o.z = pk2(v1[0], v1[1]); o.w = pk2(v1[2], v1[3]);
          *(u32x4*)(O + (size_t)r * 2048 + c) = o;
        }
        if (bcol == 1536) {
          float ss = ss0 + ss1; ss += __shfl_xor(ss, 16); ss += __shfl_xor(ss, 32);
          if (fq == 0) atomicAdd(RS + 2 * r, ss);
        } else if (bcol == 1792) {
          float ss = ss0; ss += __shfl_xor(ss, 16); ss += __shfl_xor(ss, 32);
          if (fq == 0) atomicAdd(RS + 2 * r + 1, ss);
        }
      }
  }
};

struct EpiQ { static constexpr bool HALFOK = false;
  const float* RS; const float* rope;   bf16_t* Qall;
  __device__ __forceinline__ void operator()(const Acc& acc, int brow, int bcol, int wr, int wc, int fr, int fq) const {
#pragma unroll
    for (int ai = 0; ai < 2; ++ai)
#pragma unroll
      for (int m = 0; m < 4; ++m) {
        const int r = brow + 128 * ai + 64 * wr + 16 * m + fr;
        const float rstd = rsqrtf(RS[2 * r] * (1.f / 256.f) + 1e-6f) * QSCALE;
        int b, key; row_bk(r, b, key);
        const bool latent = r >= NCTX;
        const int t = (r - NCTX) & 8191;
        bf16_t* qrow = Qall + ((size_t)(b * 8) * NKEY + key) * 96 + 4 * fq;
#pragma unroll
        for (int bj = 0; bj < 2; ++bj) {
          const int c32 = bcol + 128 * bj + 32 * wc;
          const int h = c32 / 96, d32 = c32 - 96 * h;
#pragma unroll
          for (int n = 0; n < 2; ++n) {
            f32x4 v = acc[ai][bj][m][n] * rstd;
            if (d32 == 64) {
              f32x4 pv;
#pragma unroll
              for (int j = 0; j < 4; ++j) pv[j] = __shfl_xor(v[j], 32);
              if (latent) {
                const float* rp = rope + ((size_t)t * 2 + n) * 16 + 4 * (fq & 1);
                const f32x4 cs = *(const f32x4*)rp, sn = *(const f32x4*)(rp + 8);
                v = (fq < 2) ? (v * cs - pv * sn) : (pv * sn + v * cs);
              }
            }
            u32x2 o; o.x = pk2(v[0], v[1]); o.y = pk2(v[2], v[3]);
            *(u32x2*)(qrow + (size_t)h * (NKEY * 96) + d32 + 16 * n) = o;
          }
        }
      }
  }
};
struct EpiKV { static constexpr bool HALFOK = false;
  const float* RS; bf16_t *Kall, *Vt;
  __device__ __forceinline__ void operator()(const Acc& acc, int brow, int bcol, int wr, int wc, int fr, int fq) const {
#pragma unroll
    for (int ai = 0; ai < 2; ++ai)
#pragma unroll
      for (int m = 0; m < 4; ++m) {
        const int r = brow + 128 * ai + 64 * wr + 16 * m + fr;
        const float rstd = rsqrtf(RS[2 * r + 1] * (1.f / 128.f) + 1e-6f);
        int b, key; row_bk(r, b, key);
        bf16_t* krow = Kall + ((size_t)(b * 8) * NKEY + key) * 96 + 4 * fq;
        bf16_t* vrow = Vt + (size_t)(b * 8) * 64 * NKEY + key + (size_t)(4 * fq) * NKEY;
#pragma unroll
        for (int bj = 0; bj < 2; ++bj) {
          const int cc = bcol - 768 + 128 * bj + 32 * wc, h = cc >> 7, e32 = cc & 127;
#pragma unroll
          for (int n = 0; n < 2; ++n) {
            const f32x4 v = acc[ai][bj][m][n] * rstd;
            if (e32 < 64) {
              u32x2 o; o.x = pk2(v[0], v[1]); o.y = pk2(v[2], v[3]);
              *(u32x2*)(krow + (size_t)h * (NKEY * 96) + e32 + 16 * n) = o;
            } else {
              bf16_t* vp = vrow + (size_t)(h * 64 + e32 - 64 + 16 * n) * NKEY;
#pragma unroll
              for (int j = 0; j < 4; ++j) vp[(size_t)j * NKEY] = f2bf(v[j]);
            }
          }
        }
      }
  }
};

struct EpiQKV { static constexpr bool HALFOK = false;
  EpiQ q; EpiKV kv;
  __device__ __forceinline__ void operator()(const Acc& acc, int brow, int bcol, int wr, int wc, int fr, int fq) const {
    if (bcol < 768) q(acc, brow, bcol, wr, wc, fr, fq); else kv(acc, brow, bcol, wr, wc, fr, fq);
  }
};

struct EpiOdd { static constexpr bool HALFOK = true;
  bf16_t *Qh, *Vv, *Gg; _Float16 *Lf, *Lb; const float* lbl;
  __device__ __forceinline__ void operator()(const Acc& acc, int brow, int bcol, int wr, int wc, int fr, int fq, int nai) const {
    const int sec = bcol >> 10;
    const int cb = (bcol & 1023) + 32 * wc + 8 * fq;
    asm volatile("s_waitcnt vmcnt(14)" ::: "memory");
    if (sec == 2 || sec == 3) {
      const int dir = sec - 2;
      _Float16* O = Lf + (size_t)dir * ((size_t)M_ALL * DM);
#pragma unroll
      for (int bj = 0; bj < 2; ++bj) {
        const int c = cb + 128 * bj;
        f32x4 lb[2];
#pragma unroll
        for (int n = 0; n < 2; ++n) {
          const f32x4 z0 = *(const f32x4*)(lbl + dir * 1024 + c + 4 * n), z1 = *(const f32x4*)(lbl + 2048 + dir * 1024 + c + 4 * n);
#pragma unroll
          for (int j = 0; j < 4; ++j) lb[n][j] = __builtin_amdgcn_rcpf(1.f + __expf(z0[j] - z1[j]));
        }
#pragma unroll
        for (int ai = 0; ai < 2; ++ai)
#pragma unroll
          for (int m = 0; m < 4; ++m) if (ai < nai) {
            const int r = brow + 128 * ai + 64 * wr + 16 * m + fr;
            h16x8 hv;
#pragma unroll
            for (int n = 0; n < 2; ++n) {
              const f32x4 v = acc[ai][bj][m][n];
#pragma unroll
              for (int j = 0; j < 4; ++j) hv[4 * n + j] = (_Float16)__logf(lb[n][j] + (1.f - lb[n][j]) * sigmoidf_(v[j]));
            }
            *(h16x8*)(O + (size_t)r * DM + c) = hv;
          }
      }
    } else {
      bf16_t* O = Qh + (size_t)(sec == 4 ? 2 : sec) * ((size_t)M_ALL * DM);
      const float sc = sec == 0 ? HSCALE : 1.f;
#pragma unroll
      for (int ai = 0; ai < 2; ++ai)
#pragma unroll
        for (int m = 0; m < 4; ++m) if (ai < nai) {
          const int r = brow + 128 * ai + 64 * wr + 16 * m + fr;
#pragma unroll
          for (int bj = 0; bj < 2; ++bj) {
            const int c = cb + 128 * bj;
            const f32x4 v0 = acc[ai][bj][m][0] * sc, v1 = acc[ai][bj][m][1] * sc;
            u32x4 o; o.x = pk2(v0[0], v0[1]); o.y = pk2(v0[2], v0[3]); o.z = pk2(v1[0], v1[1]); o.w = pk2(v1[2], v1[3]);
            *(u32x4*)(O + (size_t)r * DM + c) = o;
          }
        }
    }
  }
};

__device__ __forceinline__ void tr_tile(const float* src, int ldn, int k0, int n0, int nv, bf16_t* dst, int ldk, int kofs, int mode, const float* kscale, float* sm) {
  const int tid = threadIdx.x;
  float v[8];
#pragma unroll
  for (int i = 0; i < 8; ++i) {
    const int e = tid + i * NTHR, k = e >> 6, n = e & 63;
    v[i] = (n < nv) ? src[(size_t)(k0 + k) * ldn + n0 + n] : 0.f;
  }
#pragma unroll
  for (int i = 0; i < 8; ++i) {
    const int e = tid + i * NTHR, k = e >> 6, n = e & 63;
    sm[k * 65 + n] = kscale ? v[i] * kscale[k0 + k] : v[i];
  }
  __syncthreads();
  {
    const int n = tid >> 3, kq = tid & 7;
    const int ng = n0 + n;
    int drow = ng;
    if (mode == 1 || mode == 2) {
      const int pn = ng >> 7, rem = ng & 127, wc = rem >> 5, r2 = rem & 31, fq = r2 >> 3, bj = (r2 >> 2) & 1, j = r2 & 3;
      drow = 256 * pn + 128 * bj + 32 * wc + 16 * (mode - 1) + 4 * fq + j;
    } else if (mode == 3) {
      const int o = ng & 31, fq = o >> 3, nn = (o >> 2) & 1, j = o & 3;
      drow = (ng & ~31) + 16 * nn + 4 * fq + j;
    }
    if (n < nv) {
      u32x4 o;
      o.x = pk2(sm[(8 * kq + 0) * 65 + n], sm[(8 * kq + 1) * 65 + n]);
      o.y = pk2(sm[(8 * kq + 2) * 65 + n], sm[(8 * kq + 3) * 65 + n]);
      o.z = pk2(sm[(8 * kq + 4) * 65 + n], sm[(8 * kq + 5) * 65 + n]);
      o.w = pk2(sm[(8 * kq + 6) * 65 + n], sm[(8 * kq + 7) * 65 + n]);
      *(u32x4*)(dst + (size_t)drow * ldk + kofs + k0 + 8 * kq) = o;
    }
  }
  __syncthreads();
}

__device__ void phase_prep(const Params& p, float* sm) {
  const int tid = threadIdx.x;
  int base = 0;
  const int bid = blockIdx.x, G = gridDim.x;
#define TRJOB(SRC, KK, NN, DST, LDK, KOFS, MODE, KS) { const int nk = (KK) / 64, nn = ((NN) + 63) / 64, tot = nk * nn; \
    int first = (bid - base % G + G) % G; \
    for (int t = first; t < tot; t += G) { const int n0_ = (t % nn) * 64; tr_tile((SRC), (NN), (t / nn) * 64, n0_, ((NN) - n0_) < 64 ? ((NN) - n0_) : 64, (DST), (LDK), (KOFS), (MODE), (KS), sm); } \
    base += tot; }
  for (int lj = 0; lj < 4; ++lj) {
    TRJOB(p.ffn_w1 + (size_t)lj * DM * DFF, DM, DFF, p.W13[lj], DM, 0, 1, nullptr);
    TRJOB(p.ffn_w3 + (size_t)lj * DM * DFF, DM, DFF, p.W13[lj], DM, 0, 2, nullptr);
    TRJOB(p.ffn_w2 + (size_t)lj * DFF * DM, DFF, DM, p.W2[lj], DFF, 0, 0, nullptr);
  }
  TRJOB(p.even_w_in, DM, 1952, p.WinE, DM, 0, 3, nullptr);
  TRJOB(p.w_uq, 256, 768, p.Wqkv, 2048, 0, 0, p.q_norm_g);
  TRJOB(p.w_ukv, 128, 1024, p.Wqkv + (size_t)768 * 2048, 2048, 256, 0, p.kv_norm_g);
  TRJOB(p.even_w_out, DM, DM, p.WoutE, DM, 0, 0, nullptr);
  TRJOB(p.odd_w_in, DM, 5120, p.WinO, DM, 0, 3, nullptr);
  TRJOB(p.odd_w_out, DM, DM, p.WoutO, DM, 0, 0, nullptr);
#undef TRJOB
  for (int i = bid * NTHR + tid; i < 96 * 1024; i += G * NTHR) p.WinE[(size_t)1952 * 1024 + i] = 0;
  for (int i = bid * NTHR + tid; i < 768 * 128; i += G * NTHR) p.Wqkv[(size_t)(i >> 7) * 2048 + 256 + (i & 127)] = 0;
  for (int i = bid * NTHR + tid; i < 1024 * 256; i += G * NTHR) p.Wqkv[(size_t)(768 + (i >> 8)) * 2048 + (i & 255)] = 0;
  for (int i = bid * NTHR + tid; i < M_ALL * 2; i += G * NTHR) p.RS[i] = 0.f;
  for (int i = bid * NTHR + tid; i < 1024; i += G * NTHR) p.aflag[i] = 0u;
  for (int i = bid * NTHR + tid; i < 8192 * 16; i += G * NTHR) {
    const int t = i >> 4, ax = (i >> 3) & 1, fi = i & 7;
    const float pos = (float)(ax == 0 ? (t >> 6) : (t & 63));
    const float ang = pos * exp2f(-(float)fi * (13.287712379549449f / 8.f));
    p.rope[(size_t)(t * 2 + ax) * 16 + fi] = cosf(ang); p.rope[(size_t)(t * 2 + ax) * 16 + 8 + fi] = sinf(ang);
  }
  {
    float* scond = sm;
    float* red = sm + 5 * 1024;
    for (int i = tid; i < 5 * 1024; i += NTHR) {
      const int mi = i >> 10, k = i & 1023;
      const float cv = mi < 4 ? p.c[mi * 1024 + k] : p.c_ctx[k];
      scond[i] = cv * sigmoidf_(cv);
    }
    __syncthreads();
    const int col = tid & 63, kg = tid >> 6;
    for (int it = G - 1 - bid; it < 2 * 144; it += G) {
      const int l = it / 144, n = (it % 144) * 64 + col;
      const float* w = p.ada_w + (size_t)l * 1024 * 9216 + n;
      float a0 = 0, a1 = 0, a2 = 0, a3 = 0, a4 = 0;
#pragma unroll 16
      for (int k = kg * 128; k < kg * 128 + 128; ++k) {
        const float wv = w[(size_t)k * 9216];
        a0 += scond[k] * wv; a1 += scond[1024 + k] * wv; a2 += scond[2048 + k] * wv; a3 += scond[3072 + k] * wv; a4 += scond[4096 + k] * wv;
      }
      red[(kg * 5 + 0) * 64 + col] = a0; red[(kg * 5 + 1) * 64 + col] = a1; red[(kg * 5 + 2) * 64 + col] = a2;
      red[(kg * 5 + 3) * 64 + col] = a3; red[(kg * 5 + 4) * 64 + col] = a4;
      __syncthreads();
      for (int i = tid; i < 5 * 64; i += NTHR) {
        const int mi = i >> 6, cc = i & 63, nn = (it % 144) * 64 + cc;
        float sacc = 0.f;
#pragma unroll
        for (int q = 0; q < 8; ++q) sacc += red[(q * 5 + mi) * 64 + cc];
        p.mod[((size_t)(l * 5 + mi)) * 9216 + nn] = sacc + p.ada_b[l * 9216 + nn];
      }
      __syncthreads();
    }
  }
}

__device__ __forceinline__ void phase_norm(const Params& p, int l, int j, const float* srcC, const float* srcL, int row0,
                           const float* PART = nullptr, int ksl = 0, float coef = 0.f, const float* pgate = nullptr) {
  constexpr int NR = 2;
  const int wave = threadIdx.x >> 6, lane = threadIdx.x & 63;
  const float* g = p.norm_g + (l * 3 + j) * 1024;
  f32x4 gv[4];
#pragma unroll
  for (int i = 0; i < 4; ++i) gv[i] = *(const f32x4*)(g + (lane + 64 * i) * 4);
  const int stride = gridDim.x * 8;
  for (int rb = row0 + blockIdx.x * 8 + wave; rb < M_ALL; rb += stride * NR) {
    f32x4 v[NR][4], sv[NR][4], hv[NR][4];
#pragma unroll
    for (int q = 0; q < NR; ++q) {
      const int rr = rb + q * stride, r = rr < M_ALL ? rr : M_ALL - 1;
      const float* src = r < NCTX ? srcC + (size_t)r * DM : srcL + (size_t)(r - NCTX) * DM;
      const float* sh = p.mod + ((size_t)(l * 5 + row_mi(r)) * 9 + 3 * j) * 1024;
#pragma unroll
      for (int i = 0; i < 4; ++i) { v[q][i] = ((const f32x4*)src)[lane + 64 * i]; hv[q][i] = ((const f32x4*)sh)[lane + 64 * i]; sv[q][i] = ((const f32x4*)(sh + 1024))[lane + 64 * i]; }
      if (ksl > 0 && r < NCTX) {
#pragma unroll
        for (int i = 0; i < 4; ++i) {
          f32x4 a = {0.f, 0.f, 0.f, 0.f};
          for (int sl = 0; sl < ksl; ++sl) a += ((const f32x4*)(PART + ((size_t)sl * NCTX + r) * DM))[lane + 64 * i];
          v[q][i] += coef * ((const f32x4*)pgate)[lane + 64 * i] * a;
        }
      }
    }
#pragma unroll
    for (int q = 0; q < NR; ++q) {
      const int rr = rb + q * stride, r = rr < M_ALL ? rr : M_ALL - 1;
      const bool live = rr < M_ALL;
      float ss = 0.f;
#pragma unroll
      for (int i = 0; i < 4; ++i) ss += v[q][i][0] * v[q][i][0] + v[q][i][1] * v[q][i][1] + v[q][i][2] * v[q][i][2] + v[q][i][3] * v[q][i][3];
      ss = wave_sum(ss);
      const float rstd = rsqrtf(ss * (1.f / 1024.f) + 1e-6f);
      if (live) {
        if (ksl > 0 && r < NCTX) {
#pragma unroll
          for (int i = 0; i < 4; ++i) ((f32x4*)(p.XC + (size_t)r * DM))[lane + 64 * i] = v[q][i];
        }
#pragma unroll
        for (int i = 0; i < 4; ++i) {
          const f32x4 u = v[q][i] * rstd * gv[i] * (1.f + sv[q][i]) + hv[q][i];
          u32x2 o; o.x = pk2(u[0], u[1]); o.y = pk2(u[2], u[3]);
          *(u32x2*)(p.U + (size_t)r * DM + (lane + 64 * i) * 4) = o;
        }
      }
    }
  }
}

__device__ __forceinline__ void phase_final_norm(const Params& p) {
  constexpr int NR = 4;
  const int wave = threadIdx.x >> 6, lane = threadIdx.x & 63;
  f32x4 gv[4];
#pragma unroll
  for (int i = 0; i < 4; ++i) gv[i] = *(const f32x4*)(p.final_norm_g + (lane + 64 * i) * 4);
  const int stride = gridDim.x * 8;
  for (int rb = blockIdx.x * 8 + wave; rb < 32768; rb += stride * NR) {
    f32x4 v[NR][4];
#pragma unroll
    for (int q = 0; q < NR; ++q) {
      const int rr = rb + q * stride, r = rr < 32768 ? rr : 32767;
#pragma unroll
      for (int i = 0; i < 4; ++i) v[q][i] = ((const f32x4*)(p.out + (size_t)r * DM))[lane + 64 * i];
    }
#pragma unroll
    for (int q = 0; q < NR; ++q) {
      const int rr = rb + q * stride, r = rr < 32768 ? rr : 32767;
      const bool live = rr < 32768;
      float ss = 0.f;
#pragma unroll
      for (int i = 0; i < 4; ++i) ss += v[q][i][0] * v[q][i][0] + v[q][i][1] * v[q][i][1] + v[q][i][2] * v[q][i][2] + v[q][i][3] * v[q][i][3];
      ss = wave_sum(ss);
      const float rstd = rsqrtf(ss * (1.f / 1024.f) + 1e-6f);
#pragma unroll
      for (int i = 0; i < 4; ++i) {
        const int c = (lane + 64 * i) * 4;
        if (live) ((f32x4*)(p.out + (size_t)r * DM))[lane + 64 * i] = v[q][i] * rstd * gv[i];
      }
    }
  }
}

__device__ void phase_even_elem(const Params& p, const bf16_t* P, bf16_t* CAT, bf16_t* Kall) {
  const int wave = threadIdx.x >> 6, lane = threadIdx.x & 63;
  for (int r = blockIdx.x * 8 + wave; r < M_ALL; r += gridDim.x * 8) {
    int b, key; row_bk(r, b, key);
    const bool latent = r >= NCTX;
    const int t = latent ? ((r - NCTX) & 8191) : (r & 255), T = latent ? 8192 : 256;
    const int c0 = lane * 8;
    float cv[3][8];
#pragma unroll
    for (int dt = 0; dt < 3; ++dt) {
      const int tt = t + dt - 1;
      if (tt >= 0 && tt < T) {
        const bf16_t* pr = P + (size_t)(r + dt - 1) * 2048;
        u32x4 gc = *(const u32x4*)(pr + 512 + c0), vv = *(const u32x4*)(pr + 1024 + c0);
#pragma unroll
        for (int e = 0; e < 4; ++e) { cv[dt][2 * e] = lo2f(gc[e]) * lo2f(vv[e]); cv[dt][2 * e + 1] = hi2f(gc[e]) * hi2f(vv[e]); }
      } else {
#pragma unroll
        for (int e = 0; e < 8; ++e) cv[dt][e] = 0.f;
      }
    }
    u32x4 gb = *(const u32x4*)(P + (size_t)r * 2048 + c0);
    float o[8];
#pragma unroll
    for (int e = 0; e < 8; ++e) {
      const float w0 = p.even_conv_w[c0 + e], w1 = p.even_conv_w[512 + c0 + e], w2 = p.even_conv_w[1024 + c0 + e];
      const float g = (e & 1) ? hi2f(gb[e >> 1]) : lo2f(gb[e >> 1]);
      o[e] = g * (cv[0][e] * w0 + cv[1][e] * w1 + cv[2][e] * w2);
    }
    u32x4 ov; ov.x = pk2(o[0], o[1]); ov.y = pk2(o[2], o[3]); ov.z = pk2(o[4], o[5]); ov.w = pk2(o[6], o[7]);
    *(u32x4*)(CAT + (size_t)r * DM + c0) = ov;
    {
      const int d = lane & 31;
      float v = bf2f(P[(size_t)r * 2048 + 1920 + d]);
      const float pv = __shfl_xor(v, 8);
      const int idx = d & 15, fi = idx & 7;
      if (latent) {
        const float* rp = p.rope + ((size_t)t * 2 + (d >> 4)) * 16 + fi;
        const float cs = rp[0], sn = rp[8];
        v = (idx < 8) ? (v * cs - pv * sn) : (pv * sn + v * cs);
      }
      const bf16_t bv = f2bf(v);
      if (lane < 32) {
#pragma unroll
        for (int h = 0; h < 8; ++h) Kall[((size_t)(b * 8 + h) * NKEY + key) * 96 + 64 + d] = bv;
      }
    }
  }
}

__device__ void phase_attn_scalar(const Params& p, const bf16_t* Qall, const bf16_t* Kall, const bf16_t* Vt, bf16_t* CAT) {
  const int ql = threadIdx.x & 255, half = threadIdx.x >> 8;
  for (int it = blockIdx.x; it < 1056; it += gridDim.x) {
    int b, h, q0, nk;
    if (it < 1024) { b = it >> 8; h = (it >> 5) & 7; q0 = 256 + (it & 31) * 256; nk = NKEY; }
    else { const int i2 = it - 1024; b = i2 >> 3; h = i2 & 7; q0 = 0; nk = 256; }
    const int qi = q0 + ql;
    const size_t bh = (size_t)(b * 8 + h);
    float q[96];
    {
      const u32x4* qp = (const u32x4*)(Qall + (bh * NKEY + qi) * 96);
#pragma unroll
      for (int i = 0; i < 12; ++i) { u32x4 v = qp[i];
#pragma unroll
        for (int e = 0; e < 4; ++e) { q[8 * i + 2 * e] = lo2f(v[e]); q[8 * i + 2 * e + 1] = hi2f(v[e]); } }
    }
    float o[32];
#pragma unroll
    for (int i = 0; i < 32; ++i) o[i] = 0.f;
    float mrun = -1e30f, lrun = 0.f;
    for (int k0 = 0; k0 < nk; k0 += 4) {
      float s[4];
#pragma unroll
      for (int kk = 0; kk < 4; ++kk) {
        const u32x4* kp = (const u32x4*)(Kall + (bh * NKEY + k0 + kk) * 96);
        float a = 0.f;
#pragma unroll
        for (int i = 0; i < 12; ++i) { u32x4 v = kp[i];
#pragma unroll
          for (int e = 0; e < 4; ++e) a += q[8 * i + 2 * e] * lo2f(v[e]) + q[8 * i + 2 * e + 1] * hi2f(v[e]); }
        s[kk] = a;
      }
      const float mx = fmaxf(fmaxf(s[0], s[1]), fmaxf(s[2], s[3]));
      const float mnew = fmaxf(mrun, mx);
      const float alpha = exp2f(mrun - mnew);
      const float p0 = exp2f(s[0] - mnew), p1 = exp2f(s[1] - mnew), p2 = exp2f(s[2] - mnew), p3 = exp2f(s[3] - mnew);
      lrun = lrun * alpha + p0 + p1 + p2 + p3;
      mrun = mnew;
#pragma unroll
      for (int dv = 0; dv < 32; ++dv) {
        u32x2 v = *(const u32x2*)(Vt + (bh * 64 + half * 32 + dv) * NKEY + k0);
        o[dv] = o[dv] * alpha + p0 * lo2f(v.x) + p1 * hi2f(v.x) + p2 * lo2f(v.y) + p3 * hi2f(v.y);
      }
    }
    const float il = 1.f / lrun;
    const int r = qi < 256 ? b * 256 + qi : NCTX + b * 8192 + (qi - 256);
    u32x4* op = (u32x4*)(CAT + (size_t)r * DM + 512 + h * 64 + half * 32);
#pragma unroll
    for (int i = 0; i < 4; ++i) {
      u32x4 v; v.x = pk2(o[8 * i] * il, o[8 * i + 1] * il); v.y = pk2(o[8 * i + 2] * il, o[8 * i + 3] * il);
      v.z = pk2(o[8 * i + 4] * il, o[8 * i + 5] * il); v.w = pk2(o[8 * i + 6] * il, o[8 * i + 7] * il);
      op[i] = v;
    }
  }
}

typedef float f32x16 __attribute__((ext_vector_type(16)));
__device__ __forceinline__ float ex2(float x) { return __builtin_amdgcn_exp2f(x); }
template <bool SAFE>
__device__ void phase_attn(const Params& p, const bf16_t* Qall, const bf16_t* Kall, const bf16_t* Vt, bf16_t* CAT, LAS unsigned char* lds) {
  const int tid = threadIdx.x, w = __builtin_amdgcn_readfirstlane(tid >> 6), lane = tid & 63, r = lane & 31, hh = lane >> 5;
  constexpr int KROW = 104, VROW = 72;
  constexpr int KBYTES = 64 * KROW * 2, VBYTES = 64 * VROW * 2, BUF = KBYTES + VBYTES;
  unsigned soff[3];
#pragma unroll
  for (int j = 0; j < 3; ++j) {
    const int ci = (3 * w + j) * 64 + lane;
    if (3 * w + j < 13) { const int row = ci / 13, part = ci % 13; soff[j] = (unsigned)(row * 96 + (part < 12 ? part : 0) * 8) * 2u; }
    else { const int c2 = ci - 832, dv = c2 / 9, part = c2 % 9; soff[j] = (unsigned)((dv < 64 ? dv : 0) * NKEY + (part < 8 ? part : 0) * 8) * 2u; }
  }
#define ATT_STAGE(bufi, k0_) do { _Pragma("unroll") for (int j_ = 0; j_ < 3; ++j_) if (j_ == 0 || w < 7) { \
    const char* g_ = (3 * w + j_ < 13) ? (const char*)kbase + soff[j_] + (size_t)(k0_) * 192 : (const char*)vbase + soff[j_] + (size_t)(k0_) * 2; \
    __builtin_amdgcn_global_load_lds((const unsigned*)g_, (LAS unsigned*)(lds + (bufi) * BUF + (3 * w + j_) * 1024), 16, 0, 0); } } while (0)
  for (int it = blockIdx.x; it < 544; it += gridDim.x) {
    if (SAFE && p.aflag[it] == 0u) continue;
    bool wbad = false;
    int b, h, q0, nk, nq;
    if (it < 512) { b = it >> 7; h = (it >> 4) & 7; q0 = 256 + (it & 15) * 512; nk = NKEY; nq = 512; }
    else { const int i2 = it - 512; b = i2 >> 3; h = i2 & 7; q0 = 0; nk = 256; nq = 256; }
    const size_t bh = (size_t)(b * 8 + h);
    const int qw = 64 * w;
    const bool wact = qw < nq;
    const int qbase = q0 + (wact ? qw : 0) + r;
    bf16x8 qf[2][6];
#pragma unroll
    for (int qb = 0; qb < 2; ++qb) {
      const bf16_t* qp = Qall + (bh * NKEY + qbase + 32 * qb) * 96 + 8 * hh;
#pragma unroll
      for (int c = 0; c < 6; ++c) qf[qb][c] = *(const bf16x8*)(qp + 16 * c);
    }
    f32x16 o[2][2];
#pragma unroll
    for (int qb = 0; qb < 2; ++qb)
#pragma unroll
      for (int i = 0; i < 16; ++i) { o[qb][0][i] = 0.f; o[qb][1][i] = 0.f; }
    float mrun[2] = {0.f, 0.f}, lrun[2] = {0.f, 0.f};
    const bf16_t* kbase = Kall + bh * NKEY * 96;
    const bf16_t* vbase = Vt + bh * 64 * NKEY;
    ATT_STAGE(0, 0);
    asm volatile("s_waitcnt vmcnt(0)" ::: "memory");
    __syncthreads();
    const int ntile = nk >> 6;
    for (int i = 0; i < ntile; ++i) {
      const bool more = (i + 1 < ntile);
      if (more) ATT_STAGE((i + 1) & 1, (i + 1) * 64);
      LAS unsigned char* kb_ = lds + (i & 1) * BUF;
      LAS unsigned char* vb_ = kb_ + KBYTES;
      f32x16 s[2][2];
#pragma unroll
      for (int qb = 0; qb < 2; ++qb)
#pragma unroll
        for (int e = 0; e < 16; ++e) { s[qb][0][e] = 0.f; s[qb][1][e] = 0.f; }
#pragma unroll
      for (int c = 0; c < 6; ++c) {
        const bf16x8 ka = *(const LAS bf16x8*)(kb_ + (r * KROW + 16 * c + 8 * hh) * 2);
        const bf16x8 kb2 = *(const LAS bf16x8*)(kb_ + ((32 + r) * KROW + 16 * c + 8 * hh) * 2);
#pragma unroll
        for (int qb = 0; qb < 2; ++qb) {
          s[qb][0] = __builtin_amdgcn_mfma_f32_32x32x16_bf16(ka, qf[qb][c], s[qb][0], 0, 0, 0);
          s[qb][1] = __builtin_amdgcn_mfma_f32_32x32x16_bf16(kb2, qf[qb][c], s[qb][1], 0, 0, 0);
        }
      }
#pragma unroll
      for (int qb = 0; qb < 2; ++qb) {
        if (SAFE || i == 0) {
          float mx = fmaxf(s[qb][0][0], s[qb][1][0]);
#pragma unroll
          for (int e = 1; e < 16; ++e) mx = fmaxf(mx, fmaxf(s[qb][0][e], s[qb][1][e]));
          mx = fmaxf(mx, __shfl_xor(mx, 32));
          const bool need = (i == 0) || (mx - mrun[qb] > 8.f);
          if (__builtin_amdgcn_ballot_w64(need) != 0ull) {
            const float nm = need ? mx : mrun[qb];
            const float alpha = (i == 0) ? 1.f : ex2(mrun[qb] - nm);
            mrun[qb] = nm; lrun[qb] *= alpha;
#pragma unroll
            for (int e = 0; e < 16; ++e) { o[qb][0][e] *= alpha; o[qb][1][e] *= alpha; }
          }
        }
        f32x2 ps2 = {0.f, 0.f};
        const f32x2 m2 = {mrun[qb], mrun[qb]};
#pragma unroll
        for (int kb = 0; kb < 2; ++kb)
#pragma unroll
          for (int e = 0; e < 16; e += 2) {
            f32x2 t = {s[qb][kb][e], s[qb][kb][e + 1]};
            t = t - m2;
            t.x = ex2(t.x); t.y = ex2(t.y);
            ps2 += t;
            s[qb][kb][e] = t.x; s[qb][kb][e + 1] = t.y;
          }
        lrun[qb] += ps2.x + ps2.y;
        if (!SAFE) wbad = wbad || !(ps2.x + ps2.y < 1.2089258e24f);
      }
#pragma unroll
      for (int kb = 0; kb < 2; ++kb)
#pragma unroll
        for (int t = 0; t < 2; ++t) {
          const int kofs = 32 * kb + 16 * t + 4 * hh;
          u32x4 va, vb2;
          { const u32x2 lo = *(const LAS u32x2*)(vb_ + (r * VROW + kofs) * 2), hi = *(const LAS u32x2*)(vb_ + (r * VROW + kofs + 8) * 2); va.x = lo.x; va.y = lo.y; va.z = hi.x; va.w = hi.y; }
          { const u32x2 lo = *(const LAS u32x2*)(vb_ + ((32 + r) * VROW + kofs) * 2), hi = *(const LAS u32x2*)(vb_ + ((32 + r) * VROW + kofs + 8) * 2); vb2.x = lo.x; vb2.y = lo.y; vb2.z = hi.x; vb2.w = hi.y; }
#pragma unroll
          for (int qb = 0; qb < 2; ++qb) {
            u32x4 pw;
            pw.x = pk2(s[qb][kb][8 * t], s[qb][kb][8 * t + 1]); pw.y = pk2(s[qb][kb][8 * t + 2], s[qb][kb][8 * t + 3]);
            pw.z = pk2(s[qb][kb][8 * t + 4], s[qb][kb][8 * t + 5]); pw.w = pk2(s[qb][kb][8 * t + 6], s[qb][kb][8 * t + 7]);
            const bf16x8 pf = __builtin_bit_cast(bf16x8, pw);
            o[qb][0] = __builtin_amdgcn_mfma_f32_32x32x16_bf16(__builtin_bit_cast(bf16x8, va), pf, o[qb][0], 0, 0, 0);
            o[qb][1] = __builtin_amdgcn_mfma_f32_32x32x16_bf16(__builtin_bit_cast(bf16x8, vb2), pf, o[qb][1], 0, 0, 0);
          }
        }
      asm volatile("s_waitcnt vmcnt(0)" ::: "memory");
      __syncthreads();
    }
    if (!SAFE) { if (__builtin_amdgcn_ballot_w64(wbad) != 0ull && lane == 0) p.aflag[it] = 1u; }
    if (wact) {
#pragma unroll
      for (int qb = 0; qb < 2; ++qb) {
        float l = lrun[qb]; l += __shfl_xor(l, 32);
        const float il = 1.f / l;
        const int qi = qbase + 32 * qb;
        const int row = qi < 256 ? b * 256 + qi : NCTX + b * 8192 + (qi - 256);
        bf16_t* op = CAT + (size_t)row * DM + 512 + h * 64 + 4 * hh;
#pragma unroll
        for (int g = 0; g < 4; ++g) {
          u32x2 a; a.x = pk2(o[qb][0][4 * g] * il, o[qb][0][4 * g + 1] * il); a.y = pk2(o[qb][0][4 * g + 2] * il, o[qb][0][4 * g + 3] * il);
          *(u32x2*)(op + 8 * g) = a;
          u32x2 c; c.x = pk2(o[qb][1][4 * g] * il, o[qb][1][4 * g + 1] * il); c.y = pk2(o[qb][1][4 * g + 2] * il, o[qb][1][4 * g + 3] * il);
          *(u32x2*)(op + 32 + 8 * g) = c;
        }
      }
    }
  }
}
#undef ATT_STAGE

__device__ void phase_hgrn_scalar(const Params& p, int dir, const bf16_t* Qh, const bf16_t* Vv, const bf16_t* Gg, const _Float16* Lx, bf16_t* O, float* sm) {
  float* sf = sm; float* sk = sm + 128; float* sq = sm + 256; float* part = sm + 384;   float* red = sm + 896;
  const int tid = threadIdx.x, dv = tid & 127, kg = tid >> 7;
  for (int it = blockIdx.x; it < 32; it += gridDim.x) {
    const int b = it >> 3, h = it & 7;
    float S[32];
#pragma unroll
    for (int i = 0; i < 32; ++i) S[i] = 0.f;
    for (int n = 0; n < NKEY; ++n) {
      int r; bool latent = n >= 256;
      if (!latent) r = b * 256 + (dir == 0 ? n : 255 - n);
      else r = NCTX + b * 8192 + (dir == 0 ? (n - 256) : (8191 - (n - 256)));
      const size_t off = (size_t)r * DM + h * 128;
      if (tid < 128) {
        const float f = __expf((float)Lx[off + tid]);
        sf[tid] = f; sk[tid] = 1.f - f; sq[tid] = bf2f(Qh[off + tid]);
      }
      __syncthreads();
      const float v = bf2f(Vv[off + dv]);
      float po = 0.f;
#pragma unroll
      for (int i = 0; i < 32; ++i) { const int dk = kg * 32 + i; S[i] = sf[dk] * S[i] + sk[dk] * v; po += S[i] * sq[dk]; }
      if (latent) {
        part[kg * 128 + dv] = po;
        __syncthreads();
        if (tid < 128) {
          float o = part[tid] + part[128 + tid] + part[256 + tid] + part[384 + tid];
          if (dir == 0) O[off + tid] = f2bf(o);
          else {
            o += bf2f(O[off + tid]);
            float ss = wave_sum(o * o);
            if ((tid & 63) == 0) red[tid >> 6] = ss;
            part[tid] = o;
          }
        }
        __syncthreads();
        if (dir == 1 && tid < 128) {
          const float o = part[tid];
          const float rstd = rsqrtf((red[0] + red[1]) * (1.f / 128.f) + 1e-6f);
          const float g = bf2f(Gg[off + tid]);
          O[off + tid] = f2bf(o * rstd * p.g_norm_g[tid] * g * sigmoidf_(g));
        }
      }
      __syncthreads();
    }
  }
}

template <bool OUT>
__device__ void phase_hgrn(const Params& p, const bf16_t* Qh, const bf16_t* Vv, const _Float16* Lfb, bf16_t* Of, bf16_t* Ob, float* Sseg, float* Dlog, LAS unsigned char* lds) {
  constexpr int NSEG = 4, CPS = 33, NIT = OUT ? 64 * NSEG : 64 * (NSEG - 1);
  constexpr int QT = 0, KT = QT + 64 * 136 * 2, KE = KT + 64 * 136 * 2, VT = KE + 128 * 72 * 2, AT = VT + 128 * 72 * 2,
                ST = AT + 64 * 72 * 2, DC = ST + 128 * 136 * 2, TOT = DC + 512;
  const int tid = threadIdx.x, w = tid >> 6, lane = tid & 63, r = lane & 31, hh = lane >> 5;
  const int dk = tid & 127, tq = tid >> 7;
  const int dvb = w & 3, wh = w >> 2;
  for (int it = blockIdx.x; it < NIT; it += gridDim.x) {
    const int bhd = OUT ? it >> 2 : it / 3, sg = OUT ? it & 3 : it % 3;
    const int b = bhd >> 4, h = (bhd >> 1) & 7, dir = bhd & 1;
    const int c_begin = sg * CPS, c_end = c_begin + CPS;
    const _Float16* Lx = Lfb + (size_t)dir * ((size_t)M_ALL * DM);
    const int sgn = dir ? -1 : 1;
    f32x16 S0, S1;
#pragma unroll
    for (int e = 0; e < 16; ++e) { S0[e] = 0.f; S1[e] = 0.f; }
    if constexpr (OUT) {
      for (int sp = 0; sp < sg; ++sp) {
        const float* sp_ = Sseg + ((size_t)(bhd * 3 + sp) * 8 + w) * 2048;
        const float* dl = Dlog + (size_t)(bhd * 3 + sp) * 128;
#pragma unroll
        for (int g = 0; g < 4; ++g) {
          const f32x4 d0 = *(const f32x4*)(dl + 32 * (2 * wh) + 8 * g + 4 * hh), d1 = *(const f32x4*)(dl + 32 * (2 * wh + 1) + 8 * g + 4 * hh);
#pragma unroll
          for (int j = 0; j < 4; ++j) {
            S0[4 * g + j] = S0[4 * g + j] * __expf(d0[j]) + sp_[(4 * g + j) * 64 + lane];
            S1[4 * g + j] = S1[4 * g + j] * __expf(d1[j]) + sp_[1024 + (4 * g + j) * 64 + lane];
          }
        }
      }
#pragma unroll
      for (int g = 0; g < 4; ++g) {
        u32x2 a0; a0.x = pk2(S0[4 * g], S0[4 * g + 1]); a0.y = pk2(S0[4 * g + 2], S0[4 * g + 3]);
        *(LAS u32x2*)(lds + ST + ((32 * dvb + r) * 136 + 32 * (2 * wh) + 8 * g + 4 * hh) * 2) = a0;
        u32x2 a1; a1.x = pk2(S1[4 * g], S1[4 * g + 1]); a1.y = pk2(S1[4 * g + 2], S1[4 * g + 3]);
        *(LAS u32x2*)(lds + ST + ((32 * dvb + r) * 136 + 32 * (2 * wh + 1) + 8 * g + 4 * hh) * 2) = a1;
      }
    }
    float dsum = 0.f;
    _Float16 lfr[16]; bf16_t qr[16], vr[16];
    {
      const int cn = c_begin;
      const int rb0 = (cn < 4) ? b * 256 + (dir ? 255 - 64 * cn : 64 * cn) : NCTX + b * 8192 + (dir ? 8191 - 64 * (cn - 4) : 64 * (cn - 4));
      const size_t o0 = (size_t)(rb0 + sgn * 16 * tq) * DM + h * 128 + dk;
#pragma unroll
      for (int i = 0; i < 16; ++i) { const size_t o = o0 + (ptrdiff_t)(sgn * i) * DM; lfr[i] = Lx[o]; if constexpr (OUT) qr[i] = Qh[o]; else qr[i] = 0; vr[i] = Vv[o]; }
    }
    __syncthreads();
    for (int c = c_begin; c < c_end; ++c) {
      const int rbase = (c < 4) ? b * 256 + (dir ? 255 - 64 * c : 64 * c) : NCTX + b * 8192 + (dir ? 8191 - 64 * (c - 4) : 64 * (c - 4));
      float lf[16], cs[16];
      float run = 0.f;
#pragma unroll
      for (int i = 0; i < 16; ++i) { lf[i] = (float)lfr[i]; run += lf[i]; cs[i] = run; }
      *(LAS float*)(lds + TOT + (tq * 128 + dk) * 4) = run;
      __syncthreads();
      float offs = 0.f, blast = 0.f;
#pragma unroll
      for (int g = 0; g < 4; ++g) { const float t = *(const LAS float*)(lds + TOT + (g * 128 + dk) * 4); blast += t; if (g < tq) offs += t; }
      {
        unsigned kew[8], vw[8];
#pragma unroll
        for (int i = 0; i < 16; i += 2) {
          float qt[2], kt[2], ke[2];
#pragma unroll
          for (int e = 0; e < 2; ++e) {
            const float bb = offs + cs[i + e];
            const float k = 1.f - __expf(lf[i + e]);
            if constexpr (OUT) { qt[e] = bf2f(qr[i + e]) * __expf(bb); kt[e] = k * __expf(-bb); }
            ke[e] = k * __expf(blast - bb);
          }
          if constexpr (OUT) {
            const unsigned qp = pk2(qt[0], qt[1]), kp = pk2(kt[0], kt[1]);
            const int s = 16 * tq + i;
            *(LAS bf16_t*)(lds + QT + (s * 136 + dk) * 2) = (bf16_t)(qp & 0xffffu);
            *(LAS bf16_t*)(lds + QT + ((s + 1) * 136 + dk) * 2) = (bf16_t)(qp >> 16);
            *(LAS bf16_t*)(lds + KT + (s * 136 + dk) * 2) = (bf16_t)(kp & 0xffffu);
            *(LAS bf16_t*)(lds + KT + ((s + 1) * 136 + dk) * 2) = (bf16_t)(kp >> 16);
          }
          kew[i >> 1] = pk2(ke[0], ke[1]);
          vw[i >> 1] = (unsigned)vr[i] | ((unsigned)vr[i + 1] << 16);
        }
        *(LAS u32x4*)(lds + KE + (dk * 72 + 16 * tq) * 2) = (u32x4){kew[0], kew[1], kew[2], kew[3]};
        *(LAS u32x4*)(lds + KE + (dk * 72 + 16 * tq + 8) * 2) = (u32x4){kew[4], kew[5], kew[6], kew[7]};
        *(LAS u32x4*)(lds + VT + (dk * 72 + 16 * tq) * 2) = (u32x4){vw[0], vw[1], vw[2], vw[3]};
        *(LAS u32x4*)(lds + VT + (dk * 72 + 16 * tq + 8) * 2) = (u32x4){vw[4], vw[5], vw[6], vw[7]};
        if (tq == 0) *(LAS float*)(lds + DC + dk * 4) = __expf(blast);
        dsum += blast;
      }
      __syncthreads();
      if (c + 1 < c_end) {
        const int cn = c + 1;
        const int rb = (cn < 4) ? b * 256 + (dir ? 255 - 64 * cn : 64 * cn) : NCTX + b * 8192 + (dir ? 8191 - 64 * (cn - 4) : 64 * (cn - 4));
        const size_t o0 = (size_t)(rb + sgn * 16 * tq) * DM + h * 128 + dk;
#pragma unroll
        for (int i = 0; i < 16; ++i) { const size_t o = o0 + (ptrdiff_t)(sgn * i) * DM; lfr[i] = Lx[o]; if constexpr (OUT) qr[i] = Qh[o]; else qr[i] = 0; vr[i] = Vv[o]; }
      }
      if (OUT && w < 3) {
        const int sb = (w == 2) ? 1 : 0, tb = (w == 0) ? 0 : 1;
        f32x16 a;
#pragma unroll
        for (int e = 0; e < 16; ++e) a[e] = 0.f;
#pragma unroll
        for (int ks = 0; ks < 8; ++ks) {
          const bf16x8 ka = *(const LAS bf16x8*)(lds + KT + ((32 * sb + r) * 136 + 16 * ks + 8 * hh) * 2);
          const bf16x8 qb = *(const LAS bf16x8*)(lds + QT + ((32 * tb + r) * 136 + 16 * ks + 8 * hh) * 2);
          a = __builtin_amdgcn_mfma_f32_32x32x16_bf16(ka, qb, a, 0, 0, 0);
        }
        const int tok = 32 * tb + r;
#pragma unroll
        for (int g = 0; g < 4; ++g) {
          const int s0 = 32 * sb + 8 * g + 4 * hh;
          const float v0 = (s0 + 0 <= tok) ? a[4 * g + 0] : 0.f, v1 = (s0 + 1 <= tok) ? a[4 * g + 1] : 0.f;
          const float v2 = (s0 + 2 <= tok) ? a[4 * g + 2] : 0.f, v3 = (s0 + 3 <= tok) ? a[4 * g + 3] : 0.f;
          u32x2 o; o.x = pk2(v0, v1); o.y = pk2(v2, v3);
          *(LAS u32x2*)(lds + AT + (tok * 72 + s0) * 2) = o;
        }
      }
      {
#pragma unroll
        for (int g = 0; g < 4; ++g) {
          const f32x4 d0 = *(const LAS f32x4*)(lds + DC + (32 * (2 * wh) + 8 * g + 4 * hh) * 4);
          const f32x4 d1 = *(const LAS f32x4*)(lds + DC + (32 * (2 * wh + 1) + 8 * g + 4 * hh) * 4);
#pragma unroll
          for (int j = 0; j < 4; ++j) { S0[4 * g + j] *= d0[j]; S1[4 * g + j] *= d1[j]; }
        }
#pragma unroll
        for (int ks = 0; ks < 4; ++ks) {
          const bf16x8 vb = *(const LAS bf16x8*)(lds + VT + ((32 * dvb + r) * 72 + 16 * ks + 8 * hh) * 2);
          const bf16x8 k0 = *(const LAS bf16x8*)(lds + KE + ((32 * (2 * wh) + r) * 72 + 16 * ks + 8 * hh) * 2);
          const bf16x8 k1 = *(const LAS bf16x8*)(lds + KE + ((32 * (2 * wh + 1) + r) * 72 + 16 * ks + 8 * hh) * 2);
          S0 = __builtin_amdgcn_mfma_f32_32x32x16_bf16(k0, vb, S0, 0, 0, 0);
          S1 = __builtin_amdgcn_mfma_f32_32x32x16_bf16(k1, vb, S1, 0, 0, 0);
        }
      }
      if constexpr (OUT) {
      __syncthreads();
      {
        const int tb = wh;
        f32x16 o;
#pragma unroll
        for (int e = 0; e < 16; ++e) o[e] = 0.f;
#pragma unroll
        for (int ks = 0; ks < 4; ++ks) {
          if (ks < 2 * (tb + 1)) {
            const bf16x8 va = *(const LAS bf16x8*)(lds + VT + ((32 * dvb + r) * 72 + 16 * ks + 8 * hh) * 2);
            const bf16x8 ab = *(const LAS bf16x8*)(lds + AT + ((32 * tb + r) * 72 + 16 * ks + 8 * hh) * 2);
            o = __builtin_amdgcn_mfma_f32_32x32x16_bf16(va, ab, o, 0, 0, 0);
          }
        }
#pragma unroll
        for (int ks = 0; ks < 8; ++ks) {
          const bf16x8 sa = *(const LAS bf16x8*)(lds + ST + ((32 * dvb + r) * 136 + 16 * ks + 8 * hh) * 2);
          const bf16x8 qb = *(const LAS bf16x8*)(lds + QT + ((32 * tb + r) * 136 + 16 * ks + 8 * hh) * 2);
          o = __builtin_amdgcn_mfma_f32_32x32x16_bf16(sa, qb, o, 0, 0, 0);
        }
        if (c >= 4) {
          const int row = rbase + sgn * (32 * tb + r);
          bf16_t* op = (dir ? Ob + (size_t)(row - NCTX) * DM : Of + (size_t)row * DM) + h * 128 + 32 * dvb + 4 * hh;
#pragma unroll
          for (int g = 0; g < 4; ++g) {
            u32x2 ov; ov.x = pk2(o[4 * g], o[4 * g + 1]); ov.y = pk2(o[4 * g + 2], o[4 * g + 3]);
            *(u32x2*)(op + 8 * g) = ov;
          }
        }
      }
      __syncthreads();
#pragma unroll
      for (int g = 0; g < 4; ++g) {
        u32x2 a0; a0.x = pk2(S0[4 * g], S0[4 * g + 1]); a0.y = pk2(S0[4 * g + 2], S0[4 * g + 3]);
        *(LAS u32x2*)(lds + ST + ((32 * dvb + r) * 136 + 32 * (2 * wh) + 8 * g + 4 * hh) * 2) = a0;
        u32x2 a1; a1.x = pk2(S1[4 * g], S1[4 * g + 1]); a1.y = pk2(S1[4 * g + 2], S1[4 * g + 3]);
        *(LAS u32x2*)(lds + ST + ((32 * dvb + r) * 136 + 32 * (2 * wh + 1) + 8 * g + 4 * hh) * 2) = a1;
      }
      }
    }
    if constexpr (!OUT) {
      float* sp_ = Sseg + ((size_t)(bhd * 3 + sg) * 8 + w) * 2048;
#pragma unroll
      for (int e = 0; e < 16; ++e) { sp_[e * 64 + lane] = S0[e]; sp_[1024 + e * 64 + lane] = S1[e]; }
      if (tq == 0) Dlog[(size_t)(bhd * 3 + sg) * 128 + dk] = dsum;
    }
    __syncthreads();
  }
}

__device__ void phase_hgrn_readout(const Params& p, bf16_t* Of, const bf16_t* Ob, const bf16_t* Gg) {
  const int wave = threadIdx.x >> 6, lane = threadIdx.x & 63;
  for (int r = NCTX + blockIdx.x * 8 + wave; r < M_ALL; r += gridDim.x * 8) {
    const int c0 = lane * 16;
    float o[16];
#pragma unroll
    for (int i = 0; i < 2; ++i) {
      const u32x4 a = *(const u32x4*)(Of + (size_t)r * DM + c0 + 8 * i), bq = *(const u32x4*)(Ob + (size_t)(r - NCTX) * DM + c0 + 8 * i);
#pragma unroll
      for (int e = 0; e < 4; ++e) { o[8 * i + 2 * e] = lo2f(a[e]) + lo2f(bq[e]); o[8 * i + 2 * e + 1] = hi2f(a[e]) + hi2f(bq[e]); }
    }
    float ss = 0.f;
#pragma unroll
    for (int i = 0; i < 16; ++i) ss += o[i] * o[i];
    ss += __shfl_xor(ss, 1); ss += __shfl_xor(ss, 2); ss += __shfl_xor(ss, 4);
    const float rstd = rsqrtf(ss * (1.f / 128.f) + 1e-6f);
    const int cg = c0 & 127;
#pragma unroll
    for (int i = 0; i < 2; ++i) {
      const u32x4 gq = *(const u32x4*)(Gg + (size_t)r * DM + c0 + 8 * i);
      float y[8];
#pragma unroll
      for (int e = 0; e < 8; ++e) {
        const float g = (e & 1) ? hi2f(gq[e >> 1]) : lo2f(gq[e >> 1]);
        y[e] = o[8 * i + e] * rstd * p.g_norm_g[cg + 8 * i + e] * g * sigmoidf_(g);
      }
      u32x4 ov; ov.x = pk2(y[0], y[1]); ov.y = pk2(y[2], y[3]); ov.z = pk2(y[4], y[5]); ov.w = pk2(y[6], y[7]);
      *(u32x4*)(Of + (size_t)r * DM + c0 + 8 * i) = ov;
    }
  }
}

#define XB_TMO      128
#define XB_XCNT(j)  (256  + 64 * (j))
#define XB_XSUB(j)  (1280 + 64 * (j))
#define XB_XGEN(j)  (2304 + 64 * (j))
#define XB_TOP      3328
#define XB_TOPGEN   3392
#define XCD_BAR_WORDS 3456
#define XB_SPIN_CAP (1u << 22)
__device__ __forceinline__ unsigned xb_ld(unsigned* p)              { return __hip_atomic_load(p, __ATOMIC_RELAXED, __HIP_MEMORY_SCOPE_AGENT); }
__device__ __forceinline__ unsigned xb_add(unsigned* p, unsigned v) { return __hip_atomic_fetch_add(p, v, __ATOMIC_RELAXED, __HIP_MEMORY_SCOPE_AGENT); }
__device__ __forceinline__ unsigned xb_xcc_id() { return (unsigned)__builtin_amdgcn_s_getreg((3 << 11) | 20) & 0xFu; }
#define XB_SPIN(cond, bar) do { unsigned _sp = 0; while (cond) { __builtin_amdgcn_s_sleep(1); \
    if ((++_sp & 255u) == 0u) { if (xb_ld(&(bar)[XB_TMO])) break; if (_sp > XB_SPIN_CAP) { atomicAdd(&(bar)[XB_TMO], 1u); break; } } } } while (0)
__device__ __forceinline__ void xcd_barrier_complete(unsigned* bar, unsigned x, unsigned& nloc, unsigned& nx) {
  const unsigned G = gridDim.x * gridDim.y * gridDim.z;
  unsigned sum, cnt, mine, sp = 0u;
  for (;;) {
    sum = 0u; cnt = 0u; mine = 0u;
#pragma unroll
    for (unsigned j = 0; j < 16; ++j) { const unsigned c = xb_ld(&bar[XB_XCNT(j)]); sum += c; cnt += (c > 0u) ? 1u : 0u; mine = (j == x) ? c : mine; }
    if (sum == G) break;
    __builtin_amdgcn_s_sleep(1);
    if ((++sp & 255u) == 0u) { if (xb_ld(&bar[XB_TMO])) break; if (sp > XB_SPIN_CAP) { atomicAdd(&bar[XB_TMO], 1u); break; } }
  }
  nloc = mine > 0u ? mine : 1u; nx = cnt > 0u ? cnt : 1u;
}
__device__ __forceinline__ void xcd_barrier(unsigned* bar, volatile LAS unsigned* st) {
  asm volatile("s_waitcnt vmcnt(0)" ::: "memory");
  __syncthreads();
  if (threadIdx.x == 0) {
    const unsigned x = xb_xcc_id();
    __builtin_amdgcn_s_waitcnt(0);
    unsigned nloc = st[0], nx = st[1];
    if (nloc == 0u) { xcd_barrier_complete(bar, x, nloc, nx); st[0] = nloc; st[1] = nx; }
    const unsigned old = xb_add(&bar[XB_XSUB(x)], 1u);
    const unsigned gen = old / nloc;
    if (old + 1u == (gen + 1u) * nloc) {
      __builtin_amdgcn_fence(__ATOMIC_RELEASE, "agent");
      asm volatile("s_waitcnt vmcnt(0)" ::: "memory");
      const unsigned og = xb_add(&bar[XB_TOP], 1u);
      const unsigned tg = og / nx;
      if (og + 1u == (tg + 1u) * nx) xb_add(&bar[XB_TOPGEN], 1u);
      else XB_SPIN(xb_ld(&bar[XB_TOPGEN]) == tg, bar);
      __builtin_amdgcn_fence(__ATOMIC_ACQUIRE, "agent");
      xb_add(&bar[XB_XGEN(x)], 1u);
      asm volatile("s_waitcnt vmcnt(0)" ::: "memory");
    } else {
      XB_SPIN(xb_ld(&bar[XB_XGEN(x)]) == gen, bar);
      __builtin_amdgcn_fence(__ATOMIC_ACQUIRE, "agent");
      asm volatile("s_waitcnt vmcnt(0)" ::: "memory");
    }
  }
  __syncthreads();
}


template <int PH>
__device__ __forceinline__ void run_phase(const Params& p, bf16_t* shm_) {
  float* smf = (float*)shm_;
  LAS unsigned char* shm = (LAS unsigned char*)shm_;
  const size_t MR = (size_t)M_ALL;
  bf16_t* G = (bf16_t*)p.R;
  bf16_t* P = (bf16_t*)p.R;
  bf16_t* Qall = P + MR * 2048;
  bf16_t* Kall = Qall + (size_t)32 * NKEY * 96;
  bf16_t* Vt = Kall + (size_t)32 * NKEY * 96;
  bf16_t* Qh = (bf16_t*)p.R;
  bf16_t* Vv = Qh + MR * DM;
  bf16_t* Gg = Vv + MR * DM;
  _Float16* Lf = (_Float16*)(Gg + MR * DM);
  _Float16* Lb = Lf + MR * DM;
  const size_t MODL = (size_t)5 * 9216;
  float* PARTF = (float*)(G + MR * DFF);
  float* PARTE = (float*)(Vt + (size_t)32 * 64 * NKEY);
  const float* CG = p.mod + (size_t)4 * 9 * 1024;
  if constexpr (PH == 0) phase_prep(p, smf);
  if constexpr (PH == 1) phase_norm(p, 0, 0, p.ctx, p.x, 0);
  if constexpr (PH == 2) gemm_phase(p.U, DM, p.W13[0], DM, DM, 0, 132, 0, 22, EpiSwiglu{G}, shm);
  if constexpr (PH == 3) gemm_phase(G, DFF, p.W2[0], DFF, DFF, 4, 128, 0, 4, EpiResid{p.ctx, p.x, p.XC, p.out, p.mod + 2 * 1024, 0.5f}, shm, 4, 11, EpiPart{PARTF});
  if constexpr (PH == 4) phase_norm(p, 0, 1, p.ctx, p.out, 0, PARTF, 11, 0.5f, CG + 2 * 1024);
  if constexpr (PH == 5) gemm_phase(p.U, DM, p.WinE, DM, DM, 0, 132, 0, 8, EpiP{P, p.RS}, shm);
  if constexpr (PH == 6) { gemm_phase(P + 1536, 2048, p.Wqkv, 2048, 384, 0, 132, 0, 7, EpiQKV{EpiQ{p.RS, p.rope, Qall}, EpiKV{p.RS, Kall, Vt}}, shm);
                           phase_even_elem(p, P, p.U, Kall); }
  if constexpr (PH == 7) phase_attn<false>(p, Qall, Kall, Vt, p.U, shm);
  if constexpr (PH == 25) phase_attn<true>(p, Qall, Kall, Vt, p.U, shm);
  if constexpr (PH == 8) gemm_phase(p.U, DM, p.WoutE, DM, DM, 4, 128, 0, 4, EpiResid{p.XC, p.out, p.XC, p.out, p.mod + 5 * 1024, 1.0f}, shm, 4, 4, EpiPart{PARTE});
  if constexpr (PH == 9) phase_norm(p, 0, 2, p.XC, p.out, 0, PARTE, 4, 1.0f, CG + 5 * 1024);
  if constexpr (PH == 10) gemm_phase(p.U, DM, p.W13[1], DM, DM, 0, 132, 0, 22, EpiSwiglu{G}, shm);
  if constexpr (PH == 11) gemm_phase(G, DFF, p.W2[1], DFF, DFF, 4, 128, 0, 4, EpiResid{p.XC, p.out, p.XC, p.out, p.mod + 8 * 1024, 0.5f}, shm, 4, 11, EpiPart{PARTF});
  if constexpr (PH == 12) phase_norm(p, 1, 0, p.XC, p.out, 0, PARTF, 11, 0.5f, CG + 8 * 1024);
  if constexpr (PH == 13) gemm_phase(p.U, DM, p.W13[2], DM, DM, 0, 132, 0, 22, EpiSwiglu{G}, shm);
  if constexpr (PH == 14) gemm_phase(G, DFF, p.W2[2], DFF, DFF, 4, 128, 0, 4, EpiResid{p.XC, p.out, p.XC, p.out, p.mod + MODL + 2 * 1024, 0.5f}, shm, 4, 11, EpiPart{PARTF});
  if constexpr (PH == 15) phase_norm(p, 1, 1, p.XC, p.out, 0, PARTF, 11, 0.5f, CG + MODL + 2 * 1024);
  if constexpr (PH == 16) gemm_phase(p.U, DM, p.WinO, DM, DM, 0, 132, 0, 20, EpiOdd{Qh, Vv, Gg, Lf, Lb, p.lb_logits}, shm);
  bf16_t* Ob = (bf16_t*)(Lb + MR * DM);
  float* Sseg = (float*)(Ob + (size_t)32768 * DM);
  float* Dlg = Sseg + (size_t)192 * 16384;
  if constexpr (PH == 17) phase_hgrn<false>(p, Qh, Vv, Lf, p.U, Ob, Sseg, Dlg, shm);
  if constexpr (PH == 18) phase_hgrn<true>(p, Qh, Vv, Lf, p.U, Ob, Sseg, Dlg, shm);
  if constexpr (PH == 24) phase_hgrn_readout(p, p.U, Ob, Gg);
  if constexpr (PH == 19) gemm_phase(p.U, DM, p.WoutO, DM, DM, 4, 128, 0, 4, EpiResid{p.XC, p.out, p.XC, p.out, p.mod + MODL + 5 * 1024, 1.0f}, shm);
  if constexpr (PH == 20) phase_norm(p, 1, 2, p.XC, p.out, NCTX);
  if constexpr (PH == 21) gemm_phase(p.U, DM, p.W13[3], DM, DM, 4, 128, 0, 22, EpiSwiglu{G}, shm);
  if constexpr (PH == 22) gemm_phase(G, DFF, p.W2[3], DFF, DFF, 4, 128, 0, 4, EpiResid{p.XC, p.out, p.XC, p.out, p.mod + MODL + 8 * 1024, 0.5f}, shm);
  if constexpr (PH == 23) phase_final_norm(p);
}

constexpr int N_PHASES = 24;

#define PROBE_DUP -1
template <int PH>
__device__ __forceinline__ void step(const Params& p, int ph0, int ph1, bf16_t* shm) {
  if ((ph0 <= PH && PH < ph1) || (PH >= 24 && ph1 - ph0 > 1)) {
    run_phase<PH>(p, shm);
    if constexpr (PH == PROBE_DUP) { xcd_barrier(p.bar, (volatile LAS unsigned*)((LAS unsigned char*)shm + SHM_B)); run_phase<PH>(p, shm); }
    if (PH != 23 && ph1 - ph0 > 1) xcd_barrier(p.bar, (volatile LAS unsigned*)((LAS unsigned char*)shm + SHM_B));
  }
}

__global__ void __launch_bounds__(NTHR, 2) mega(Params p, int ph0, int ph1) {
  extern __shared__ __attribute__((aligned(16))) bf16_t shm[];
  if (ph1 < 0) cg::this_grid().sync();
  {
    volatile LAS unsigned* st = (volatile LAS unsigned*)((LAS unsigned char*)shm + SHM_B);
    if (threadIdx.x == 0) { st[0] = 0u; st[1] = 0u; }
    __syncthreads();
    if (threadIdx.x == 0) (void)xb_add(&p.bar[XB_XCNT(xb_xcc_id())], 1u);
  }
  step<0>(p, ph0, ph1, shm); step<1>(p, ph0, ph1, shm); step<2>(p, ph0, ph1, shm); step<3>(p, ph0, ph1, shm);
  step<4>(p, ph0, ph1, shm); step<5>(p, ph0, ph1, shm); step<6>(p, ph0, ph1, shm); step<7>(p, ph0, ph1, shm); step<25>(p, ph0, ph1, shm);
  step<8>(p, ph0, ph1, shm); step<9>(p, ph0, ph1, shm); step<10>(p, ph0, ph1, shm); step<11>(p, ph0, ph1, shm);
  step<12>(p, ph0, ph1, shm); step<13>(p, ph0, ph1, shm); step<14>(p, ph0, ph1, shm); step<15>(p, ph0, ph1, shm);
  step<16>(p, ph0, ph1, shm); step<17>(p, ph0, ph1, shm); step<18>(p, ph0, ph1, shm); step<24>(p, ph0, ph1, shm); step<19>(p, ph0, ph1, shm);
  step<20>(p, ph0, ph1, shm); step<21>(p, ph0, ph1, shm); step<22>(p, ph0, ph1, shm); step<23>(p, ph0, ph1, shm);
}

extern "C" void kernel_launch(void* const* d_in, const int* in_sizes, int n_in, void* d_out, int out_size, void* d_ws, size_t ws_size,
                              hipStream_t stream) {
  Params p{};
  const float** f = (const float**)&p;
  for (int i = 0; i < 22; ++i) f[i] = (const float*)d_in[i];
  p.out = (float*)d_out;
  char* w = (char*)d_ws; size_t off = 0;
  auto take = [&](size_t bytes) { char* r = w + off; off += (bytes + 255) & ~(size_t)255; return r; };
  p.W13[3] = (bf16_t*)take((size_t)2 * DFF * DM * 2);
  p.W2[3] = (bf16_t*)take((size_t)DM * DFF * 2);
  p.WinO = (bf16_t*)take((size_t)5120 * 1024 * 2);
  p.WoutO = (bf16_t*)take((size_t)1024 * 1024 * 2);
  p.mod = (float*)take((size_t)2 * 5 * 9216 * 4);
  p.XC = (float*)take((size_t)NCTX * DM * 4);
  p.RS = (float*)take((size_t)M_ALL * 2 * 4);
  p.rope = (float*)take((size_t)8192 * 32 * 4);
  p.bar = (unsigned*)take((size_t)XCD_BAR_WORDS * 4);
  p.aflag = (unsigned*)take((size_t)1024 * 4);
  p.U = (bf16_t*)take((size_t)M_ALL * DM * 2);
  p.R = take(0);
  {
    const size_t early = (size_t)3 * (2 * DFF * DM * 2) + (size_t)3 * (DM * DFF * 2) + (size_t)2048 * 1024 * 2 + (size_t)1792 * 2048 * 2 + (size_t)1024 * 1024 * 2;
    size_t e0 = (ws_size - early) & ~(size_t)255;
    const size_t rbytes = e0 - off;
    if (rbytes < (size_t)M_ALL * DM * 2 * 5 || ws_size - off < (size_t)M_ALL * DM * 2 * 5 + (size_t)32768 * DM * 2)
      fprintf(stderr, "workspace too small: R=%zu ws=%zu\n", rbytes, ws_size);
    if (ws_size - off < (size_t)M_ALL * DM * 2 * 5 + (size_t)32768 * DM * 2 + (size_t)192 * 16384 * 4 + 192 * 128 * 4) fprintf(stderr, "workspace too small for Sseg\n");
    off = e0;
    for (int i = 0; i < 3; ++i) p.W13[i] = (bf16_t*)take((size_t)2 * DFF * DM * 2);
    for (int i = 0; i < 3; ++i) p.W2[i] = (bf16_t*)take((size_t)DM * DFF * 2);
    p.WinE = (bf16_t*)take((size_t)2048 * 1024 * 2);
    p.Wqkv = (bf16_t*)take((size_t)1792 * 2048 * 2);
    p.WoutE = (bf16_t*)take((size_t)1024 * 1024 * 2);
  }
  static bool attr_done = false;
  if (!attr_done) { (void)hipFuncSetAttribute((const void*)mega, hipFuncAttributeMaxDynamicSharedMemorySize, SHM_B + 256); attr_done = true; }
#if 0
  for (int ph = 0; ph < N_PHASES; ++ph) {
    hipLaunchKernelGGL(mega, dim3(256), dim3(NTHR), SHM_B, stream, p, ph, ph + 1);
  }
#else
  static int grid_blocks = 0;
  if (!grid_blocks) {
    int dev = 0, cus = 0, per_cu = 0;
    hipGetDevice(&dev);
    hipDeviceGetAttribute(&cus, hipDeviceAttributeMultiprocessorCount, dev);
    hipOccupancyMaxActiveBlocksPerMultiprocessor(&per_cu, mega, NTHR, SHM_B + 256);
    if (per_cu > 1) per_cu = 1;
    grid_blocks = cus * per_cu;
  }
  int ph0 = 0, ph1 = N_PHASES;
  void* args[] = {&p, &ph0, &ph1};
  (void)hipMemsetAsync(p.bar, 0, (size_t)XCD_BAR_WORDS * 4, stream);
  hipError_t e = hipLaunchCooperativeKernel((void*)mega, dim3(grid_blocks), dim3(NTHR), args, SHM_B + 256, stream);
  if (e != hipSuccess) fprintf(stderr, "cooperative launch failed: %s (grid %d)\n", hipGetErrorString(e), grid_blocks);
#endif
}
```

```cpp
#include <hip/hip_runtime.h>
#include <hip/hip_cooperative_groups.h>
#include <cstdio>
namespace cg = cooperative_groups;

typedef unsigned short bf16_t;
typedef short bf16x8 __attribute__((ext_vector_type(8)));
typedef float f32x4 __attribute__((ext_vector_type(4)));
typedef unsigned u32x2 __attribute__((ext_vector_type(2)));
typedef unsigned u32x4 __attribute__((ext_vector_type(4)));
typedef _Float16 h16x4 __attribute__((ext_vector_type(4)));
typedef _Float16 h16x8 __attribute__((ext_vector_type(8)));

constexpr int M_ALL = 33792;
constexpr int NCTX = 1024;
constexpr int DM = 1024;
constexpr int DFF = 2816;
constexpr int NKEY = 8448;
constexpr int NTHR = 512;
constexpr float QSCALE = 0.10206207261596577f * 1.4426950408889634f;
constexpr float HSCALE = 0.08838834764831845f;

struct Params {
  const float *x, *c, *ctx, *c_ctx, *ada_w, *ada_b, *norm_g, *ffn_w1, *ffn_w3, *ffn_w2, *even_w_in, *even_conv_w,
      *q_norm_g, *w_uq, *kv_norm_g, *w_ukv, *even_w_out, *odd_w_in, *lb_logits, *g_norm_g, *odd_w_out, *final_norm_g;
  float* out;
  bf16_t *W13[4], *W2[4], *WinE, *Wqkv, *WoutE, *WinO, *WoutO;
  float *mod, *XC, *RS, *rope;
  unsigned* bar;
  unsigned* aflag;
  bf16_t* U;
  char* R;
};

__device__ __forceinline__ float bf2f(bf16_t v) { return __uint_as_float(((unsigned)v) << 16); }
typedef float f32x2 __attribute__((ext_vector_type(2)));
typedef __bf16 bf16v2 __attribute__((ext_vector_type(2)));
__device__ __forceinline__ unsigned pk2(float lo, float hi) { f32x2 v = {lo, hi}; return __builtin_bit_cast(unsigned, __builtin_convertvector(v, bf16v2)); }
__device__ __forceinline__ bf16_t f2bf(float f) { return (bf16_t)(pk2(f, 0.f) & 0xffffu); }
__device__ __forceinline__ float lo2f(unsigned u) { return __uint_as_float(u << 16); }
__device__ __forceinline__ float hi2f(unsigned u) { return __uint_as_float(u & 0xffff0000u); }
__device__ __forceinline__ float wave_sum(float v) {
#pragma unroll
  for (int o = 32; o > 0; o >>= 1) v += __shfl_xor(v, o);
  return v;
}
__device__ __forceinline__ float sigmoidf_(float a) { return __builtin_amdgcn_rcpf(1.f + __expf(-a)); }
__device__ __forceinline__ int row_mi(int r) { return r < NCTX ? 4 : ((r - NCTX) >> 13); }
__device__ __forceinline__ void row_bk(int r, int& b, int& key) {
  if (r < NCTX) { b = r >> 8; key = r & 255; } else { int rr = r - NCTX; b = rr >> 13; key = 256 + (rr & 8191); }
}

constexpr int BM = 256, BK = 64, HALF = 128, NXCD = 8, WGM = 8, HT = HALF * BK, SHM_B = 8 * HT * 2;

__device__ __forceinline__ int lds_byte(int r, int c) {
  int st = (r >> 4) * 2 + (c >> 5), rr = r & 15, cc = c & 31, ob = rr * 64 + cc * 2;
  return st * 1024 + (ob ^ (((ob >> 9) & 1) << 5));
}
__device__ __forceinline__ void stage_rc(int b, int& R, int& C) {
  int st = b / 1024, sb = b % 1024, swz = sb ^ (((sb >> 9) & 1) << 5);
  R = (st >> 1) * 16 + swz / 64; C = (st & 1) * 32 + (swz % 64) / 2;
}

#define LAS __attribute__((address_space(3)))
struct EpiNone { static constexpr bool HALFOK = false; __device__ __forceinline__ void operator()(const f32x4 (&)[2][2][4][2], int, int, int, int, int, int, int) const {} };
template <class Epi, class Epi2 = EpiNone>
__device__ __forceinline__ void gemm_phase(const bf16_t* A, int lda, const bf16_t* Bt, int ldb, int K, int pm0, int nM, int pn0, int nN,
                                           const Epi& epi, LAS unsigned char* lds, int nsm = 0, int ksl = 1, const Epi2& epi2 = Epi2()) {
  const int tid = threadIdx.x, wid = __builtin_amdgcn_readfirstlane(tid >> 6), lane = tid & 63, wr = wid >> 2, wc = wid & 3, fr = lane & 15, fq = lane >> 4;
  const int nt = K / BK;
  const int nwg = nM * nN, G = gridDim.x;
  const int nsplit = nsm * nN * ksl, nts = nt / ksl;
  if ((int)blockIdx.x >= nwg + nsplit) return;
  const int Rfull = nwg / G, Lleft = nwg - Rfull * G;
  const bool tail_split = Epi::HALFOK && nsm == 0 && Lleft > 0 && 2 * Lleft <= G;
  unsigned voffA[2], voffB[2];
#pragma unroll
  for (int i = 0; i < 2; ++i) { int R, C; stage_rc(tid * 16 + i * 8192, R, C); voffA[i] = (unsigned)(R * lda + C) * 2u; voffB[i] = (unsigned)(R * ldb + C) * 2u; }
  const size_t kstep = (size_t)(BK * 2);
  const size_t hstepA = (size_t)HALF * lda * 2, hstepB = (size_t)HALF * ldb * 2;
  const unsigned ldsw = (unsigned)wid * 1024u;
  const int aoff = lds_byte(wr * 64 + fr, fq * 8), boff = lds_byte(wc * 32 + fr, fq * 8);
#define G_SA(b, h) (((b) * 2 + (h)) * (HT * 2))
#define G_SB(b, h) ((4 + (b) * 2 + (h)) * (HT * 2))
#define G_STAGE(bufoff, gbase, voff) do { _Pragma("unroll") for (int _i = 0; _i < 2; ++_i) \
    __builtin_amdgcn_global_load_lds((const unsigned*)((const char*)(gbase) + (voff)[_i]), (LAS unsigned*)(lds + (bufoff) + ldsw + _i * 8192), 16, 0, 0); } while (0)
#define G_LDA(dst, b, h) do { _Pragma("unroll") for (int m = 0; m < 4; ++m) _Pragma("unroll") for (int k = 0; k < 2; ++k) dst[m][k] = *(const LAS bf16x8*)(lds + G_SA(b, h) + aoff + m * 2048 + k * 1024); } while (0)
#define G_LDB(dst, b, h) do { _Pragma("unroll") for (int n = 0; n < 2; ++n) _Pragma("unroll") for (int k = 0; k < 2; ++k) dst[n][k] = *(const LAS bf16x8*)(lds + G_SB(b, h) + boff + n * 2048 + k * 1024); } while (0)
#define G_MMA(ai, bj, At, Bx) do { __builtin_amdgcn_s_setprio(1); _Pragma("unroll") for (int m = 0; m < 4; ++m) _Pragma("unroll") for (int n = 0; n < 2; ++n) _Pragma("unroll") for (int k = 0; k < 2; ++k) \
    acc[ai][bj][m][n] = __builtin_amdgcn_mfma_f32_16x16x32_bf16(Bx[n][k], At[m][k], acc[ai][bj][m][n], 0, 0, 0); __builtin_amdgcn_s_setprio(0); } while (0)
#define WAIT_V(n) asm volatile("s_waitcnt vmcnt(" #n ")" ::: "memory")
#define WAIT_L(n) asm volatile("s_waitcnt lgkmcnt(" #n ")" ::: "memory")
#define BAR __builtin_amdgcn_s_barrier()
#define SCHED __builtin_amdgcn_sched_barrier(0)
  auto unit = [&](int i, int& pm, int& pn, int& sl, int& hf) -> bool {
    long L = (long)i * G + blockIdx.x; sl = -1; hf = -1;
    if (tail_split && i >= Rfull) { if (i > Rfull || (int)blockIdx.x >= 2 * Lleft) return false; L = (long)Rfull * G + (blockIdx.x >> 1); hf = blockIdx.x & 1; }
    if (L >= nwg) { const int j = (int)(L - nwg); if (j >= nsplit) return false; sl = j % ksl; const int tile = j / ksl; pm = tile / nN; pn = pn0 + tile % nN; return true; }
    int wgid = (int)L; { const int q = nwg / NXCD, r = nwg % NXCD, xcd = wgid % NXCD, off = wgid / NXCD; wgid = (xcd < r ? xcd * (q + 1) : r * (q + 1) + (xcd - r) * q) + off; }
    const int nig = WGM * nN, gid = wgid / nig, fm = gid * WGM, gsz = (nM - fm) < WGM ? (nM - fm) : WGM;
    pm = pm0 + fm + ((wgid % nig) % gsz); pn = pn0 + (wgid % nig) / gsz; return true;
  };
  int cpm, cpn, csl, chf, npm = 0, npn = 0, nsl = -1, nhf = -1, ui = 0;
  unit(0, cpm, cpn, csl, chf);
  f32x4 acc[2][2][4][2];
#pragma unroll
  for (int a = 0; a < 2; ++a)
#pragma unroll
    for (int b = 0; b < 2; ++b)
#pragma unroll
      for (int m = 0; m < 4; ++m)
#pragma unroll
        for (int n = 0; n < 2; ++n) acc[a][b][m][n] = (f32x4){0.f, 0.f, 0.f, 0.f};
  bf16x8 At[4][2], B0[2][2], B1[2][2];
  const char* cA = (const char*)A + (size_t)cpm * 2 * hstepA + (csl < 0 ? 0 : (size_t)csl * nts * kstep) + (chf > 0 ? hstepA : 0);
  size_t chA = chf < 0 ? hstepA : 0, nhA = hstepA;
  const char* cB = (const char*)Bt + (size_t)cpn * 2 * hstepB + (csl < 0 ? 0 : (size_t)csl * nts * kstep);
  G_STAGE(G_SB(0, 0), cB, voffB); G_STAGE(G_SA(0, 0), cA, voffA); G_STAGE(G_SB(0, 1), cB + hstepB, voffB); G_STAGE(G_SA(0, 1), cA + chA, voffA);
  if (wr == 1) BAR;
  WAIT_V(4); BAR;
  G_STAGE(G_SB(1, 0), cB + kstep, voffB); G_STAGE(G_SA(1, 0), cA + kstep, voffA); G_STAGE(G_SB(1, 1), cB + hstepB + kstep, voffB);
  WAIT_V(6); BAR;
#define G_KLOOP(AI1) \
    _Pragma("nounroll") \
    for (int t = 0; t < cnt; t += 2) { \
      const bool last = (t == cnt - 2); \
      const char* a1 = cA + (size_t)(t + 1) * kstep; \
      const char* a2 = last ? nA : cA + (size_t)(t + 2) * kstep; const char* b2 = last ? nB : cB + (size_t)(t + 2) * kstep; \
      const char* a3 = a2 + kstep; const char* b3 = b2 + kstep; \
      G_LDB(B0, 0, 0); SCHED; G_LDA(At, 0, 0); G_STAGE(G_SA(1, 1), a1 + chA, voffA); \
      WAIT_L(8); BAR; WAIT_L(0); G_MMA(0, 0, At, B0); BAR; SCHED; \
      G_LDB(B1, 0, 1); G_STAGE(G_SB(0, 0), b2, voffB); \
      BAR; WAIT_L(0); G_MMA(0, 1, At, B1); BAR; \
      G_LDA(At, 0, 1); G_STAGE(G_SA(0, 0), a2, voffA); \
      BAR; WAIT_L(0); if (AI1) G_MMA(1, 0, At, B0); BAR; SCHED; \
      G_STAGE(G_SB(0, 1), b2 + hstepB, voffB); \
      WAIT_V(6); BAR; if (AI1) G_MMA(1, 1, At, B1); BAR; \
      G_LDB(B0, 1, 0); SCHED; G_LDA(At, 1, 0); G_STAGE(G_SA(0, 1), a2 + (last ? nhA : chA), voffA); \
      WAIT_L(8); BAR; WAIT_L(0); G_MMA(0, 0, At, B0); BAR; SCHED; \
      G_LDB(B1, 1, 1); G_STAGE(G_SB(1, 0), b3, voffB); \
      BAR; WAIT_L(0); G_MMA(0, 1, At, B1); BAR; \
      G_LDA(At, 1, 1); G_STAGE(G_SA(1, 0), a3, voffA); \
      BAR; WAIT_L(0); if (AI1) G_MMA(1, 0, At, B0); BAR; SCHED; \
      G_STAGE(G_SB(1, 1), b3 + hstepB, voffB); \
      WAIT_V(6); BAR; if (AI1) G_MMA(1, 1, At, B1); BAR; \
    }
  bool pending_half = false;
  for (;;) {
    const bool has_next = unit(ui + 1, npm, npn, nsl, nhf);
    const char* nA = has_next ? (const char*)A + (size_t)npm * 2 * hstepA + (nsl < 0 ? 0 : (size_t)nsl * nts * kstep) + (nhf > 0 ? hstepA : 0) : cA;
    const char* nB = has_next ? (const char*)Bt + (size_t)npn * 2 * hstepB + (nsl < 0 ? 0 : (size_t)nsl * nts * kstep) : cB;
    nhA = has_next ? (nhf < 0 ? hstepA : 0) : chA;
    const int cnt = csl < 0 ? nt : nts;
    G_KLOOP(1)
    if (csl < 0) {
      if constexpr (Epi::HALFOK) epi(acc, cpm * BM, cpn * BM, wr, wc, fr, fq, 2);
      else epi(acc, cpm * BM, cpn * BM, wr, wc, fr, fq);
    } else epi2(acc, cpm * BM, cpn * BM, wr, wc, fr, fq, csl);
#ifndef NO_EPI_DRAIN
    WAIT_V(0);
#endif
    if (!has_next) break;
#pragma unroll
    for (int a = 0; a < 2; ++a)
#pragma unroll
      for (int b = 0; b < 2; ++b)
#pragma unroll
        for (int m = 0; m < 4; ++m)
#pragma unroll
          for (int n = 0; n < 2; ++n) acc[a][b][m][n] = (f32x4){0.f, 0.f, 0.f, 0.f};
    cpm = npm; cpn = npn; csl = nsl; chf = nhf; chA = nhA; cA = nA; cB = nB; ++ui;
    if (chf >= 0) { pending_half = true; break; }
  }
  if constexpr (Epi::HALFOK) {
    if (pending_half) {
      const char* nA = cA; const char* nB = cB; nhA = chA;
      const int cnt = nt;
      G_KLOOP(0)
      epi(acc, cpm * BM + (chf > 0 ? HALF : 0), cpn * BM, wr, wc, fr, fq, 1);
    }
  }
#undef G_KLOOP
  WAIT_V(0);
  if (wr == 0) BAR;
  BAR;
}

typedef f32x4 Acc[2][2][4][2];

struct EpiSwiglu { static constexpr bool HALFOK = true;
  bf16_t* G;
  __device__ __forceinline__ void operator()(const Acc& acc, int brow, int bcol, int wr, int wc, int fr, int fq, int nai) const {
    const int f0 = (bcol >> 1) + 32 * wc + 8 * fq;
    asm volatile("s_waitcnt vmcnt(14)" ::: "memory");
#pragma unroll
    for (int ai = 0; ai < 2; ++ai)
#pragma unroll
      for (int m = 0; m < 4; ++m) if (ai < nai) {
        const int r = brow + 128 * ai + 64 * wr + 16 * m + fr;
        u32x4 o;
#pragma unroll
        for (int bj = 0; bj < 2; ++bj) {
          const f32x4 a = acc[ai][bj][m][0], b = acc[ai][bj][m][1];
          const float g0 = a[0] * sigmoidf_(a[0]) * b[0], g1 = a[1] * sigmoidf_(a[1]) * b[1];
          const float g2 = a[2] * sigmoidf_(a[2]) * b[2], g3 = a[3] * sigmoidf_(a[3]) * b[3];
          if (bj == 0) { o.x = pk2(g0, g1); o.y = pk2(g2, g3); } else { o.z = pk2(g0, g1); o.w = pk2(g2, g3); }
        }
        *(u32x4*)(G + (size_t)r * DFF + f0) = o;
      }
  }
};

struct EpiResid { static constexpr bool HALFOK = false;
  const float *srcC, *srcL; float *dstC, *dstL; const float* gate;   float coef;
  __device__ __forceinline__ void operator()(const Acc& acc, int brow, int bcol, int wr, int wc, int fr, int fq) const {
    const float* g = gate + (size_t)row_mi(brow) * 9 * DM + bcol + 32 * wc + 4 * fq;
    f32x4 gv[2][2];
#pragma unroll
    for (int bj = 0; bj < 2; ++bj)
#pragma unroll
      for (int n = 0; n < 2; ++n) gv[bj][n] = coef * *(const f32x4*)(g + 128 * bj + 16 * n);
    const size_t rb = (size_t)(brow - NCTX + 64 * wr + fr) * DM + bcol + 32 * wc + 4 * fq;
#pragma unroll
    for (int ai = 0; ai < 2; ++ai)
#pragma unroll
      for (int mp = 0; mp < 2; ++mp) {
        f32x4 xv[2][2][2];
#pragma unroll
        for (int mm = 0; mm < 2; ++mm)
#pragma unroll
          for (int bj = 0; bj < 2; ++bj)
#pragma unroll
            for (int n = 0; n < 2; ++n)
              xv[mm][bj][n] = *(const f32x4*)(srcL + rb + (size_t)(128 * ai + 16 * (2 * mp + mm)) * DM + 128 * bj + 16 * n);
#pragma unroll
        for (int mm = 0; mm < 2; ++mm)
#pragma unroll
          for (int bj = 0; bj < 2; ++bj)
#pragma unroll
            for (int n = 0; n < 2; ++n)
              *(f32x4*)(dstL + rb + (size_t)(128 * ai + 16 * (2 * mp + mm)) * DM + 128 * bj + 16 * n) = xv[mm][bj][n] + gv[bj][n] * acc[ai][bj][2 * mp + mm][n];
      }
  }
};

struct EpiPart { static constexpr bool HALFOK = false;
  float* PART;
  __device__ __forceinline__ void operator()(const Acc& acc, int brow, int bcol, int wr, int wc, int fr, int fq, int sl) const {
#pragma unroll
    for (int ai = 0; ai < 2; ++ai)
#pragma unroll
      for (int m = 0; m < 4; ++m) {
        const int r = brow + 128 * ai + 64 * wr + 16 * m + fr;
        float* d = PART + ((size_t)sl * NCTX + r) * DM;
#pragma unroll
        for (int bj = 0; bj < 2; ++bj)
#pragma unroll
          for (int n = 0; n < 2; ++n) *(f32x4*)(d + bcol + 128 * bj + 32 * wc + 16 * n + 4 * fq) = acc[ai][bj][m][n];
      }
  }
};

struct EpiBf16 { static constexpr bool HALFOK = false;
  bf16_t* O; int ldc;
  __device__ __forceinline__ void operator()(const Acc& acc, int brow, int bcol, int wr, int wc, int fr, int fq) const {
#pragma unroll
    for (int ai = 0; ai < 2; ++ai)
#pragma unroll
      for (int m = 0; m < 4; ++m) {
        const int r = brow + 128 * ai + 64 * wr + 16 * m + fr;
#pragma unroll
        for (int bj = 0; bj < 2; ++bj)
#pragma unroll
          for (int n = 0; n < 2; ++n) {
            const int c = bcol + 128 * bj + 32 * wc + 16 * n + 4 * fq;
            f32x4 v = acc[ai][bj][m][n];
            u32x2 o; o.x = pk2(v[0], v[1]); o.y = pk2(v[2], v[3]);
            *(u32x2*)(O + (size_t)r * ldc + c) = o;
          }
      }
  }
};

struct EpiP { static constexpr bool HALFOK = true;
  bf16_t* O; float* RS;
  __device__ __forceinline__ void operator()(const Acc& acc, int brow, int bcol, int wr, int wc, int fr, int fq, int nai) const {
    asm volatile("s_waitcnt vmcnt(14)" ::: "memory");
#pragma unroll
    for (int ai = 0; ai < 2; ++ai)
#pragma unroll
      for (int m = 0; m < 4; ++m) if (ai < nai) {
        const int r = brow + 128 * ai + 64 * wr + 16 * m + fr;
        float ss0 = 0.f, ss1 = 0.f;
#pragma unroll
        for (int bj = 0; bj < 2; ++bj) {
          const int c = bcol + 128 * bj + 32 * wc + 8 * fq;
          const f32x4 v0 = acc[ai][bj][m][0], v1 = acc[ai][bj][m][1];
          const float q = v0[0] * v0[0] + v0[1] * v0[1] + v0[2] * v0[2] + v0[3] * v0[3] + v1[0] * v1[0] + v1[1] * v1[1] + v1[2] * v1[2] + v1[3] * v1[3];
          if (bj == 0) ss0 += q; else ss1 += q;
          u32x4 o; o.x = pk2(v0[0], v0[1]); o.y = pk2(v0[2], v0[3]); o.z = pk2(v1[0], v1[1]); o.w = pk2(v1[2], v1[3]);
          *(u32x4*)(O + (size_t)r * 2048 + c) = o;
        }
        if (bcol == 1536) {
          float ss = ss0 + ss1; ss += __shfl_xor(ss, 16); ss += __shfl_xor(ss, 32);
          if (fq == 0) atomicAdd(RS + 2 * r, ss);
        } else if (bcol == 1792) {
          float ss = ss0; ss += __shfl_xor(ss, 16); ss += __shfl_xor(ss, 32);
          if (fq == 0) atomicAdd(RS + 2 * r + 1, ss);
        }
      }
  }
};

struct EpiQ { static constexpr bool HALFOK = false;
  const float* RS; const float* rope;   bf16_t* Qall;
  __device__ __forceinline__ void operator()(const Acc& acc, int brow, int bcol, int wr, int wc, int fr, int fq) const {
#pragma unroll
    for (int ai = 0; ai < 2; ++ai)
#pragma unroll
      for (int m = 0; m < 4; ++m) {
        const int r = brow + 128 * ai + 64 * wr + 16 * m + fr;
        const float rstd = rsqrtf(RS[2 * r] * (1.f / 256.f) + 1e-6f) * QSCALE;
        int b, key; row_bk(r, b, key);
        const bool latent = r >= NCTX;
        const int t = (r - NCTX) & 8191;
        bf16_t* qrow = Qall + ((size_t)(b * 8) * NKEY + key) * 96 + 4 * fq;
#pragma unroll
        for (int bj = 0; bj < 2; ++bj) {
          const int c32 = bcol + 128 * bj + 32 * wc;
          const int h = c32 / 96, d32 = c32 - 96 * h;
#pragma unroll
          for (int n = 0; n < 2; ++n) {
            f32x4 v = acc[ai][bj][m][n] * rstd;
            if (d32 == 64) {
              f32x4 pv;
#pragma unroll
              for (int j = 0; j < 4; ++j) pv[j] = __shfl_xor(v[j], 32);
              if (latent) {
                const float* rp = rope + ((size_t)t * 2 + n) * 16 + 4 * (fq & 1);
                const f32x4 cs = *(const f32x4*)rp, sn = *(const f32x4*)(rp + 8);
                v = (fq < 2) ? (v * cs - pv * sn) : (pv * sn + v * cs);
              }
            }
            u32x2 o; o.x = pk2(v[0], v[1]); o.y = pk2(v[2], v[3]);
            *(u32x2*)(qrow + (size_t)h * (NKEY * 96) + d32 + 16 * n) = o;
          }
        }
      }
  }
};
struct EpiKV { static constexpr bool HALFOK = false;
  const float* RS; bf16_t *Kall, *Vt;
  __device__ __forceinline__ void operator()(const Acc& acc, int brow, int bcol, int wr, int wc, int fr, int fq) const {
#pragma unroll
    for (int ai = 0; ai < 2; ++ai)
#pragma unroll
      for (int m = 0; m < 4; ++m) {
        const int r = brow + 128 * ai + 64 * wr + 16 * m + fr;
        const float rstd = rsqrtf(RS[2 * r + 1] * (1.f / 128.f) + 1e-6f);
        int b, key; row_bk(r, b, key);
        bf16_t* krow = Kall + ((size_t)(b * 8) * NKEY + key) * 96 + 4 * fq;
        bf16_t* vrow = Vt + (size_t)(b * 8) * 64 * NKEY + key + (size_t)(4 * fq) * NKEY;
#pragma unroll
        for (int bj = 0; bj < 2; ++bj) {
          const int cc = bcol - 768 + 128 * bj + 32 * wc, h = cc >> 7, e32 = cc & 127;
#pragma unroll
          for (int n = 0; n < 2; ++n) {
            const f32x4 v = acc[ai][bj][m][n] * rstd;
            if (e32 < 64) {
              u32x2 o; o.x = pk2(v[0], v[1]); o.y = pk2(v[2], v[3]);
              *(u32x2*)(krow + (size_t)h * (NKEY * 96) + e32 + 16 * n) = o;
            } else {
              bf16_t* vp = vrow + (size_t)(h * 64 + e32 - 64 + 16 * n) * NKEY;
#pragma unroll
              for (int j = 0; j < 4; ++j) vp[(size_t)j * NKEY] = f2bf(v[j]);
            }
          }
        }
      }
  }
};

struct EpiQKV { static constexpr bool HALFOK = false;
  EpiQ q; EpiKV kv;
  __device__ __forceinline__ void operator()(const Acc& acc, int brow, int bcol, int wr, int wc, int fr, int fq) const {
    if (bcol < 768) q(acc, brow, bcol, wr, wc, fr, fq); else kv(acc, brow, bcol, wr, wc, fr, fq);
  }
};

struct EpiOdd { static constexpr bool HALFOK = true;
  bf16_t *Qh, *Vv, *Gg; _Float16 *Lf, *Lb; const float* lbl;
  __device__ __forceinline__ void operator()(const Acc& acc, int brow, int bcol, int wr, int wc, int fr, int fq, int nai) const {
    const int sec = bcol >> 10;
    const int cb = (bcol & 1023) + 32 * wc + 8 * fq;
    asm volatile("s_waitcnt vmcnt(14)" ::: "memory");
    if (sec == 2 || sec == 3) {
      const int dir = sec - 2;
      _Float16* O = Lf + (size_t)dir * ((size_t)M_ALL * DM);
#pragma unroll
      for (int bj = 0; bj < 2; ++bj) {
        const int c = cb + 128 * bj;
        f32x4 lb[2];
#pragma unroll
        for (int n = 0; n < 2; ++n) {
          const f32x4 z0 = *(const f32x4*)(lbl + dir * 1024 + c + 4 * n), z1 = *(const f32x4*)(lbl + 2048 + dir * 1024 + c + 4 * n);
#pragma unroll
          for (int j = 0; j < 4; ++j) lb[n][j] = __builtin_amdgcn_rcpf(1.f + __expf(z0[j] - z1[j]));
        }
#pragma unroll
        for (int ai = 0; ai < 2; ++ai)
#pragma unroll
          for (int m = 0; m < 4; ++m) if (ai < nai) {
            const int r = brow + 128 * ai + 64 * wr + 16 * m + fr;
            h16x8 hv;
#pragma unroll
            for (int n = 0; n < 2; ++n) {
              const f32x4 v = acc[ai][bj][m][n];
#pragma unroll
              for (int j = 0; j < 4; ++j) hv[4 * n + j] = (_Float16)__logf(lb[n][j] + (1.f - lb[n][j]) * sigmoidf_(v[j]));
            }
            *(h16x8*)(O + (size_t)r * DM + c) = hv;
          }
      }
    } else {
      bf16_t* O = Qh + (size_t)(sec == 4 ? 2 : sec) * ((size_t)M_ALL * DM);
      const float sc = sec == 0 ? HSCALE : 1.f;
#pragma unroll
      for (int ai = 0; ai < 2; ++ai)
#pragma unroll
        for (int m = 0; m < 4; ++m) if (ai < nai) {
          const int r = brow + 128 * ai + 64 * wr + 16 * m + fr;
#pragma unroll
          for (int bj = 0; bj < 2; ++bj) {
            const int c = cb + 128 * bj;
            const f32x4 v0 = acc[ai][bj][m][0] * sc, v1 = acc[ai][bj][m][1] * sc;
            u32x4 o; o.x = pk2(v0[0], v0[1]); o.y = pk2(v0[2], v0[3]); o.z = pk2(v1[0], v1[1]); o.w = pk2(v1[2], v1[3]);
            *(u32x4*)(O + (size_t)r * DM + c) = o;
          }
        }
    }
  }
};

__device__ __forceinline__ void tr_tile(const float* src, int ldn, int k0, int n0, int nv, bf16_t* dst, int ldk, int kofs, int mode, const float* kscale, float* sm) {
  const int tid = threadIdx.x;
  float v[8];
#pragma unroll
  for (int i = 0; i < 8; ++i) {
    const int e = tid + i * NTHR, k = e >> 6, n = e & 63;
    v[i] = (n < nv) ? src[(size_t)(k0 + k) * ldn + n0 + n] : 0.f;
  }
#pragma unroll
  for (int i = 0; i < 8; ++i) {
    const int e = tid + i * NTHR, k = e >> 6, n = e & 63;
    sm[k * 65 + n] = kscale ? v[i] * kscale[k0 + k] : v[i];
  }
  __syncthreads();
  {
    const int n = tid >> 3, kq = tid & 7;
    const int ng = n0 + n;
    int drow = ng;
    if (mode == 1 || mode == 2) {
      const int pn = ng >> 7, rem = ng & 127, wc = rem >> 5, r2 = rem & 31, fq = r2 >> 3, bj = (r2 >> 2) & 1, j = r2 & 3;
      drow = 256 * pn + 128 * bj + 32 * wc + 16 * (mode - 1) + 4 * fq + j;
    } else if (mode == 3) {
      const int o = ng & 31, fq = o >> 3, nn = (o >> 2) & 1, j = o & 3;
      drow = (ng & ~31) + 16 * nn + 4 * fq + j;
    }
    if (n < nv) {
      u32x4 o;
      o.x = pk2(sm[(8 * kq + 0) * 65 + n], sm[(8 * kq + 1) * 65 + n]);
      o.y = pk2(sm[(8 * kq + 2) * 65 + n], sm[(8 * kq + 3) * 65 + n]);
      o.z = pk2(sm[(8 * kq + 4) * 65 + n], sm[(8 * kq + 5) * 65 + n]);
      o.w = pk2(sm[(8 * kq + 6) * 65 + n], sm[(8 * kq + 7) * 65 + n]);
      *(u32x4*)(dst + (size_t)drow * ldk + kofs + k0 + 8 * kq) = o;
    }
  }
  __syncthreads();
}

__device__ void phase_prep(const Params& p, float* sm) {
  const int tid = threadIdx.x;
  int base = 0;
  const int bid = blockIdx.x, G = gridDim.x;
#define TRJOB(SRC, KK, NN, DST, LDK, KOFS, MODE, KS) { const int nk = (KK) / 64, nn = ((NN) + 63) / 64, tot = nk * nn; \
    int first = (bid - base % G + G) % G; \
    for (int t = first; t < tot; t += G) { const int n0_ = (t % nn) * 64; tr_tile((SRC), (NN), (t / nn) * 64, n0_, ((NN) - n0_) < 64 ? ((NN) - n0_) : 64, (DST), (LDK), (KOFS), (MODE), (KS), sm); } \
    base += tot; }
  for (int lj = 0; lj < 4; ++lj) {
    TRJOB(p.ffn_w1 + (size_t)lj * DM * DFF, DM, DFF, p.W13[lj], DM, 0, 1, nullptr);
    TRJOB(p.ffn_w3 + (size_t)lj * DM * DFF, DM, DFF, p.W13[lj], DM, 0, 2, nullptr);
    TRJOB(p.ffn_w2 + (size_t)lj * DFF * DM, DFF, DM, p.W2[lj], DFF, 0, 0, nullptr);
  }
  TRJOB(p.even_w_in, DM, 1952, p.WinE, DM, 0, 3, nullptr);
  TRJOB(p.w_uq, 256, 768, p.Wqkv, 2048, 0, 0, p.q_norm_g);
  TRJOB(p.w_ukv, 128, 1024, p.Wqkv + (size_t)768 * 2048, 2048, 256, 0, p.kv_norm_g);
  TRJOB(p.even_w_out, DM, DM, p.WoutE, DM, 0, 0, nullptr);
  TRJOB(p.odd_w_in, DM, 5120, p.WinO, DM, 0, 3, nullptr);
  TRJOB(p.odd_w_out, DM, DM, p.WoutO, DM, 0, 0, nullptr);
#undef TRJOB
  for (int i = bid * NTHR + tid; i < 96 * 1024; i += G * NTHR) p.WinE[(size_t)1952 * 1024 + i] = 0;
  for (int i = bid * NTHR + tid; i < 768 * 128; i += G * NTHR) p.Wqkv[(size_t)(i >> 7) * 2048 + 256 + (i & 127)] = 0;
  for (int i = bid * NTHR + tid; i < 1024 * 256; i += G * NTHR) p.Wqkv[(size_t)(768 + (i >> 8)) * 2048 + (i & 255)] = 0;
  for (int i = bid * NTHR + tid; i < M_ALL * 2; i += G * NTHR) p.RS[i] = 0.f;
  for (int i = bid * NTHR + tid; i < 1024; i += G * NTHR) p.aflag[i] = 0u;
  for (int i = bid * NTHR + tid; i < 8192 * 16; i += G * NTHR) {
    const int t = i >> 4, ax = (i >> 3) & 1, fi = i & 7;
    const float pos = (float)(ax == 0 ? (t >> 6) : (t & 63));
    const float ang = pos * exp2f(-(float)fi * (13.287712379549449f / 8.f));
    p.rope[(size_t)(t * 2 + ax) * 16 + fi] = cosf(ang); p.rope[(size_t)(t * 2 + ax) * 16 + 8 + fi] = sinf(ang);
  }
  {
    float* scond = sm;
    float* red = sm + 5 * 1024;
    for (int i = tid; i < 5 * 1024; i += NTHR) {
      const int mi = i >> 10, k = i & 1023;
      const float cv = mi < 4 ? p.c[mi * 1024 + k] : p.c_ctx[k];
      scond[i] = cv * sigmoidf_(cv);
    }
    __syncthreads();
    const int col = tid & 63, kg = tid >> 6;
    for (int it = G - 1 - bid; it < 2 * 144; it += G) {
      const int l = it / 144, n = (it % 144) * 64 + col;
      const float* w = p.ada_w + (size_t)l * 1024 * 9216 + n;
      float a0 = 0, a1 = 0, a2 = 0, a3 = 0, a4 = 0;
#pragma unroll 16
      for (int k = kg * 128; k < kg * 128 + 128; ++k) {
        const float wv = w[(size_t)k * 9216];
        a0 += scond[k] * wv; a1 += scond[1024 + k] * wv; a2 += scond[2048 + k] * wv; a3 += scond[3072 + k] * wv; a4 += scond[4096 + k] * wv;
      }
      red[(kg * 5 + 0) * 64 + col] = a0; red[(kg * 5 + 1) * 64 + col] = a1; red[(kg * 5 + 2) * 64 + col] = a2;
      red[(kg * 5 + 3) * 64 + col] = a3; red[(kg * 5 + 4) * 64 + col] = a4;
      __syncthreads();
      for (int i = tid; i < 5 * 64; i += NTHR) {
        const int mi = i >> 6, cc = i & 63, nn = (it % 144) * 64 + cc;
        float sacc = 0.f;
#pragma unroll
        for (int q = 0; q < 8; ++q) sacc += red[(q * 5 + mi) * 64 + cc];
        p.mod[((size_t)(l * 5 + mi)) * 9216 + nn] = sacc + p.ada_b[l * 9216 + nn];
      }
      __syncthreads();
    }
  }
}

__device__ __forceinline__ void phase_norm(const Params& p, int l, int j, const float* srcC, const float* srcL, int row0,
                           const float* PART = nullptr, int ksl = 0, float coef = 0.f, const float* pgate = nullptr) {
  constexpr int NR = 2;
  const int wave = threadIdx.x >> 6, lane = threadIdx.x & 63;
  const float* g = p.norm_g + (l * 3 + j) * 1024;
  f32x4 gv[4];
#pragma unroll
  for (int i = 0; i < 4; ++i) gv[i] = *(const f32x4*)(g + (lane + 64 * i) * 4);
  const int stride = gridDim.x * 8;
  for (int rb = row0 + blockIdx.x * 8 + wave; rb < M_ALL; rb += stride * NR) {
    f32x4 v[NR][4], sv[NR][4], hv[NR][4];
#pragma unroll
    for (int q = 0; q < NR; ++q) {
      const int rr = rb + q * stride, r = rr < M_ALL ? rr : M_ALL - 1;
      const float* src = r < NCTX ? srcC + (size_t)r * DM : srcL + (size_t)(r - NCTX) * DM;
      const float* sh = p.mod + ((size_t)(l * 5 + row_mi(r)) * 9 + 3 * j) * 1024;
#pragma unroll
      for (int i = 0; i < 4; ++i) { v[q][i] = ((const f32x4*)src)[lane + 64 * i]; hv[q][i] = ((const f32x4*)sh)[lane + 64 * i]; sv[q][i] = ((const f32x4*)(sh + 1024))[lane + 64 * i]; }
      if (ksl > 0 && r < NCTX) {
#pragma unroll
        for (int i = 0; i < 4; ++i) {
          f32x4 a = {0.f, 0.f, 0.f, 0.f};
          for (int sl = 0; sl < ksl; ++sl) a += ((const f32x4*)(PART + ((size_t)sl * NCTX + r) * DM))[lane + 64 * i];
          v[q][i] += coef * ((const f32x4*)pgate)[lane + 64 * i] * a;
        }
      }
    }
#pragma unroll
    for (int q = 0; q < NR; ++q) {
      const int rr = rb + q * stride, r = rr < M_ALL ? rr : M_ALL - 1;
      const bool live = rr < M_ALL;
      float ss = 0.f;
#pragma unroll
      for (int i = 0; i < 4; ++i) ss += v[q][i][0] * v[q][i][0] + v[q][i][1] * v[q][i][1] + v[q][i][2] * v[q][i][2] + v[q][i][3] * v[q][i][3];
      ss = wave_sum(ss);
      const float rstd = rsqrtf(ss * (1.f / 1024.f) + 1e-6f);
      if (live) {
        if (ksl > 0 && r < NCTX) {
#pragma unroll
          for (int i = 0; i < 4; ++i) ((f32x4*)(p.XC + (size_t)r * DM))[lane + 64 * i] = v[q][i];
        }
#pragma unroll
        for (int i = 0; i < 4; ++i) {
          const f32x4 u = v[q][i] * rstd * gv[i] * (1.f + sv[q][i]) + hv[q][i];
          u32x2 o; o.x = pk2(u[0], u[1]); o.y = pk2(u[2], u[3]);
          *(u32x2*)(p.U + (size_t)r * DM + (lane + 64 * i) * 4) = o;
        }
      }
    }
  }
}

__device__ __forceinline__ void phase_final_norm(const Params& p) {
  constexpr int NR = 4;
  const int wave = threadIdx.x >> 6, lane = threadIdx.x & 63;
  f32x4 gv[4];
#pragma unroll
  for (int i = 0; i < 4; ++i) gv[i] = *(const f32x4*)(p.final_norm_g + (lane + 64 * i) * 4);
  const int stride = gridDim.x * 8;
  for (int rb = blockIdx.x * 8 + wave; rb < 32768; rb += stride * NR) {
    f32x4 v[NR][4];
#pragma unroll
    for (int q = 0; q < NR; ++q) {
      const int rr = rb + q * stride, r = rr < 32768 ? rr : 32767;
#pragma unroll
      for (int i = 0; i < 4; ++i) v[q][i] = ((const f32x4*)(p.out + (size_t)r * DM))[lane + 64 * i];
    }
#pragma unroll
    for (int q = 0; q < NR; ++q) {
      const int rr = rb + q * stride, r = rr < 32768 ? rr : 32767;
      const bool live = rr < 32768;
      float ss = 0.f;
#pragma unroll
      for (int i = 0; i < 4; ++i) ss += v[q][i][0] * v[q][i][0] + v[q][i][1] * v[q][i][1] + v[q][i][2] * v[q][i][2] + v[q][i][3] * v[q][i][3];
      ss = wave_sum(ss);
      const float rstd = rsqrtf(ss * (1.f / 1024.f) + 1e-6f);
#pragma unroll
      for (int i = 0; i < 4; ++i) {
        const int c = (lane + 64 * i) * 4;
        if (live) ((f32x4*)(p.out + (size_t)r * DM))[lane + 64 * i] = v[q][i] * rstd * gv[i];
      }
    }
  }
}

__device__ void phase_even_elem(const Params& p, const bf16_t* P, bf16_t* CAT, bf16_t* Kall) {
  const int wave = threadIdx.x >> 6, lane = threadIdx.x & 63;
  for (int r = blockIdx.x * 8 + wave; r < M_ALL; r += gridDim.x * 8) {
    int b, key; row_bk(r, b, key);
    const bool latent = r >= NCTX;
    const int t = latent ? ((r - NCTX) & 8191) : (r & 255), T = latent ? 8192 : 256;
    const int c0 = lane * 8;
    float cv[3][8];
#pragma unroll
    for (int dt = 0; dt < 3; ++dt) {
      const int tt = t + dt - 1;
      if (tt >= 0 && tt < T) {
        const bf16_t* pr = P + (size_t)(r + dt - 1) * 2048;
        u32x4 gc = *(const u32x4*)(pr + 512 + c0), vv = *(const u32x4*)(pr + 1024 + c0);
#pragma unroll
        for (int e = 0; e < 4; ++e) { cv[dt][2 * e] = lo2f(gc[e]) * lo2f(vv[e]); cv[dt][2 * e + 1] = hi2f(gc[e]) * hi2f(vv[e]); }
      } else {
#pragma unroll
        for (int e = 0; e < 8; ++e) cv[dt][e] = 0.f;
      }
    }
    u32x4 gb = *(const u32x4*)(P + (size_t)r * 2048 + c0);
    float o[8];
#pragma unroll
    for (int e = 0; e < 8; ++e) {
      const float w0 = p.even_conv_w[c0 + e], w1 = p.even_conv_w[512 + c0 + e], w2 = p.even_conv_w[1024 + c0 + e];
      const float g = (e & 1) ? hi2f(gb[e >> 1]) : lo2f(gb[e >> 1]);
      o[e] = g * (cv[0][e] * w0 + cv[1][e] * w1 + cv[2][e] * w2);
    }
    u32x4 ov; ov.x = pk2(o[0], o[1]); ov.y = pk2(o[2], o[3]); ov.z = pk2(o[4], o[5]); ov.w = pk2(o[6], o[7]);
    *(u32x4*)(CAT + (size_t)r * DM + c0) = ov;
    {
      const int d = lane & 31;
      float v = bf2f(P[(size_t)r * 2048 + 1920 + d]);
      const float pv = __shfl_xor(v, 8);
      const int idx = d & 15, fi = idx & 7;
      if (latent) {
        const float* rp = p.rope + ((size_t)t * 2 + (d >> 4)) * 16 + fi;
        const float cs = rp[0], sn = rp[8];
        v = (idx < 8) ? (v * cs - pv * sn) : (pv * sn + v * cs);
      }
      const bf16_t bv = f2bf(v);
      if (lane < 32) {
#pragma unroll
        for (int h = 0; h < 8; ++h) Kall[((size_t)(b * 8 + h) * NKEY + key) * 96 + 64 + d] = bv;
      }
    }
  }
}

__device__ void phase_attn_scalar(const Params& p, const bf16_t* Qall, const bf16_t* Kall, const bf16_t* Vt, bf16_t* CAT) {
  const int ql = threadIdx.x & 255, half = threadIdx.x >> 8;
  for (int it = blockIdx.x; it < 1056; it += gridDim.x) {
    int b, h, q0, nk;
    if (it < 1024) { b = it >> 8; h = (it >> 5) & 7; q0 = 256 + (it & 31) * 256; nk = NKEY; }
    else { const int i2 = it - 1024; b = i2 >> 3; h = i2 & 7; q0 = 0; nk = 256; }
    const int qi = q0 + ql;
    const size_t bh = (size_t)(b * 8 + h);
    float q[96];
    {
      const u32x4* qp = (const u32x4*)(Qall + (bh * NKEY + qi) * 96);
#pragma unroll
      for (int i = 0; i < 12; ++i) { u32x4 v = qp[i];
#pragma unroll
        for (int e = 0; e < 4; ++e) { q[8 * i + 2 * e] = lo2f(v[e]); q[8 * i + 2 * e + 1] = hi2f(v[e]); } }
    }
    float o[32];
#pragma unroll
    for (int i = 0; i < 32; ++i) o[i] = 0.f;
    float mrun = -1e30f, lrun = 0.f;
    for (int k0 = 0; k0 < nk; k0 += 4) {
      float s[4];
#pragma unroll
      for (int kk = 0; kk < 4; ++kk) {
        const u32x4* kp = (const u32x4*)(Kall + (bh * NKEY + k0 + kk) * 96);
        float a = 0.f;
#pragma unroll
        for (int i = 0; i < 12; ++i) { u32x4 v = kp[i];
#pragma unroll
          for (int e = 0; e < 4; ++e) a += q[8 * i + 2 * e] * lo2f(v[e]) + q[8 * i + 2 * e + 1] * hi2f(v[e]); }
        s[kk] = a;
      }
      const float mx = fmaxf(fmaxf(s[0], s[1]), fmaxf(s[2], s[3]));
      const float mnew = fmaxf(mrun, mx);
      const float alpha = exp2f(mrun - mnew);
      const float p0 = exp2f(s[0] - mnew), p1 = exp2f(s[1] - mnew), p2 = exp2f(s[2] - mnew), p3 = exp2f(s[3] - mnew);
      lrun = lrun * alpha + p0 + p1 + p2 + p3;
      mrun = mnew;
#pragma unroll
      for (int dv = 0; dv < 32; ++dv) {
        u32x2 v = *(const u32x2*)(Vt + (bh * 64 + half * 32 + dv) * NKEY + k0);
        o[dv] = o[dv] * alpha + p0 * lo2f(v.x) + p1 * hi2f(v.x) + p2 * lo2f(v.y) + p3 * hi2f(v.y);
      }
    }
    const float il = 1.f / lrun;
    const int r = qi < 256 ? b * 256 + qi : NCTX + b * 8192 + (qi - 256);
    u32x4* op = (u32x4*)(CAT + (size_t)r * DM + 512 + h * 64 + half * 32);
#pragma unroll
    for (int i = 0; i < 4; ++i) {
      u32x4 v; v.x = pk2(o[8 * i] * il, o[8 * i + 1] * il); v.y = pk2(o[8 * i + 2] * il, o[8 * i + 3] * il);
      v.z = pk2(o[8 * i + 4] * il, o[8 * i + 5] * il); v.w = pk2(o[8 * i + 6] * il, o[8 * i + 7] * il);
      op[i] = v;
    }
  }
}

typedef float f32x16 __attribute__((ext_vector_type(16)));
__device__ __forceinline__ float ex2(float x) { return __builtin_amdgcn_exp2f(x); }
template <bool SAFE>
__device__ void phase_attn(const Params& p, const bf16_t* Qall, const bf16_t* Kall, const bf16_t* Vt, bf16_t* CAT, LAS unsigned char* lds) {
  const int tid = threadIdx.x, w = __builtin_amdgcn_readfirstlane(tid >> 6), lane = tid & 63, r = lane & 31, hh = lane >> 5;
  constexpr int KROW = 104, VROW = 72;
  constexpr int KBYTES = 64 * KROW * 2, VBYTES = 64 * VROW * 2, BUF = KBYTES + VBYTES;
  unsigned soff[3];
#pragma unroll
  for (int j = 0; j < 3; ++j) {
    const int ci = (3 * w + j) * 64 + lane;
    if (3 * w + j < 13) { const int row = ci / 13, part = ci % 13; soff[j] = (unsigned)(row * 96 + (part < 12 ? part : 0) * 8) * 2u; }
    else { const int c2 = ci - 832, dv = c2 / 9, part = c2 % 9; soff[j] = (unsigned)((dv < 64 ? dv : 0) * NKEY + (part < 8 ? part : 0) * 8) * 2u; }
  }
#define ATT_STAGE(bufi, k0_) do { _Pragma("unroll") for (int j_ = 0; j_ < 3; ++j_) if (j_ == 0 || w < 7) { \
    const char* g_ = (3 * w + j_ < 13) ? (const char*)kbase + soff[j_] + (size_t)(k0_) * 192 : (const char*)vbase + soff[j_] + (size_t)(k0_) * 2; \
    __builtin_amdgcn_global_load_lds((const unsigned*)g_, (LAS unsigned*)(lds + (bufi) * BUF + (3 * w + j_) * 1024), 16, 0, 0); } } while (0)
  for (int it = blockIdx.x; it < 544; it += gridDim.x) {
    if (SAFE && p.aflag[it] == 0u) continue;
    bool wbad = false;
    int b, h, q0, nk, nq;
    if (it < 512) { b = it >> 7; h = (it >> 4) & 7; q0 = 256 + (it & 15) * 512; nk = NKEY; nq = 512; }
    else { const int i2 = it - 512; b = i2 >> 3; h = i2 & 7; q0 = 0; nk = 256; nq = 256; }
    const size_t bh = (size_t)(b * 8 + h);
    const int qw = 64 * w;
    const bool wact = qw < nq;
    const int qbase = q0 + (wact ? qw : 0) + r;
    bf16x8 qf[2][6];
#pragma unroll
    for (int qb = 0; qb < 2; ++qb) {
      const bf16_t* qp = Qall + (bh * NKEY + qbase + 32 * qb) * 96 + 8 * hh;
#pragma unroll
      for (int c = 0; c < 6; ++c) qf[qb][c] = *(const bf16x8*)(qp + 16 * c);
    }
    f32x16 o[2][2];
#pragma unroll
    for (int qb = 0; qb < 2; ++qb)
#pragma unroll
      for (int i = 0; i < 16; ++i) { o[qb][0][i] = 0.f; o[qb][1][i] = 0.f; }
    float mrun[2] = {0.f, 0.f}, lrun[2] = {0.f, 0.f};
    const bf16_t* kbase = Kall + bh * NKEY * 96;
    const bf16_t* vbase = Vt + bh * 64 * NKEY;
    ATT_STAGE(0, 0);
    asm volatile("s_waitcnt vmcnt(0)" ::: "memory");
    __syncthreads();
    const int ntile = nk >> 6;
    for (int i = 0; i < ntile; ++i) {
      const bool more = (i + 1 < ntile);
      if (more) ATT_STAGE((i + 1) & 1, (i + 1) * 64);
      LAS unsigned char* kb_ = lds + (i & 1) * BUF;
      LAS unsigned char* vb_ = kb_ + KBYTES;
      f32x16 s[2][2];
#pragma unroll
      for (int qb = 0; qb < 2; ++qb)
#pragma unroll
        for (int e = 0; e < 16; ++e) { s[qb][0][e] = 0.f; s[qb][1][e] = 0.f; }
#pragma unroll
      for (int c = 0; c < 6; ++c) {
        const bf16x8 ka = *(const LAS bf16x8*)(kb_ + (r * KROW + 16 * c + 8 * hh) * 2);
        const bf16x8 kb2 = *(const LAS bf16x8*)(kb_ + ((32 + r) * KROW + 16 * c + 8 * hh) * 2);
#pragma unroll
        for (int qb = 0; qb < 2; ++qb) {
          s[qb][0] = __builtin_amdgcn_mfma_f32_32x32x16_bf16(ka, qf[qb][c], s[qb][0], 0, 0, 0);
          s[qb][1] = __builtin_amdgcn_mfma_f32_32x32x16_bf16(kb2, qf[qb][c], s[qb][1], 0, 0, 0);
        }
      }
#pragma unroll
      for (int qb = 0; qb < 2; ++qb) {
        if (SAFE) {
          float mx = fmaxf(s[qb][0][0], s[qb][1][0]);
#pragma unroll
          for (int e = 1; e < 16; ++e) mx = fmaxf(mx, fmaxf(s[qb][0][e], s[qb][1][e]));
          mx = fmaxf(mx, __shfl_xor(mx, 32));
          const bool need = (i == 0) || (mx - mrun[qb] > 8.f);
          if (__builtin_amdgcn_ballot_w64(need) != 0ull) {
            const float nm = need ? mx : mrun[qb];
            const float alpha = (i == 0) ? 1.f : ex2(mrun[qb] - nm);
            mrun[qb] = nm; lrun[qb] *= alpha;
#pragma unroll
            for (int e = 0; e < 16; ++e) { o[qb][0][e] *= alpha; o[qb][1][e] *= alpha; }
          }
        }
        f32x2 ps2 = {0.f, 0.f};
        const f32x2 m2 = {mrun[qb], mrun[qb]};
#pragma unroll
        for (int kb = 0; kb < 2; ++kb)
#pragma unroll
          for (int e = 0; e < 16; e += 2) {
            f32x2 t = {s[qb][kb][e], s[qb][kb][e + 1]};
            if (SAFE) t = t - m2;
            t.x = ex2(t.x); t.y = ex2(t.y);
            ps2 += t;
            s[qb][kb][e] = t.x; s[qb][kb][e + 1] = t.y;
          }
        lrun[qb] += ps2.x + ps2.y;
        if (!SAFE) wbad = wbad || !(ps2.x + ps2.y < 1.2089258e24f);
      }
#pragma unroll
      for (int kb = 0; kb < 2; ++kb)
#pragma unroll
        for (int t = 0; t < 2; ++t) {
          const int kofs = 32 * kb + 16 * t + 4 * hh;
          u32x4 va, vb2;
          { const u32x2 lo = *(const LAS u32x2*)(vb_ + (r * VROW + kofs) * 2), hi = *(const LAS u32x2*)(vb_ + (r * VROW + kofs + 8) * 2); va.x = lo.x; va.y = lo.y; va.z = hi.x; va.w = hi.y; }
          { const u32x2 lo = *(const LAS u32x2*)(vb_ + ((32 + r) * VROW + kofs) * 2), hi = *(const LAS u32x2*)(vb_ + ((32 + r) * VROW + kofs + 8) * 2); vb2.x = lo.x; vb2.y = lo.y; vb2.z = hi.x; vb2.w = hi.y; }
#pragma unroll
          for (int qb = 0; qb < 2; ++qb) {
            u32x4 pw;
            pw.x = pk2(s[qb][kb][8 * t], s[qb][kb][8 * t + 1]); pw.y = pk2(s[qb][kb][8 * t + 2], s[qb][kb][8 * t + 3]);
            pw.z = pk2(s[qb][kb][8 * t + 4], s[qb][kb][8 * t + 5]); pw.w = pk2(s[qb][kb][8 * t + 6], s[qb][kb][8 * t + 7]);
            const bf16x8 pf = __builtin_bit_cast(bf16x8, pw);
            o[qb][0] = __builtin_amdgcn_mfma_f32_32x32x16_bf16(__builtin_bit_cast(bf16x8, va), pf, o[qb][0], 0, 0, 0);
            o[qb][1] = __builtin_amdgcn_mfma_f32_32x32x16_bf16(__builtin_bit_cast(bf16x8, vb2), pf, o[qb][1], 0, 0, 0);
          }
        }
      asm volatile("s_waitcnt vmcnt(0)" ::: "memory");
      __syncthreads();
    }
    if (!SAFE) { if (__builtin_amdgcn_ballot_w64(wbad) != 0ull && lane == 0) p.aflag[it] = 1u; }
    if (wact) {
#pragma unroll
      for (int qb = 0; qb < 2; ++qb) {
        float l = lrun[qb]; l += __shfl_xor(l, 32);
        if (!SAFE) { if (__builtin_amdgcn_ballot_w64(!(l > 8.6736174e-19f)) != 0ull && lane == 0) p.aflag[it] = 1u; }
        const float il = 1.f / l;
        const int qi = qbase + 32 * qb;
        const int row = qi < 256 ? b * 256 + qi : NCTX + b * 8192 + (qi - 256);
        bf16_t* op = CAT + (size_t)row * DM + 512 + h * 64 + 4 * hh;
#pragma unroll
        for (int g = 0; g < 4; ++g) {
          u32x2 a; a.x = pk2(o[qb][0][4 * g] * il, o[qb][0][4 * g + 1] * il); a.y = pk2(o[qb][0][4 * g + 2] * il, o[qb][0][4 * g + 3] * il);
          *(u32x2*)(op + 8 * g) = a;
          u32x2 c; c.x = pk2(o[qb][1][4 * g] * il, o[qb][1][4 * g + 1] * il); c.y = pk2(o[qb][1][4 * g + 2] * il, o[qb][1][4 * g + 3] * il);
          *(u32x2*)(op + 32 + 8 * g) = c;
        }
      }
    }
  }
}
#undef ATT_STAGE

__device__ void phase_hgrn_scalar(const Params& p, int dir, const bf16_t* Qh, const bf16_t* Vv, const bf16_t* Gg, const _Float16* Lx, bf16_t* O, float* sm) {
  float* sf = sm; float* sk = sm + 128; float* sq = sm + 256; float* part = sm + 384;   float* red = sm + 896;
  const int tid = threadIdx.x, dv = tid & 127, kg = tid >> 7;
  for (int it = blockIdx.x; it < 32; it += gridDim.x) {
    const int b = it >> 3, h = it & 7;
    float S[32];
#pragma unroll
    for (int i = 0; i < 32; ++i) S[i] = 0.f;
    for (int n = 0; n < NKEY; ++n) {
      int r; bool latent = n >= 256;
      if (!latent) r = b * 256 + (dir == 0 ? n : 255 - n);
      else r = NCTX + b * 8192 + (dir == 0 ? (n - 256) : (8191 - (n - 256)));
      const size_t off = (size_t)r * DM + h * 128;
      if (tid < 128) {
        const float f = __expf((float)Lx[off + tid]);
        sf[tid] = f; sk[tid] = 1.f - f; sq[tid] = bf2f(Qh[off + tid]);
      }
      __syncthreads();
      const float v = bf2f(Vv[off + dv]);
      float po = 0.f;
#pragma unroll
      for (int i = 0; i < 32; ++i) { const int dk = kg * 32 + i; S[i] = sf[dk] * S[i] + sk[dk] * v; po += S[i] * sq[dk]; }
      if (latent) {
        part[kg * 128 + dv] = po;
        __syncthreads();
        if (tid < 128) {
          float o = part[tid] + part[128 + tid] + part[256 + tid] + part[384 + tid];
          if (dir == 0) O[off + tid] = f2bf(o);
          else {
            o += bf2f(O[off + tid]);
            float ss = wave_sum(o * o);
            if ((tid & 63) == 0) red[tid >> 6] = ss;
            part[tid] = o;
          }
        }
        __syncthreads();
        if (dir == 1 && tid < 128) {
          const float o = part[tid];
          const float rstd = rsqrtf((red[0] + red[1]) * (1.f / 128.f) + 1e-6f);
          const float g = bf2f(Gg[off + tid]);
          O[off + tid] = f2bf(o * rstd * p.g_norm_g[tid] * g * sigmoidf_(g));
        }
      }
      __syncthreads();
    }
  }
}

template <bool OUT>
__device__ void phase_hgrn(const Params& p, const bf16_t* Qh, const bf16_t* Vv, const _Float16* Lfb, bf16_t* Of, bf16_t* Ob, float* Sseg, float* Dlog, LAS unsigned char* lds) {
  constexpr int NSEG = 4, CPS = 33, NIT = OUT ? 64 * NSEG : 64 * (NSEG - 1);
  constexpr int QT = 0, KT = QT + 64 * 136 * 2, KE = KT + 64 * 136 * 2, VT = KE + 128 * 72 * 2, AT = VT + 128 * 72 * 2,
                ST = AT + 64 * 72 * 2, DC = ST + 128 * 136 * 2, TOT = DC + 512;
  const int tid = threadIdx.x, w = tid >> 6, lane = tid & 63, r = lane & 31, hh = lane >> 5;
  const int dk = tid & 127, tq = tid >> 7;
  const int dvb = w & 3, wh = w >> 2;
  for (int it = blockIdx.x; it < NIT; it += gridDim.x) {
    const int bhd = OUT ? it >> 2 : it / 3, sg = OUT ? it & 3 : it % 3;
    const int b = bhd >> 4, h = (bhd >> 1) & 7, dir = bhd & 1;
    const int c_begin = sg * CPS, c_end = c_begin + CPS;
    const _Float16* Lx = Lfb + (size_t)dir * ((size_t)M_ALL * DM);
    const int sgn = dir ? -1 : 1;
    f32x16 S0, S1;
#pragma unroll
    for (int e = 0; e < 16; ++e) { S0[e] = 0.f; S1[e] = 0.f; }
    if constexpr (OUT) {
      for (int sp = 0; sp < sg; ++sp) {
        const float* sp_ = Sseg + ((size_t)(bhd * 3 + sp) * 8 + w) * 2048;
        const float* dl = Dlog + (size_t)(bhd * 3 + sp) * 128;
#pragma unroll
        for (int g = 0; g < 4; ++g) {
          const f32x4 d0 = *(const f32x4*)(dl + 32 * (2 * wh) + 8 * g + 4 * hh), d1 = *(const f32x4*)(dl + 32 * (2 * wh + 1) + 8 * g + 4 * hh);
#pragma unroll
          for (int j = 0; j < 4; ++j) {
            S0[4 * g + j] = S0[4 * g + j] * __expf(d0[j]) + sp_[(4 * g + j) * 64 + lane];
            S1[4 * g + j] = S1[4 * g + j] * __expf(d1[j]) + sp_[1024 + (4 * g + j) * 64 + lane];
          }
        }
      }
#pragma unroll
      for (int g = 0; g < 4; ++g) {
        u32x2 a0; a0.x = pk2(S0[4 * g], S0[4 * g + 1]); a0.y = pk2(S0[4 * g + 2], S0[4 * g + 3]);
        *(LAS u32x2*)(lds + ST + ((32 * dvb + r) * 136 + 32 * (2 * wh) + 8 * g + 4 * hh) * 2) = a0;
        u32x2 a1; a1.x = pk2(S1[4 * g], S1[4 * g + 1]); a1.y = pk2(S1[4 * g + 2], S1[4 * g + 3]);
        *(LAS u32x2*)(lds + ST + ((32 * dvb + r) * 136 + 32 * (2 * wh + 1) + 8 * g + 4 * hh) * 2) = a1;
      }
    }
    float dsum = 0.f;
    _Float16 lfr[16]; bf16_t qr[16], vr[16];
    {
      const int cn = c_begin;
      const int rb0 = (cn < 4) ? b * 256 + (dir ? 255 - 64 * cn : 64 * cn) : NCTX + b * 8192 + (dir ? 8191 - 64 * (cn - 4) : 64 * (cn - 4));
      const size_t o0 = (size_t)(rb0 + sgn * 16 * tq) * DM + h * 128 + dk;
#pragma unroll
      for (int i = 0; i < 16; ++i) { const size_t o = o0 + (ptrdiff_t)(sgn * i) * DM; lfr[i] = Lx[o]; if constexpr (OUT) qr[i] = Qh[o]; else qr[i] = 0; vr[i] = Vv[o]; }
    }
    __syncthreads();
    for (int c = c_begin; c < c_end; ++c) {
      const int rbase = (c < 4) ? b * 256 + (dir ? 255 - 64 * c : 64 * c) : NCTX + b * 8192 + (dir ? 8191 - 64 * (c - 4) : 64 * (c - 4));
      float lf[16], cs[16];
      float run = 0.f;
#pragma unroll
      for (int i = 0; i < 16; ++i) { lf[i] = (float)lfr[i]; run += lf[i]; cs[i] = run; }
      *(LAS float*)(lds + TOT + (tq * 128 + dk) * 4) = run;
      __syncthreads();
      float offs = 0.f, blast = 0.f;
#pragma unroll
      for (int g = 0; g < 4; ++g) { const float t = *(const LAS float*)(lds + TOT + (g * 128 + dk) * 4); blast += t; if (g < tq) offs += t; }
      {
        unsigned kew[8], vw[8];
#pragma unroll
        for (int i = 0; i < 16; i += 2) {
          float qt[2], kt[2], ke[2];
#pragma unroll
          for (int e = 0; e < 2; ++e) {
            const float bb = offs + cs[i + e];
            const float k = 1.f - __expf(lf[i + e]);
            if constexpr (OUT) { qt[e] = bf2f(qr[i + e]) * __expf(bb); kt[e] = k * __expf(-bb); }
            ke[e] = k * __expf(blast - bb);
          }
          if constexpr (OUT) {
            const unsigned qp = pk2(qt[0], qt[1]), kp = pk2(kt[0], kt[1]);
            const int s = 16 * tq + i;
            *(LAS bf16_t*)(lds + QT + (s * 136 + dk) * 2) = (bf16_t)(qp & 0xffffu);
            *(LAS bf16_t*)(lds + QT + ((s + 1) * 136 + dk) * 2) = (bf16_t)(qp >> 16);
            *(LAS bf16_t*)(lds + KT + (s * 136 + dk) * 2) = (bf16_t)(kp & 0xffffu);
            *(LAS bf16_t*)(lds + KT + ((s + 1) * 136 + dk) * 2) = (bf16_t)(kp >> 16);
          }
          kew[i >> 1] = pk2(ke[0], ke[1]);
          vw[i >> 1] = (unsigned)vr[i] | ((unsigned)vr[i + 1] << 16);
        }
        *(LAS u32x4*)(lds + KE + (dk * 72 + 16 * tq) * 2) = (u32x4){kew[0], kew[1], kew[2], kew[3]};
        *(LAS u32x4*)(lds + KE + (dk * 72 + 16 * tq + 8) * 2) = (u32x4){kew[4], kew[5], kew[6], kew[7]};
        *(LAS u32x4*)(lds + VT + (dk * 72 + 16 * tq) * 2) = (u32x4){vw[0], vw[1], vw[2], vw[3]};
        *(LAS u32x4*)(lds + VT + (dk * 72 + 16 * tq + 8) * 2) = (u32x4){vw[4], vw[5], vw[6], vw[7]};
        if (tq == 0) *(LAS float*)(lds + DC + dk * 4) = __expf(blast);
        dsum += blast;
      }
      __syncthreads();
      if (c + 1 < c_end) {
        const int cn = c + 1;
        const int rb = (cn < 4) ? b * 256 + (dir ? 255 - 64 * cn : 64 * cn) : NCTX + b * 8192 + (dir ? 8191 - 64 * (cn - 4) : 64 * (cn - 4));
        const size_t o0 = (size_t)(rb + sgn * 16 * tq) * DM + h * 128 + dk;
#pragma unroll
        for (int i = 0; i < 16; ++i) { const size_t o = o0 + (ptrdiff_t)(sgn * i) * DM; lfr[i] = Lx[o]; if constexpr (OUT) qr[i] = Qh[o]; else qr[i] = 0; vr[i] = Vv[o]; }
      }
      if (OUT && w < 3) {
        const int sb = (w == 2) ? 1 : 0, tb = (w == 0) ? 0 : 1;
        f32x16 a;
#pragma unroll
        for (int e = 0; e < 16; ++e) a[e] = 0.f;
#pragma unroll
        for (int ks = 0; ks < 8; ++ks) {
          const bf16x8 ka = *(const LAS bf16x8*)(lds + KT + ((32 * sb + r) * 136 + 16 * ks + 8 * hh) * 2);
          const bf16x8 qb = *(const LAS bf16x8*)(lds + QT + ((32 * tb + r) * 136 + 16 * ks + 8 * hh) * 2);
          a = __builtin_amdgcn_mfma_f32_32x32x16_bf16(ka, qb, a, 0, 0, 0);
        }
        const int tok = 32 * tb + r;
#pragma unroll
        for (int g = 0; g < 4; ++g) {
          const int s0 = 32 * sb + 8 * g + 4 * hh;
          const float v0 = (s0 + 0 <= tok) ? a[4 * g + 0] : 0.f, v1 = (s0 + 1 <= tok) ? a[4 * g + 1] : 0.f;
          const float v2 = (s0 + 2 <= tok) ? a[4 * g + 2] : 0.f, v3 = (s0 + 3 <= tok) ? a[4 * g + 3] : 0.f;
          u32x2 o; o.x = pk2(v0, v1); o.y = pk2(v2, v3);
          *(LAS u32x2*)(lds + AT + (tok * 72 + s0) * 2) = o;
        }
      }
      {
#pragma unroll
        for (int g = 0; g < 4; ++g) {
          const f32x4 d0 = *(const LAS f32x4*)(lds + DC + (32 * (2 * wh) + 8 * g + 4 * hh) * 4);
          const f32x4 d1 = *(const LAS f32x4*)(lds + DC + (32 * (2 * wh + 1) + 8 * g + 4 * hh) * 4);
#pragma unroll
          for (int j = 0; j < 4; ++j) { S0[4 * g + j] *= d0[j]; S1[4 * g + j] *= d1[j]; }
        }
#pragma unroll
        for (int ks = 0; ks < 4; ++ks) {
          const bf16x8 vb = *(const LAS bf16x8*)(lds + VT + ((32 * dvb + r) * 72 + 16 * ks + 8 * hh) * 2);
          const bf16x8 k0 = *(const LAS bf16x8*)(lds + KE + ((32 * (2 * wh) + r) * 72 + 16 * ks + 8 * hh) * 2);
          const bf16x8 k1 = *(const LAS bf16x8*)(lds + KE + ((32 * (2 * wh + 1) + r) * 72 + 16 * ks + 8 * hh) * 2);
          S0 = __builtin_amdgcn_mfma_f32_32x32x16_bf16(k0, vb, S0, 0, 0, 0);
          S1 = __builtin_amdgcn_mfma_f32_32x32x16_bf16(k1, vb, S1, 0, 0, 0);
        }
      }
      if constexpr (OUT) {
      __syncthreads();
      {
        const int tb = wh;
        f32x16 o;
#pragma unroll
        for (int e = 0; e < 16; ++e) o[e] = 0.f;
#pragma unroll
        for (int ks = 0; ks < 4; ++ks) {
          if (ks < 2 * (tb + 1)) {
            const bf16x8 va = *(const LAS bf16x8*)(lds + VT + ((32 * dvb + r) * 72 + 16 * ks + 8 * hh) * 2);
            const bf16x8 ab = *(const LAS bf16x8*)(lds + AT + ((32 * tb + r) * 72 + 16 * ks + 8 * hh) * 2);
            o = __builtin_amdgcn_mfma_f32_32x32x16_bf16(va, ab, o, 0, 0, 0);
          }
        }
#pragma unroll
        for (int ks = 0; ks < 8; ++ks) {
          const bf16x8 sa = *(const LAS bf16x8*)(lds + ST + ((32 * dvb + r) * 136 + 16 * ks + 8 * hh) * 2);
          const bf16x8 qb = *(const LAS bf16x8*)(lds + QT + ((32 * tb + r) * 136 + 16 * ks + 8 * hh) * 2);
          o = __builtin_amdgcn_mfma_f32_32x32x16_bf16(sa, qb, o, 0, 0, 0);
        }
        if (c >= 4) {
          const int row = rbase + sgn * (32 * tb + r);
          bf16_t* op = (dir ? Ob + (size_t)(row - NCTX) * DM : Of + (size_t)row * DM) + h * 128 + 32 * dvb + 4 * hh;
#pragma unroll
          for (int g = 0; g < 4; ++g) {
            u32x2 ov; ov.x = pk2(o[4 * g], o[4 * g + 1]); ov.y = pk2(o[4 * g + 2], o[4 * g + 3]);
            *(u32x2*)(op + 8 * g) = ov;
          }
        }
      }
      __syncthreads();
#pragma unroll
      for (int g = 0; g < 4; ++g) {
        u32x2 a0; a0.x = pk2(S0[4 * g], S0[4 * g + 1]); a0.y = pk2(S0[4 * g + 2], S0[4 * g + 3]);
        *(LAS u32x2*)(lds + ST + ((32 * dvb + r) * 136 + 32 * (2 * wh) + 8 * g + 4 * hh) * 2) = a0;
        u32x2 a1; a1.x = pk2(S1[4 * g], S1[4 * g + 1]); a1.y = pk2(S1[4 * g + 2], S1[4 * g + 3]);
        *(LAS u32x2*)(lds + ST + ((32 * dvb + r) * 136 + 32 * (2 * wh + 1) + 8 * g + 4 * hh) * 2) = a1;
      }
      }
    }
    if constexpr (!OUT) {
      float* sp_ = Sseg + ((size_t)(bhd * 3 + sg) * 8 + w) * 2048;
#pragma unroll
      for (int e = 0; e < 16; ++e) { sp_[e * 64 + lane] = S0[e]; sp_[1024 + e * 64 + lane] = S1[e]; }
      if (tq == 0) Dlog[(size_t)(bhd * 3 + sg) * 128 + dk] = dsum;
    }
    __syncthreads();
  }
}

__device__ void phase_hgrn_readout(const Params& p, bf16_t* Of, const bf16_t* Ob, const bf16_t* Gg) {
  const int wave = threadIdx.x >> 6, lane = threadIdx.x & 63;
  for (int r = NCTX + blockIdx.x * 8 + wave; r < M_ALL; r += gridDim.x * 8) {
    const int c0 = lane * 16;
    float o[16];
#pragma unroll
    for (int i = 0; i < 2; ++i) {
      const u32x4 a = *(const u32x4*)(Of + (size_t)r * DM + c0 + 8 * i), bq = *(const u32x4*)(Ob + (size_t)(r - NCTX) * DM + c0 + 8 * i);
#pragma unroll
      for (int e = 0; e < 4; ++e) { o[8 * i + 2 * e] = lo2f(a[e]) + lo2f(bq[e]); o[8 * i + 2 * e + 1] = hi2f(a[e]) + hi2f(bq[e]); }
    }
    float ss = 0.f;
#pragma unroll
    for (int i = 0; i < 16; ++i) ss += o[i] * o[i];
    ss += __shfl_xor(ss, 1); ss += __shfl_xor(ss, 2); ss += __shfl_xor(ss, 4);
    const float rstd = rsqrtf(ss * (1.f / 128.f) + 1e-6f);
    const int cg = c0 & 127;
#pragma unroll
    for (int i = 0; i < 2; ++i) {
      const u32x4 gq = *(const u32x4*)(Gg + (size_t)r * DM + c0 + 8 * i);
      float y[8];
#pragma unroll
      for (int e = 0; e < 8; ++e) {
        const float g = (e & 1) ? hi2f(gq[e >> 1]) : lo2f(gq[e >> 1]);
        y[e] = o[8 * i + e] * rstd * p.g_norm_g[cg + 8 * i + e] * g * sigmoidf_(g);
      }
      u32x4 ov; ov.x = pk2(y[0], y[1]); ov.y = pk2(y[2], y[3]); ov.z = pk2(y[4], y[5]); ov.w = pk2(y[6], y[7]);
      *(u32x4*)(Of + (size_t)r * DM + c0 + 8 * i) = ov;
    }
  }
}

#define XB_TMO      128
#define XB_XCNT(j)  (256  + 64 * (j))
#define XB_XSUB(j)  (1280 + 64 * (j))
#define XB_XGEN(j)  (2304 + 64 * (j))
#define XB_TOP      3328
#define XB_TOPGEN   3392
#define XCD_BAR_WORDS 3456
#define XB_SPIN_CAP (1u << 22)
__device__ __forceinline__ unsigned xb_ld(unsigned* p)              { return __hip_atomic_load(p, __ATOMIC_RELAXED, __HIP_MEMORY_SCOPE_AGENT); }
__device__ __forceinline__ unsigned xb_add(unsigned* p, unsigned v) { return __hip_atomic_fetch_add(p, v, __ATOMIC_RELAXED, __HIP_MEMORY_SCOPE_AGENT); }
__device__ __forceinline__ unsigned xb_xcc_id() { return (unsigned)__builtin_amdgcn_s_getreg((3 << 11) | 20) & 0xFu; }
#define XB_SPIN(cond, bar) do { unsigned _sp = 0; while (cond) { __builtin_amdgcn_s_sleep(1); \
    if ((++_sp & 255u) == 0u) { if (xb_ld(&(bar)[XB_TMO])) break; if (_sp > XB_SPIN_CAP) { atomicAdd(&(bar)[XB_TMO], 1u); break; } } } } while (0)
__device__ __forceinline__ void xcd_barrier_complete(unsigned* bar, unsigned x, unsigned& nloc, unsigned& nx) {
  const unsigned G = gridDim.x * gridDim.y * gridDim.z;
  unsigned sum, cnt, mine, sp = 0u;
  for (;;) {
    sum = 0u; cnt = 0u; mine = 0u;
#pragma unroll
    for (unsigned j = 0; j < 16; ++j) { const unsigned c = xb_ld(&bar[XB_XCNT(j)]); sum += c; cnt += (c > 0u) ? 1u : 0u; mine = (j == x) ? c : mine; }
    if (sum == G) break;
    __builtin_amdgcn_s_sleep(1);
    if ((++sp & 255u) == 0u) { if (xb_ld(&bar[XB_TMO])) break; if (sp > XB_SPIN_CAP) { atomicAdd(&bar[XB_TMO], 1u); break; } }
  }
  nloc = mine > 0u ? mine : 1u; nx = cnt > 0u ? cnt : 1u;
}
__device__ __forceinline__ void xcd_barrier(unsigned* bar, volatile LAS unsigned* st) {
  asm volatile("s_waitcnt vmcnt(0)" ::: "memory");
  __syncthreads();
  if (threadIdx.x == 0) {
    const unsigned x = xb_xcc_id();
    __builtin_amdgcn_s_waitcnt(0);
    unsigned nloc = st[0], nx = st[1];
    if (nloc == 0u) { xcd_barrier_complete(bar, x, nloc, nx); st[0] = nloc; st[1] = nx; }
    const unsigned old = xb_add(&bar[XB_XSUB(x)], 1u);
    const unsigned gen = old / nloc;
    if (old + 1u == (gen + 1u) * nloc) {
      __builtin_amdgcn_fence(__ATOMIC_RELEASE, "agent");
      asm volatile("s_waitcnt vmcnt(0)" ::: "memory");
      const unsigned og = xb_add(&bar[XB_TOP], 1u);
      const unsigned tg = og / nx;
      if (og + 1u == (tg + 1u) * nx) xb_add(&bar[XB_TOPGEN], 1u);
      else XB_SPIN(xb_ld(&bar[XB_TOPGEN]) == tg, bar);
      __builtin_amdgcn_fence(__ATOMIC_ACQUIRE, "agent");
      xb_add(&bar[XB_XGEN(x)], 1u);
      asm volatile("s_waitcnt vmcnt(0)" ::: "memory");
    } else {
      XB_SPIN(xb_ld(&bar[XB_XGEN(x)]) == gen, bar);
      __builtin_amdgcn_fence(__ATOMIC_ACQUIRE, "agent");
      asm volatile("s_waitcnt vmcnt(0)" ::: "memory");
    }
  }
  __syncthreads();
}


template <int PH>
__device__ __forceinline__ void run_phase(const Params& p, bf16_t* shm_) {
  float* smf = (float*)shm_;
  LAS unsigned char* shm = (LAS unsigned char*)shm_;
  const size_t MR = (size_t)M_ALL;
  bf16_t* G = (bf16_t*)p.R;
  bf16_t* P = (bf16_t*)p.R;
  bf16_t* Qall = P + MR * 2048;
  bf16_t* Kall = Qall + (size_t)32 * NKEY * 96;
  bf16_t* Vt = Kall + (size_t)32 * NKEY * 96;
  bf16_t* Qh = (bf16_t*)p.R;
  bf16_t* Vv = Qh + MR * DM;
  bf16_t* Gg = Vv + MR * DM;
  _Float16* Lf = (_Float16*)(Gg + MR * DM);
  _Float16* Lb = Lf + MR * DM;
  const size_t MODL = (size_t)5 * 9216;
  float* PARTF = (float*)(G + MR * DFF);
  float* PARTE = (float*)(Vt + (size_t)32 * 64 * NKEY);
  const float* CG = p.mod + (size_t)4 * 9 * 1024;
  if constexpr (PH == 0) phase_prep(p, smf);
  if constexpr (PH == 1) phase_norm(p, 0, 0, p.ctx, p.x, 0);
  if constexpr (PH == 2) gemm_phase(p.U, DM, p.W13[0], DM, DM, 0, 132, 0, 22, EpiSwiglu{G}, shm);
  if constexpr (PH == 3) gemm_phase(G, DFF, p.W2[0], DFF, DFF, 4, 128, 0, 4, EpiResid{p.ctx, p.x, p.XC, p.out, p.mod + 2 * 1024, 0.5f}, shm, 4, 11, EpiPart{PARTF});
  if constexpr (PH == 4) phase_norm(p, 0, 1, p.ctx, p.out, 0, PARTF, 11, 0.5f, CG + 2 * 1024);
  if constexpr (PH == 5) gemm_phase(p.U, DM, p.WinE, DM, DM, 0, 132, 0, 8, EpiP{P, p.RS}, shm);
  if constexpr (PH == 6) { gemm_phase(P + 1536, 2048, p.Wqkv, 2048, 384, 0, 132, 0, 7, EpiQKV{EpiQ{p.RS, p.rope, Qall}, EpiKV{p.RS, Kall, Vt}}, shm);
                           phase_even_elem(p, P, p.U, Kall); }
  if constexpr (PH == 7) phase_attn<false>(p, Qall, Kall, Vt, p.U, shm);
  if constexpr (PH == 25) phase_attn<true>(p, Qall, Kall, Vt, p.U, shm);
  if constexpr (PH == 8) gemm_phase(p.U, DM, p.WoutE, DM, DM, 4, 128, 0, 4, EpiResid{p.XC, p.out, p.XC, p.out, p.mod + 5 * 1024, 1.0f}, shm, 4, 4, EpiPart{PARTE});
  if constexpr (PH == 9) phase_norm(p, 0, 2, p.XC, p.out, 0, PARTE, 4, 1.0f, CG + 5 * 1024);
  if constexpr (PH == 10) gemm_phase(p.U, DM, p.W13[1], DM, DM, 0, 132, 0, 22, EpiSwiglu{G}, shm);
  if constexpr (PH == 11) gemm_phase(G, DFF, p.W2[1], DFF, DFF, 4, 128, 0, 4, EpiResid{p.XC, p.out, p.XC, p.out, p.mod + 8 * 1024, 0.5f}, shm, 4, 11, EpiPart{PARTF});
  if constexpr (PH == 12) phase_norm(p, 1, 0, p.XC, p.out, 0, PARTF, 11, 0.5f, CG + 8 * 1024);
  if constexpr (PH == 13) gemm_phase(p.U, DM, p.W13[2], DM, DM, 0, 132, 0, 22, EpiSwiglu{G}, shm);
  if constexpr (PH == 14) gemm_phase(G, DFF, p.W2[2], DFF, DFF, 4, 128, 0, 4, EpiResid{p.XC, p.out, p.XC, p.out, p.mod + MODL + 2 * 1024, 0.5f}, shm, 4, 11, EpiPart{PARTF});
  if constexpr (PH == 15) phase_norm(p, 1, 1, p.XC, p.out, 0, PARTF, 11, 0.5f, CG + MODL + 2 * 1024);
  if constexpr (PH == 16) gemm_phase(p.U, DM, p.WinO, DM, DM, 0, 132, 0, 20, EpiOdd{Qh, Vv, Gg, Lf, Lb, p.lb_logits}, shm);
  bf16_t* Ob = (bf16_t*)(Lb + MR * DM);
  float* Sseg = (float*)(Ob + (size_t)32768 * DM);
  float* Dlg = Sseg + (size_t)192 * 16384;
  if constexpr (PH == 17) phase_hgrn<false>(p, Qh, Vv, Lf, p.U, Ob, Sseg, Dlg, shm);
  if constexpr (PH == 18) phase_hgrn<true>(p, Qh, Vv, Lf, p.U, Ob, Sseg, Dlg, shm);
  if constexpr (PH == 24) phase_hgrn_readout(p, p.U, Ob, Gg);
  if constexpr (PH == 19) gemm_phase(p.U, DM, p.WoutO, DM, DM, 4, 128, 0, 4, EpiResid{p.XC, p.out, p.XC, p.out, p.mod + MODL + 5 * 1024, 1.0f}, shm);
  if constexpr (PH == 20) phase_norm(p, 1, 2, p.XC, p.out, NCTX);
  if constexpr (PH == 21) gemm_phase(p.U, DM, p.W13[3], DM, DM, 4, 128, 0, 22, EpiSwiglu{G}, shm);
  if constexpr (PH == 22) gemm_phase(G, DFF, p.W2[3], DFF, DFF, 4, 128, 0, 4, EpiResid{p.XC, p.out, p.XC, p.out, p.mod + MODL + 8 * 1024, 0.5f}, shm);
  if constexpr (PH == 23) phase_final_norm(p);
}

constexpr int N_PHASES = 24;

#define PROBE_DUP -1
template <int PH>
__device__ __forceinline__ void step(const Params& p, int ph0, int ph1, bf16_t* shm) {
  if ((ph0 <= PH && PH < ph1) || (PH >= 24 && ph1 - ph0 > 1)) {
    run_phase<PH>(p, shm);
    if constexpr (PH == PROBE_DUP) { xcd_barrier(p.bar, (volatile LAS unsigned*)((LAS unsigned char*)shm + SHM_B)); run_phase<PH>(p, shm); }
    if (PH != 23 && ph1 - ph0 > 1) xcd_barrier(p.bar, (volatile LAS unsigned*)((LAS unsigned char*)shm + SHM_B));
  }
}

__global__ void __launch_bounds__(NTHR, 2) mega(Params p, int ph0, int ph1) {
  extern __shared__ __attribute__((aligned(16))) bf16_t shm[];
  if (ph1 < 0) cg::this_grid().sync();
  {
    volatile LAS unsigned* st = (volatile LAS unsigned*)((LAS unsigned char*)shm + SHM_B);
    if (threadIdx.x == 0) { st[0] = 0u; st[1] = 0u; }
    __syncthreads();
    if (threadIdx.x == 0) (void)xb_add(&p.bar[XB_XCNT(xb_xcc_id())], 1u);
  }
  step<0>(p, ph0, ph1, shm); step<1>(p, ph0, ph1, shm); step<2>(p, ph0, ph1, shm); step<3>(p, ph0, ph1, shm);
  step<4>(p, ph0, ph1, shm); step<5>(p, ph0, ph1, shm); step<6>(p, ph0, ph1, shm); step<7>(p, ph0, ph1, shm); step<25>(p, ph0, ph1, shm);
  step<8>(p, ph0, ph1, shm); step<9>(p, ph0, ph1, shm); step<10>(p, ph0, ph1, shm); step<11>(p, ph0, ph1, shm);
  step<12>(p, ph0, ph1, shm); step<13>(p, ph0, ph1, shm); step<14>(p, ph0, ph1, shm); step<15>(p, ph0, ph1, shm);
  step<16>(p, ph0, ph1, shm); step<17>(p, ph0, ph1, shm); step<18>(p, ph0, ph1, shm); step<24>(p, ph0, ph1, shm); step<19>(p, ph0, ph1, shm);
  step<20>(p, ph0, ph1, shm); step<21>(p, ph0, ph1, shm); step<22>(p, ph0, ph1, shm); step<23>(p, ph0, ph1, shm);
}

extern "C" void kernel_launch(void* const* d_in, const int* in_sizes, int n_in, void* d_out, int out_size, void* d_ws, size_t ws_size,
                              hipStream_t stream) {
  Params p{};
  const float** f = (const float**)&p;
  for (int i = 0; i < 22; ++i) f[i] = (const float*)d_in[i];
  p.out = (float*)d_out;
  char* w = (char*)d_ws; size_t off = 0;
  auto take = [&](size_t bytes) { char* r = w + off; off += (bytes + 255) & ~(size_t)255; return r; };
  p.W13[3] = (bf16_t*)take((size_t)2 * DFF * DM * 2);
  p.W2[3] = (bf16_t*)take((size_t)DM * DFF * 2);
  p.WinO = (bf16_t*)take((size_t)5120 * 1024 * 2);
  p.WoutO = (bf16_t*)take((size_t)1024 * 1024 * 2);
  p.mod = (float*)take((size_t)2 * 5 * 9216 * 4);
  p.XC = (float*)take((size_t)NCTX * DM * 4);
  p.RS = (float*)take((size_t)M_ALL * 2 * 4);
  p.rope = (float*)take((size_t)8192 * 32 * 4);
  p.bar = (unsigned*)take((size_t)XCD_BAR_WORDS * 4);
  p.aflag = (unsigned*)take((size_t)1024 * 4);
  p.U = (bf16_t*)take((size_t)M_ALL * DM * 2);
  p.R = take(0);
  {
    const size_t early = (size_t)3 * (2 * DFF * DM * 2) + (size_t)3 * (DM * DFF * 2) + (size_t)2048 * 1024 * 2 + (size_t)1792 * 2048 * 2 + (size_t)1024 * 1024 * 2;
    size_t e0 = (ws_size - early) & ~(size_t)255;
    const size_t rbytes = e0 - off;
    if (rbytes < (size_t)M_ALL * DM * 2 * 5 || ws_size - off < (size_t)M_ALL * DM * 2 * 5 + (size_t)32768 * DM * 2)
      fprintf(stderr, "workspace too small: R=%zu ws=%zu\n", rbytes, ws_size);
    if (ws_size - off < (size_t)M_ALL * DM * 2 * 5 + (size_t)32768 * DM * 2 + (size_t)192 * 16384 * 4 + 192 * 128 * 4) fprintf(stderr, "workspace too small for Sseg\n");
    off = e0;
    for (int i = 0; i < 3; ++i) p.W13[i] = (bf16_t*)take((size_t)2 * DFF * DM * 2);
    for (int i = 0; i < 3; ++i) p.W2[i] = (bf16_t*)take((size_t)DM * DFF * 2);
    p.WinE = (bf16_t*)take((size_t)2048 * 1024 * 2);
    p.Wqkv = (bf16_t*)take((size_t)1792 * 2048 * 2);
    p.WoutE = (bf16_t*)take((size_t)1024 * 1024 * 2);
  }
  static bool attr_done = false;
  if (!attr_done) { (void)hipFuncSetAttribute((const void*)mega, hipFuncAttributeMaxDynamicSharedMemorySize, SHM_B + 256); attr_done = true; }
#if 0
  for (int ph = 0; ph < N_PHASES; ++ph) {
    hipLaunchKernelGGL(mega, dim3(256), dim3(NTHR), SHM_B, stream, p, ph, ph + 1);
  }
#else
  static int grid_blocks = 0;
  if (!grid_blocks) {
    int dev = 0, cus = 0, per_cu = 0;
    hipGetDevice(&dev);
    hipDeviceGetAttribute(&cus, hipDeviceAttributeMultiprocessorCount, dev);
    hipOccupancyMaxActiveBlocksPerMultiprocessor(&per_cu, mega, NTHR, SHM_B + 256);
    if (per_cu > 1) per_cu = 1;
    grid_blocks = cus * per_cu;
  }
  int ph0 = 0, ph1 = N_PHASES;
  void* args[] = {&p, &ph0, &ph1};
  (void)hipMemsetAsync(p.bar, 0, (size_t)XCD_BAR_WORDS * 4, stream);
  hipError_t e = hipLaunchCooperativeKernel((void*)mega, dim3(grid_blocks), dim3(NTHR), args, SHM_B + 256, stream);
  if (e != hipSuccess) fprintf(stderr, "cooperative launch failed: %s (grid %d)\n", hipGetErrorString(e), grid_blocks);
#endif
}
```

```cpp
#include <hip/hip_runtime.h>
#include <hip/hip_cooperative_groups.h>
#include <cstdio>
namespace cg = cooperative_groups;

typedef unsigned short bf16_t;
typedef short bf16x8 __attribute__((ext_vector_type(8)));
typedef float f32x4 __attribute__((ext_vector_type(4)));
typedef unsigned u32x2 __attribute__((ext_vector_type(2)));
typedef unsigned u32x4 __attribute__((ext_vector_type(4)));
typedef _Float16 h16x4 __attribute__((ext_vector_type(4)));
typedef _Float16 h16x8 __attribute__((ext_vector_type(8)));

constexpr int M_ALL = 33792;
constexpr int NCTX = 1024;
constexpr int DM = 1024;
constexpr int DFF = 2816;
constexpr int NKEY = 8448;
constexpr int NTHR = 512;
constexpr float QSCALE = 0.10206207261596577f * 1.4426950408889634f;
constexpr float HSCALE = 0.08838834764831845f;

struct Params {
  const float *x, *c, *ctx, *c_ctx, *ada_w, *ada_b, *norm_g, *ffn_w1, *ffn_w3, *ffn_w2, *even_w_in, *even_conv_w,
      *q_norm_g, *w_uq, *kv_norm_g, *w_ukv, *even_w_out, *odd_w_in, *lb_logits, *g_norm_g, *odd_w_out, *final_norm_g;
  float* out;
  bf16_t *W13[4], *W2[4], *WinE, *Wqkv, *WoutE, *WinO, *WoutO;
  float *mod, *XC, *RS, *rope;
  unsigned* bar;
  unsigned* aflag;
  bf16_t* U;
  char* R;
};

__device__ __forceinline__ float bf2f(bf16_t v) { return __uint_as_float(((unsigned)v) << 16); }
typedef float f32x2 __attribute__((ext_vector_type(2)));
typedef __bf16 bf16v2 __attribute__((ext_vector_type(2)));
__device__ __forceinline__ unsigned pk2(float lo, float hi) { f32x2 v = {lo, hi}; return __builtin_bit_cast(unsigned, __builtin_convertvector(v, bf16v2)); }
__device__ __forceinline__ bf16_t f2bf(float f) { return (bf16_t)(pk2(f, 0.f) & 0xffffu); }
__device__ __forceinline__ float lo2f(unsigned u) { return __uint_as_float(u << 16); }
__device__ __forceinline__ float hi2f(unsigned u) { return __uint_as_float(u & 0xffff0000u); }
__device__ __forceinline__ float wave_sum(float v) {
#pragma unroll
  for (int o = 32; o > 0; o >>= 1) v += __shfl_xor(v, o);
  return v;
}
__device__ __forceinline__ float sigmoidf_(float a) { return __builtin_amdgcn_rcpf(1.f + __expf(-a)); }
__device__ __forceinline__ int row_mi(int r) { return r < NCTX ? 4 : ((r - NCTX) >> 13); }
__device__ __forceinline__ void row_bk(int r, int& b, int& key) {
  if (r < NCTX) { b = r >> 8; key = r & 255; } else { int rr = r - NCTX; b = rr >> 13; key = 256 + (rr & 8191); }
}

constexpr int BM = 256, BK = 64, HALF = 128, NXCD = 8, WGM = 8, HT = HALF * BK, SHM_B = 8 * HT * 2;

__device__ __forceinline__ int lds_byte(int r, int c) {
  int st = (r >> 4) * 2 + (c >> 5), rr = r & 15, cc = c & 31, ob = rr * 64 + cc * 2;
  return st * 1024 + (ob ^ (((ob >> 9) & 1) << 5));
}
__device__ __forceinline__ void stage_rc(int b, int& R, int& C) {
  int st = b / 1024, sb = b % 1024, swz = sb ^ (((sb >> 9) & 1) << 5);
  R = (st >> 1) * 16 + swz / 64; C = (st & 1) * 32 + (swz % 64) / 2;
}

#define LAS __attribute__((address_space(3)))
struct EpiNone { static constexpr bool HALFOK = false; __device__ __forceinline__ void operator()(const f32x4 (&)[2][2][4][2], int, int, int, int, int, int, int) const {} };
template <class Epi, class Epi2 = EpiNone>
__device__ __forceinline__ void gemm_phase(const bf16_t* A, int lda, const bf16_t* Bt, int ldb, int K, int pm0, int nM, int pn0, int nN,
                                           const Epi& epi, LAS unsigned char* lds, int nsm = 0, int ksl = 1, const Epi2& epi2 = Epi2()) {
  const int tid = threadIdx.x, wid = __builtin_amdgcn_readfirstlane(tid >> 6), lane = tid & 63, wr = wid >> 2, wc = wid & 3, fr = lane & 15, fq = lane >> 4;
  const int nt = K / BK;
  const int nwg = nM * nN, G = gridDim.x;
  const int nsplit = nsm * nN * ksl, nts = nt / ksl;
  if ((int)blockIdx.x >= nwg + nsplit) return;
  const int Rfull = nwg / G, Lleft = nwg - Rfull * G;
  const bool tail_split = Epi::HALFOK && nsm == 0 && Lleft > 0 && 2 * Lleft <= G;
  unsigned voffA[2], voffB[2];
#pragma unroll
  for (int i = 0; i < 2; ++i) { int R, C; stage_rc(tid * 16 + i * 8192, R, C); voffA[i] = (unsigned)(R * lda + C) * 2u; voffB[i] = (unsigned)(R * ldb + C) * 2u; }
  const size_t kstep = (size_t)(BK * 2);
  const size_t hstepA = (size_t)HALF * lda * 2, hstepB = (size_t)HALF * ldb * 2;
  const unsigned ldsw = (unsigned)wid * 1024u;
  const int aoff = lds_byte(wr * 64 + fr, fq * 8), boff = lds_byte(wc * 32 + fr, fq * 8);
#define G_SA(b, h) (((b) * 2 + (h)) * (HT * 2))
#define G_SB(b, h) ((4 + (b) * 2 + (h)) * (HT * 2))
#define G_STAGE(bufoff, gbase, voff) do { _Pragma("unroll") for (int _i = 0; _i < 2; ++_i) \
    __builtin_amdgcn_global_load_lds((const unsigned*)((const char*)(gbase) + (voff)[_i]), (LAS unsigned*)(lds + (bufoff) + ldsw + _i * 8192), 16, 0, 0); } while (0)
#define G_LDA(dst, b, h) do { _Pragma("unroll") for (int m = 0; m < 4; ++m) _Pragma("unroll") for (int k = 0; k < 2; ++k) dst[m][k] = *(const LAS bf16x8*)(lds + G_SA(b, h) + aoff + m * 2048 + k * 1024); } while (0)
#define G_LDB(dst, b, h) do { _Pragma("unroll") for (int n = 0; n < 2; ++n) _Pragma("unroll") for (int k = 0; k < 2; ++k) dst[n][k] = *(const LAS bf16x8*)(lds + G_SB(b, h) + boff + n * 2048 + k * 1024); } while (0)
#define G_MMA(ai, bj, At, Bx) do { __builtin_amdgcn_s_setprio(1); _Pragma("unroll") for (int m = 0; m < 4; ++m) _Pragma("unroll") for (int n = 0; n < 2; ++n) _Pragma("unroll") for (int k = 0; k < 2; ++k) \
    acc[ai][bj][m][n] = __builtin_amdgcn_mfma_f32_16x16x32_bf16(Bx[n][k], At[m][k], acc[ai][bj][m][n], 0, 0, 0); __builtin_amdgcn_s_setprio(0); } while (0)
#define WAIT_V(n) asm volatile("s_waitcnt vmcnt(" #n ")" ::: "memory")
#define WAIT_L(n) asm volatile("s_waitcnt lgkmcnt(" #n ")" ::: "memory")
#define BAR __builtin_amdgcn_s_barrier()
#define SCHED __builtin_amdgcn_sched_barrier(0)
  auto unit = [&](int i, int& pm, int& pn, int& sl, int& hf) -> bool {
    long L = (long)i * G + blockIdx.x; sl = -1; hf = -1;
    if (tail_split && i >= Rfull) { if (i > Rfull || (int)blockIdx.x >= 2 * Lleft) return false; L = (long)Rfull * G + (blockIdx.x >> 1); hf = blockIdx.x & 1; }
    if (L >= nwg) { const int j = (int)(L - nwg); if (j >= nsplit) return false; sl = j % ksl; const int tile = j / ksl; pm = tile / nN; pn = pn0 + tile % nN; return true; }
    int wgid = (int)L; { const int q = nwg / NXCD, r = nwg % NXCD, xcd = wgid % NXCD, off = wgid / NXCD; wgid = (xcd < r ? xcd * (q + 1) : r * (q + 1) + (xcd - r) * q) + off; }
    const int nig = WGM * nN, gid = wgid / nig, fm = gid * WGM, gsz = (nM - fm) < WGM ? (nM - fm) : WGM;
    pm = pm0 + fm + ((wgid % nig) % gsz); pn = pn0 + (wgid % nig) / gsz; return true;
  };
  int cpm, cpn, csl, chf, npm = 0, npn = 0, nsl = -1, nhf = -1, ui = 0;
  unit(0, cpm, cpn, csl, chf);
  f32x4 acc[2][2][4][2];
#pragma unroll
  for (int a = 0; a < 2; ++a)
#pragma unroll
    for (int b = 0; b < 2; ++b)
#pragma unroll
      for (int m = 0; m < 4; ++m)
#pragma unroll
        for (int n = 0; n < 2; ++n) acc[a][b][m][n] = (f32x4){0.f, 0.f, 0.f, 0.f};
  bf16x8 At[4][2], B0[2][2], B1[2][2];
  const char* cA = (const char*)A + (size_t)cpm * 2 * hstepA + (csl < 0 ? 0 : (size_t)csl * nts * kstep) + (chf > 0 ? hstepA : 0);
  size_t chA = chf < 0 ? hstepA : 0, nhA = hstepA;
  const char* cB = (const char*)Bt + (size_t)cpn * 2 * hstepB + (csl < 0 ? 0 : (size_t)csl * nts * kstep);
  G_STAGE(G_SB(0, 0), cB, voffB); G_STAGE(G_SA(0, 0), cA, voffA); G_STAGE(G_SB(0, 1), cB + hstepB, voffB); G_STAGE(G_SA(0, 1), cA + chA, voffA);
  if (wr == 1) BAR;
  WAIT_V(4); BAR;
  G_STAGE(G_SB(1, 0), cB + kstep, voffB); G_STAGE(G_SA(1, 0), cA + kstep, voffA); G_STAGE(G_SB(1, 1), cB + hstepB + kstep, voffB);
  WAIT_V(6); BAR;
#define G_KLOOP(AI1) \
    _Pragma("nounroll") \
    for (int t = 0; t < cnt; t += 2) { \
      const bool last = (t == cnt - 2); \
      const char* a1 = cA + (size_t)(t + 1) * kstep; \
      const char* a2 = last ? nA : cA + (size_t)(t + 2) * kstep; const char* b2 = last ? nB : cB + (size_t)(t + 2) * kstep; \
      const char* a3 = a2 + kstep; const char* b3 = b2 + kstep; \
      G_LDB(B0, 0, 0); SCHED; G_LDA(At, 0, 0); G_STAGE(G_SA(1, 1), a1 + chA, voffA); \
      WAIT_L(8); BAR; WAIT_L(0); G_MMA(0, 0, At, B0); BAR; SCHED; \
      G_LDB(B1, 0, 1); G_STAGE(G_SB(0, 0), b2, voffB); \
      BAR; WAIT_L(0); G_MMA(0, 1, At, B1); BAR; \
      G_LDA(At, 0, 1); G_STAGE(G_SA(0, 0), a2, voffA); \
      BAR; WAIT_L(0); if (AI1) G_MMA(1, 0, At, B0); BAR; SCHED; \
      G_STAGE(G_SB(0, 1), b2 + hstepB, voffB); \
      WAIT_V(6); BAR; if (AI1) G_MMA(1, 1, At, B1); BAR; \
      G_LDB(B0, 1, 0); SCHED; G_LDA(At, 1, 0); G_STAGE(G_SA(0, 1), a2 + (last ? nhA : chA), voffA); \
      WAIT_L(8); BAR; WAIT_L(0); G_MMA(0, 0, At, B0); BAR; SCHED; \
      G_LDB(B1, 1, 1); G_STAGE(G_SB(1, 0), b3, voffB); \
      BAR; WAIT_L(0); G_MMA(0, 1, At, B1); BAR; \
      G_LDA(At, 1, 1); G_STAGE(G_SA(1, 0), a3, voffA); \
      BAR; WAIT_L(0); if (AI1) G_MMA(1, 0, At, B0); BAR; SCHED; \
      G_STAGE(G_SB(1, 1), b3 + hstepB, voffB); \
      WAIT_V(6); BAR; if (AI1) G_MMA(1, 1, At, B1); BAR; \
    }
  bool pending_half = false;
  for (;;) {
    const bool has_next = unit(ui + 1, npm, npn, nsl, nhf);
    const char* nA = has_next ? (const char*)A + (size_t)npm * 2 * hstepA + (nsl < 0 ? 0 : (size_t)nsl * nts * kstep) + (nhf > 0 ? hstepA : 0) : cA;
    const char* nB = has_next ? (const char*)Bt + (size_t)npn * 2 * hstepB + (nsl < 0 ? 0 : (size_t)nsl * nts * kstep) : cB;
    nhA = has_next ? (nhf < 0 ? hstepA : 0) : chA;
    const int cnt = csl < 0 ? nt : nts;
    G_KLOOP(1)
    if (csl < 0) {
      if constexpr (Epi::HALFOK) epi(acc, cpm * BM, cpn * BM, wr, wc, fr, fq, 2);
      else epi(acc, cpm * BM, cpn * BM, wr, wc, fr, fq);
    } else epi2(acc, cpm * BM, cpn * BM, wr, wc, fr, fq, csl);
#ifndef NO_EPI_DRAIN
    WAIT_V(0);
#endif
    if (!has_next) break;
#pragma unroll
    for (int a = 0; a < 2; ++a)
#pragma unroll
      for (int b = 0; b < 2; ++b)
#pragma unroll
        for (int m = 0; m < 4; ++m)
#pragma unroll
          for (int n = 0; n < 2; ++n) acc[a][b][m][n] = (f32x4){0.f, 0.f, 0.f, 0.f};
    cpm = npm; cpn = npn; csl = nsl; chf = nhf; chA = nhA; cA = nA; cB = nB; ++ui;
    if (chf >= 0) { pending_half = true; break; }
  }
  if constexpr (Epi::HALFOK) {
    if (pending_half) {
      const char* nA = cA; const char* nB = cB; nhA = chA;
      const int cnt = nt;
      G_KLOOP(0)
      epi(acc, cpm * BM + (chf > 0 ? HALF : 0), cpn * BM, wr, wc, fr, fq, 1);
    }
  }
#undef G_KLOOP
  WAIT_V(0);
  if (wr == 0) BAR;
  BAR;
}

typedef f32x4 Acc[2][2][4][2];

struct EpiSwiglu { static constexpr bool HALFOK = true;
  bf16_t* G;
  __device__ __forceinline__ void operator()(const Acc& acc, int brow, int bcol, int wr, int wc, int fr, int fq, int nai) const {
    const int f0 = (bcol >> 1) + 32 * wc + 8 * fq;
    asm volatile("s_waitcnt vmcnt(14)" ::: "memory");
#pragma unroll
    for (int ai = 0; ai < 2; ++ai)
#pragma unroll
      for (int m = 0; m < 4; ++m) if (ai < nai) {
        const int r = brow + 128 * ai + 64 * wr + 16 * m + fr;
        u32x4 o;
#pragma unroll
        for (int bj = 0; bj < 2; ++bj) {
          const f32x4 a = acc[ai][bj][m][0], b = acc[ai][bj][m][1];
          const float g0 = a[0] * sigmoidf_(a[0]) * b[0], g1 = a[1] * sigmoidf_(a[1]) * b[1];
          const float g2 = a[2] * sigmoidf_(a[2]) * b[2], g3 = a[3] * sigmoidf_(a[3]) * b[3];
          if (bj == 0) { o.x = pk2(g0, g1); o.y = pk2(g2, g3); } else { o.z = pk2(g0, g1); o.w = pk2(g2, g3); }
        }
        *(u32x4*)(G + (size_t)r * DFF + f0) = o;
      }
  }
};

struct EpiResid { static constexpr bool HALFOK = false;
  const float *srcC, *srcL; float *dstC, *dstL; const float* gate;   float coef;
  __device__ __forceinline__ void operator()(const Acc& acc, int brow, int bcol, int wr, int wc, int fr, int fq) const {
    const float* g = gate + (size_t)row_mi(brow) * 9 * DM + bcol + 32 * wc + 4 * fq;
    f32x4 gv[2][2];
#pragma unroll
    for (int bj = 0; bj < 2; ++bj)
#pragma unroll
      for (int n = 0; n < 2; ++n) gv[bj][n] = coef * *(const f32x4*)(g + 128 * bj + 16 * n);
    const size_t rb = (size_t)(brow - NCTX + 64 * wr + fr) * DM + bcol + 32 * wc + 4 * fq;
#pragma unroll
    for (int ai = 0; ai < 2; ++ai)
#pragma unroll
      for (int mp = 0; mp < 2; ++mp) {
        f32x4 xv[2][2][2];
#pragma unroll
        for (int mm = 0; mm < 2; ++mm)
#pragma unroll
          for (int bj = 0; bj < 2; ++bj)
#pragma unroll
            for (int n = 0; n < 2; ++n)
              xv[mm][bj][n] = *(const f32x4*)(srcL + rb + (size_t)(128 * ai + 16 * (2 * mp + mm)) * DM + 128 * bj + 16 * n);
#pragma unroll
        for (int mm = 0; mm < 2; ++mm)
#pragma unroll
          for (int bj = 0; bj < 2; ++bj)
#pragma unroll
            for (int n = 0; n < 2; ++n)
              *(f32x4*)(dstL + rb + (size_t)(128 * ai + 16 * (2 * mp + mm)) * DM + 128 * bj + 16 * n) = xv[mm][bj][n] + gv[bj][n] * acc[ai][bj][2 * mp + mm][n];
      }
  }
};

struct EpiPart { static constexpr bool HALFOK = false;
  float* PART;
  __device__ __forceinline__ void operator()(const Acc& acc, int brow, int bcol, int wr, int wc, int fr, int fq, int sl) const {
#pragma unroll
    for (int ai = 0; ai < 2; ++ai)
#pragma unroll
      for (int m = 0; m < 4; ++m) {
        const int r = brow + 128 * ai + 64 * wr + 16 * m + fr;
        float* d = PART + ((size_t)sl * NCTX + r) * DM;
#pragma unroll
        for (int bj = 0; bj < 2; ++bj)
#pragma unroll
          for (int n = 0; n < 2; ++n) *(f32x4*)(d + bcol + 128 * bj + 32 * wc + 16 * n + 4 * fq) = acc[ai][bj][m][n];
      }
  }
};

struct EpiBf16 { static constexpr bool HALFOK = false;
  bf16_t* O; int ldc;
  __device__ __forceinline__ void operator()(const Acc& acc, int brow, int bcol, int wr, int wc, int fr, int fq) const {
#pragma unroll
    for (int ai = 0; ai < 2; ++ai)
#pragma unroll
      for (int m = 0; m < 4; ++m) {
        const int r = brow + 128 * ai + 64 * wr + 16 * m + fr;
#pragma unroll
        for (int bj = 0; bj < 2; ++bj)
#pragma unroll
          for (int n = 0; n < 2; ++n) {
            const int c = bcol + 128 * bj + 32 * wc + 16 * n + 4 * fq;
            f32x4 v = acc[ai][bj][m][n];
            u32x2 o; o.x = pk2(v[0], v[1]); o.y = pk2(v[2], v[3]);
            *(u32x2*)(O + (size_t)r * ldc + c) = o;
          }
      }
  }
};

struct EpiP { static constexpr bool HALFOK = true;
  bf16_t* O; float* RS;
  __device__ __forceinline__ void operator()(const Acc& acc, int brow, int bcol, int wr, int wc, int fr, int fq, int nai) const {
    asm volatile("s_waitcnt vmcnt(14)" ::: "memory");
#pragma unroll
    for (int ai = 0; ai < 2; ++ai)
#pragma unroll
      for (int m = 0; m < 4; ++m) if (ai < nai) {
        const int r = brow + 128 * ai + 64 * wr + 16 * m + fr;
        float ss0 = 0.f, ss1 = 0.f;
#pragma unroll
        for (int bj = 0; bj < 2; ++bj) {
          const int c = bcol + 128 * bj + 32 * wc + 8 * fq;
          const f32x4 v0 = acc[ai][bj][m][0], v1 = acc[ai][bj][m][1];
          const float q = v0[0] * v0[0] + v0[1] * v0[1] + v0[2] * v0[2] + v0[3] * v0[3] + v1[0] * v1[0] + v1[1] * v1[1] + v1[2] * v1[2] + v1[3] * v1[3];
          if (bj == 0) ss0 += q; else ss1 += q;
          u32x4 o; o.x = pk2(v0[0], v0[1]); o.y = pk2(v0[2], v0[3]); o.z = pk2(v1[0], v1[1]); o.w = pk2(v1[2], v1[3]);
          *(u32x4*)(O + (size_t)r * 2048 + c) = o;
        }
        if (bcol == 1536) {
          float ss = ss0 + ss1; ss += __shfl_xor(ss, 16); ss += __shfl_xor(ss, 32);
          if (fq == 0) atomicAdd(RS + 2 * r, ss);
        } else if (bcol == 1792) {
          float ss = ss0; ss += __shfl_xor(ss, 16); ss += __shfl_xor(ss, 32);
          if (fq == 0) atomicAdd(RS + 2 * r + 1, ss);
        }
      }
  }
};

struct EpiQ { static constexpr bool HALFOK = false;
  const float* RS; const float* rope;   bf16_t* Qall;
  __device__ __forceinline__ void operator()(const Acc& acc, int brow, int bcol, int wr, int wc, int fr, int fq) const {
#pragma unroll
    for (int ai = 0; ai < 2; ++ai)
#pragma unroll
      for (int m = 0; m < 4; ++m) {
        const int r = brow + 128 * ai + 64 * wr + 16 * m + fr;
        const float rstd = rsqrtf(RS[2 * r] * (1.f / 256.f) + 1e-6f) * QSCALE;
        int b, key; row_bk(r, b, key);
        const bool latent = r >= NCTX;
        const int t = (r - NCTX) & 8191;
        bf16_t* qrow = Qall + ((size_t)(b * 8) * NKEY + key) * 96 + 4 * fq;
#pragma unroll
        for (int bj = 0; bj < 2; ++bj) {
          const int c32 = bcol + 128 * bj + 32 * wc;
          const int h = c32 / 96, d32 = c32 - 96 * h;
#pragma unroll
          for (int n = 0; n < 2; ++n) {
            f32x4 v = acc[ai][bj][m][n] * rstd;
            if (d32 == 64) {
              f32x4 pv;
#pragma unroll
              for (int j = 0; j < 4; ++j) pv[j] = __shfl_xor(v[j], 32);
              if (latent) {
                const float* rp = rope + ((size_t)t * 2 + n) * 16 + 4 * (fq & 1);
                const f32x4 cs = *(const f32x4*)rp, sn = *(const f32x4*)(rp + 8);
                v = (fq < 2) ? (v * cs - pv * sn) : (pv * sn + v * cs);
              }
            }
            u32x2 o; o.x = pk2(v[0], v[1]); o.y = pk2(v[2], v[3]);
            *(u32x2*)(qrow + (size_t)h * (NKEY * 96) + d32 + 16 * n) = o;
          }
        }
      }
  }
};
struct EpiKV { static constexpr bool HALFOK = false;
  const float* RS; bf16_t *Kall, *Vt;
  __device__ __forceinline__ void operator()(const Acc& acc, int brow, int bcol, int wr, int wc, int fr, int fq) const {
#pragma unroll
    for (int ai = 0; ai < 2; ++ai)
#pragma unroll
      for (int m = 0; m < 4; ++m) {
        const int r = brow + 128 * ai + 64 * wr + 16 * m + fr;
        const float rstd = rsqrtf(RS[2 * r + 1] * (1.f / 128.f) + 1e-6f);
        int b, key; row_bk(r, b, key);
        bf16_t* krow = Kall + ((size_t)(b * 8) * NKEY + key) * 96 + 4 * fq;
        bf16_t* vrow = Vt + (size_t)(b * 8) * 64 * NKEY + key + (size_t)(4 * fq) * NKEY;
#pragma unroll
        for (int bj = 0; bj < 2; ++bj) {
          const int cc = bcol - 768 + 128 * bj + 32 * wc, h = cc >> 7, e32 = cc & 127;
#pragma unroll
          for (int n = 0; n < 2; ++n) {
            const f32x4 v = acc[ai][bj][m][n] * rstd;
            if (e32 < 64) {
              u32x2 o; o.x = pk2(v[0], v[1]); o.y = pk2(v[2], v[3]);
              *(u32x2*)(krow + (size_t)h * (NKEY * 96) + e32 + 16 * n) = o;
            } else {
              bf16_t* vp = vrow + (size_t)(h * 64 + e32 - 64 + 16 * n) * NKEY;
#pragma unroll
              for (int j = 0; j < 4; ++j) vp[(size_t)j * NKEY] = f2bf(v[j]);
            }
          }
        }
      }
  }
};

struct EpiQKV { static constexpr bool HALFOK = false;
  EpiQ q; EpiKV kv;
  __device__ __forceinline__ void operator()(const Acc& acc, int brow, int bcol, int wr, int wc, int fr, int fq) const {
    if (bcol < 768) q(acc, brow, bcol, wr, wc, fr, fq); else kv(acc, brow, bcol, wr, wc, fr, fq);
  }
};

struct EpiOdd { static constexpr bool HALFOK = true;
  bf16_t *Qh, *Vv, *Gg; _Float16 *Lf, *Lb; const float* lbl;
  __device__ __forceinline__ void operator()(const Acc& acc, int brow, int bcol, int wr, int wc, int fr, int fq, int nai) const {
    const int sec = bcol >> 10;
    const int cb = (bcol & 1023) + 32 * wc + 8 * fq;
    asm volatile("s_waitcnt vmcnt(14)" ::: "memory");
    if (sec == 2 || sec == 3) {
      const int dir = sec - 2;
      _Float16* O = Lf + (size_t)dir * ((size_t)M_ALL * DM);
#pragma unroll
      for (int bj = 0; bj < 2; ++bj) {
        const int c = cb + 128 * bj;
        f32x4 lb[2];
#pragma unroll
        for (int n = 0; n < 2; ++n) {
          const f32x4 z0 = *(const f32x4*)(lbl + dir * 1024 + c + 4 * n), z1 = *(const f32x4*)(lbl + 2048 + dir * 1024 + c + 4 * n);
#pragma unroll
          for (int j = 0; j < 4; ++j) lb[n][j] = __builtin_amdgcn_rcpf(1.f + __expf(z0[j] - z1[j]));
        }
#pragma unroll
        for (int ai = 0; ai < 2; ++ai)
#pragma unroll
          for (int m = 0; m < 4; ++m) if (ai < nai) {
            const int r = brow + 128 * ai + 64 * wr + 16 * m + fr;
            h16x8 hv;
#pragma unroll
            for (int n = 0; n < 2; ++n) {
              const f32x4 v = acc[ai][bj][m][n];
#pragma unroll
              for (int j = 0; j < 4; ++j) hv[4 * n + j] = (_Float16)__logf(lb[n][j] + (1.f - lb[n][j]) * sigmoidf_(v[j]));
            }
            *(h16x8*)(O + (size_t)r * DM + c) = hv;
          }
      }
    } else {
      bf16_t* O = Qh + (size_t)(sec == 4 ? 2 : sec) * ((size_t)M_ALL * DM);
      const float sc = sec == 0 ? HSCALE : 1.f;
#pragma unroll
      for (int ai = 0; ai < 2; ++ai)
#pragma unroll
        for (int m = 0; m < 4; ++m) if (ai < nai) {
          const int r = brow + 128 * ai + 64 * wr + 16 * m + fr;
#pragma unroll
          for (int bj = 0; bj < 2; ++bj) {
            const int c = cb + 128 * bj;
            const f32x4 v0 = acc[ai][bj][m][0] * sc, v1 = acc[ai][bj][m][1] * sc;
            u32x4 o; o.x = pk2(v0[0], v0[1]); o.y = pk2(v0[2], v0[3]); o.z = pk2(v1[0], v1[1]); o.w = pk2(v1[2], v1[3]);
            *(u32x4*)(O + (size_t)r * DM + c) = o;
          }
        }
    }
  }
};

__device__ __forceinline__ void tr_tile(const float* src, int ldn, int k0, int n0, int nv, bf16_t* dst, int ldk, int kofs, int mode, const float* kscale, float* sm) {
  const int tid = threadIdx.x;
  float v[8];
#pragma unroll
  for (int i = 0; i < 8; ++i) {
    const int e = tid + i * NTHR, k = e >> 6, n = e & 63;
    v[i] = (n < nv) ? src[(size_t)(k0 + k) * ldn + n0 + n] : 0.f;
  }
#pragma unroll
  for (int i = 0; i < 8; ++i) {
    const int e = tid + i * NTHR, k = e >> 6, n = e & 63;
    sm[k * 65 + n] = kscale ? v[i] * kscale[k0 + k] : v[i];
  }
  __syncthreads();
  {
    const int n = tid >> 3, kq = tid & 7;
    const int ng = n0 + n;
    int drow = ng;
    if (mode == 1 || mode == 2) {
      const int pn = ng >> 7, rem = ng & 127, wc = rem >> 5, r2 = rem & 31, fq = r2 >> 3, bj = (r2 >> 2) & 1, j = r2 & 3;
      drow = 256 * pn + 128 * bj + 32 * wc + 16 * (mode - 1) + 4 * fq + j;
    } else if (mode == 3) {
      const int o = ng & 31, fq = o >> 3, nn = (o >> 2) & 1, j = o & 3;
      drow = (ng & ~31) + 16 * nn + 4 * fq + j;
    }
    if (n < nv) {
      u32x4 o;
      o.x = pk2(sm[(8 * kq + 0) * 65 + n], sm[(8 * kq + 1) * 65 + n]);
      o.y = pk2(sm[(8 * kq + 2) * 65 + n], sm[(8 * kq + 3) * 65 + n]);
      o.z = pk2(sm[(8 * kq + 4) * 65 + n], sm[(8 * kq + 5) * 65 + n]);
      o.w = pk2(sm[(8 * kq + 6) * 65 + n], sm[(8 * kq + 7) * 65 + n]);
      *(u32x4*)(dst + (size_t)drow * ldk + kofs + k0 + 8 * kq) = o;
    }
  }
  __syncthreads();
}

__device__ void phase_prep(const Params& p, float* sm) {
  const int tid = threadIdx.x;
  int base = 0;
  const int bid = blockIdx.x, G = gridDim.x;
#define TRJOB(SRC, KK, NN, DST, LDK, KOFS, MODE, KS) { const int nk = (KK) / 64, nn = ((NN) + 63) / 64, tot = nk * nn; \
    int first = (bid - base % G + G) % G; \
    for (int t = first; t < tot; t += G) { const int n0_ = (t % nn) * 64; tr_tile((SRC), (NN), (t / nn) * 64, n0_, ((NN) - n0_) < 64 ? ((NN) - n0_) : 64, (DST), (LDK), (KOFS), (MODE), (KS), sm); } \
    base += tot; }
  for (int lj = 0; lj < 4; ++lj) {
    TRJOB(p.ffn_w1 + (size_t)lj * DM * DFF, DM, DFF, p.W13[lj], DM, 0, 1, nullptr);
    TRJOB(p.ffn_w3 + (size_t)lj * DM * DFF, DM, DFF, p.W13[lj], DM, 0, 2, nullptr);
    TRJOB(p.ffn_w2 + (size_t)lj * DFF * DM, DFF, DM, p.W2[lj], DFF, 0, 0, nullptr);
  }
  TRJOB(p.even_w_in, DM, 1952, p.WinE, DM, 0, 3, nullptr);
  TRJOB(p.w_uq, 256, 768, p.Wqkv, 2048, 0, 0, p.q_norm_g);
  TRJOB(p.w_ukv, 128, 1024, p.Wqkv + (size_t)768 * 2048, 2048, 256, 0, p.kv_norm_g);
  TRJOB(p.even_w_out, DM, DM, p.WoutE, DM, 0, 0, nullptr);
  TRJOB(p.odd_w_in, DM, 5120, p.WinO, DM, 0, 3, nullptr);
  TRJOB(p.odd_w_out, DM, DM, p.WoutO, DM, 0, 0, nullptr);
#undef TRJOB
  for (int i = bid * NTHR + tid; i < 96 * 1024; i += G * NTHR) p.WinE[(size_t)1952 * 1024 + i] = 0;
  for (int i = bid * NTHR + tid; i < 768 * 128; i += G * NTHR) p.Wqkv[(size_t)(i >> 7) * 2048 + 256 + (i & 127)] = 0;
  for (int i = bid * NTHR + tid; i < 1024 * 256; i += G * NTHR) p.Wqkv[(size_t)(768 + (i >> 8)) * 2048 + (i & 255)] = 0;
  for (int i = bid * NTHR + tid; i < M_ALL * 2; i += G * NTHR) p.RS[i] = 0.f;
  for (int i = bid * NTHR + tid; i < 1024; i += G * NTHR) p.aflag[i] = 0u;
  for (int i = bid * NTHR + tid; i < 8192 * 16; i += G * NTHR) {
    const int t = i >> 4, ax = (i >> 3) & 1, fi = i & 7;
    const float pos = (float)(ax == 0 ? (t >> 6) : (t & 63));
    const float ang = pos * exp2f(-(float)fi * (13.287712379549449f / 8.f));
    p.rope[(size_t)(t * 2 + ax) * 16 + fi] = cosf(ang); p.rope[(size_t)(t * 2 + ax) * 16 + 8 + fi] = sinf(ang);
  }
  {
    float* scond = sm;
    float* red = sm + 5 * 1024;
    for (int i = tid; i < 5 * 1024; i += NTHR) {
      const int mi = i >> 10, k = i & 1023;
      const float cv = mi < 4 ? p.c[mi * 1024 + k] : p.c_ctx[k];
      scond[i] = cv * sigmoidf_(cv);
    }
    __syncthreads();
    const int col = tid & 63, kg = tid >> 6;
    for (int it = G - 1 - bid; it < 2 * 144; it += G) {
      const int l = it / 144, n = (it % 144) * 64 + col;
      const float* w = p.ada_w + (size_t)l * 1024 * 9216 + n;
      float a0 = 0, a1 = 0, a2 = 0, a3 = 0, a4 = 0;
#pragma unroll 16
      for (int k = kg * 128; k < kg * 128 + 128; ++k) {
        const float wv = w[(size_t)k * 9216];
        a0 += scond[k] * wv; a1 += scond[1024 + k] * wv; a2 += scond[2048 + k] * wv; a3 += scond[3072 + k] * wv; a4 += scond[4096 + k] * wv;
      }
      red[(kg * 5 + 0) * 64 + col] = a0; red[(kg * 5 + 1) * 64 + col] = a1; red[(kg * 5 + 2) * 64 + col] = a2;
      red[(kg * 5 + 3) * 64 + col] = a3; red[(kg * 5 + 4) * 64 + col] = a4;
      __syncthreads();
      for (int i = tid; i < 5 * 64; i += NTHR) {
        const int mi = i >> 6, cc = i & 63, nn = (it % 144) * 64 + cc;
        float sacc = 0.f;
#pragma unroll
        for (int q = 0; q < 8; ++q) sacc += red[(q * 5 + mi) * 64 + cc];
        p.mod[((size_t)(l * 5 + mi)) * 9216 + nn] = sacc + p.ada_b[l * 9216 + nn];
      }
      __syncthreads();
    }
  }
}

__device__ __forceinline__ void phase_norm(const Params& p, int l, int j, const float* srcC, const float* srcL, int row0,
                           const float* PART = nullptr, int ksl = 0, float coef = 0.f, const float* pgate = nullptr) {
  constexpr int NR = 2;
  const int wave = threadIdx.x >> 6, lane = threadIdx.x & 63;
  const float* g = p.norm_g + (l * 3 + j) * 1024;
  f32x4 gv[4];
#pragma unroll
  for (int i = 0; i < 4; ++i) gv[i] = *(const f32x4*)(g + (lane + 64 * i) * 4);
  const int stride = gridDim.x * 8;
  for (int rb = row0 + blockIdx.x * 8 + wave; rb < M_ALL; rb += stride * NR) {
    f32x4 v[NR][4], sv[NR][4], hv[NR][4];
#pragma unroll
    for (int q = 0; q < NR; ++q) {
      const int rr = rb + q * stride, r = rr < M_ALL ? rr : M_ALL - 1;
      const float* src = r < NCTX ? srcC + (size_t)r * DM : srcL + (size_t)(r - NCTX) * DM;
      const float* sh = p.mod + ((size_t)(l * 5 + row_mi(r)) * 9 + 3 * j) * 1024;
#pragma unroll
      for (int i = 0; i < 4; ++i) { v[q][i] = ((const f32x4*)src)[lane + 64 * i]; hv[q][i] = ((const f32x4*)sh)[lane + 64 * i]; sv[q][i] = ((const f32x4*)(sh + 1024))[lane + 64 * i]; }
      if (ksl > 0 && r < NCTX) {
#pragma unroll
        for (int i = 0; i < 4; ++i) {
          f32x4 a = {0.f, 0.f, 0.f, 0.f};
          for (int sl = 0; sl < ksl; ++sl) a += ((const f32x4*)(PART + ((size_t)sl * NCTX + r) * DM))[lane + 64 * i];
          v[q][i] += coef * ((const f32x4*)pgate)[lane + 64 * i] * a;
        }
      }
    }
#pragma unroll
    for (int q = 0; q < NR; ++q) {
      const int rr = rb + q * stride, r = rr < M_ALL ? rr : M_ALL - 1;
      const bool live = rr < M_ALL;
      float ss = 0.f;
#pragma unroll
      for (int i = 0; i < 4; ++i) ss += v[q][i][0] * v[q][i][0] + v[q][i][1] * v[q][i][1] + v[q][i][2] * v[q][i][2] + v[q][i][3] * v[q][i][3];
      ss = wave_sum(ss);
      const float rstd = rsqrtf(ss * (1.f / 1024.f) + 1e-6f);
      if (live) {
        if (ksl > 0 && r < NCTX) {
#pragma unroll
          for (int i = 0; i < 4; ++i) ((f32x4*)(p.XC + (size_t)r * DM))[lane + 64 * i] = v[q][i];
        }
#pragma unroll
        for (int i = 0; i < 4; ++i) {
          const f32x4 u = v[q][i] * rstd * gv[i] * (1.f + sv[q][i]) + hv[q][i];
          u32x2 o; o.x = pk2(u[0], u[1]); o.y = pk2(u[2], u[3]);
          *(u32x2*)(p.U + (size_t)r * DM + (lane + 64 * i) * 4) = o;
        }
      }
    }
  }
}

__device__ __forceinline__ void phase_final_norm(const Params& p) {
  constexpr int NR = 4;
  const int wave = threadIdx.x >> 6, lane = threadIdx.x & 63;
  f32x4 gv[4];
#pragma unroll
  for (int i = 0; i < 4; ++i) gv[i] = *(const f32x4*)(p.final_norm_g + (lane + 64 * i) * 4);
  const int stride = gridDim.x * 8;
  for (int rb = blockIdx.x * 8 + wave; rb < 32768; rb += stride * NR) {
    f32x4 v[NR][4];
#pragma unroll
    for (int q = 0; q < NR; ++q) {
      const int rr = rb + q * stride, r = rr < 32768 ? rr : 32767;
#pragma unroll
      for (int i = 0; i < 4; ++i) v[q][i] = ((const f32x4*)(p.out + (size_t)r * DM))[lane + 64 * i];
    }
#pragma unroll
    for (int q = 0; q < NR; ++q) {
      const int rr = rb + q * stride, r = rr < 32768 ? rr : 32767;
      const bool live = rr < 32768;
      float ss = 0.f;
#pragma unroll
      for (int i = 0; i < 4; ++i) ss += v[q][i][0] * v[q][i][0] + v[q][i][1] * v[q][i][1] + v[q][i][2] * v[q][i][2] + v[q][i][3] * v[q][i][3];
      ss = wave_sum(ss);
      const float rstd = rsqrtf(ss * (1.f / 1024.f) + 1e-6f);
#pragma unroll
      for (int i = 0; i < 4; ++i) {
        const int c = (lane + 64 * i) * 4;
        if (live) ((f32x4*)(p.out + (size_t)r * DM))[lane + 64 * i] = v[q][i] * rstd * gv[i];
      }
    }
  }
}

__device__ void phase_even_elem(const Params& p, const bf16_t* P, bf16_t* CAT, bf16_t* Kall) {
  const int wave = threadIdx.x >> 6, lane = threadIdx.x & 63;
  for (int r = blockIdx.x * 8 + wave; r < M_ALL; r += gridDim.x * 8) {
    int b, key; row_bk(r, b, key);
    const bool latent = r >= NCTX;
    const int t = latent ? ((r - NCTX) & 8191) : (r & 255), T = latent ? 8192 : 256;
    const int c0 = lane * 8;
    float cv[3][8];
#pragma unroll
    for (int dt = 0; dt < 3; ++dt) {
      const int tt = t + dt - 1;
      if (tt >= 0 && tt < T) {
        const bf16_t* pr = P + (size_t)(r + dt - 1) * 2048;
        u32x4 gc = *(const u32x4*)(pr + 512 + c0), vv = *(const u32x4*)(pr + 1024 + c0);
#pragma unroll
        for (int e = 0; e < 4; ++e) { cv[dt][2 * e] = lo2f(gc[e]) * lo2f(vv[e]); cv[dt][2 * e + 1] = hi2f(gc[e]) * hi2f(vv[e]); }
      } else {
#pragma unroll
        for (int e = 0; e < 8; ++e) cv[dt][e] = 0.f;
      }
    }
    u32x4 gb = *(const u32x4*)(P + (size_t)r * 2048 + c0);
    float o[8];
#pragma unroll
    for (int e = 0; e < 8; ++e) {
      const float w0 = p.even_conv_w[c0 + e], w1 = p.even_conv_w[512 + c0 + e], w2 = p.even_conv_w[1024 + c0 + e];
      const float g = (e & 1) ? hi2f(gb[e >> 1]) : lo2f(gb[e >> 1]);
      o[e] = g * (cv[0][e] * w0 + cv[1][e] * w1 + cv[2][e] * w2);
    }
    u32x4 ov; ov.x = pk2(o[0], o[1]); ov.y = pk2(o[2], o[3]); ov.z = pk2(o[4], o[5]); ov.w = pk2(o[6], o[7]);
    *(u32x4*)(CAT + (size_t)r * DM + c0) = ov;
    {
      const int d = lane & 31;
      float v = bf2f(P[(size_t)r * 2048 + 1920 + d]);
      const float pv = __shfl_xor(v, 8);
      const int idx = d & 15, fi = idx & 7;
      if (latent) {
        const float* rp = p.rope + ((size_t)t * 2 + (d >> 4)) * 16 + fi;
        const float cs = rp[0], sn = rp[8];
        v = (idx < 8) ? (v * cs - pv * sn) : (pv * sn + v * cs);
      }
      const bf16_t bv = f2bf(v);
      if (lane < 32) {
#pragma unroll
        for (int h = 0; h < 8; ++h) Kall[((size_t)(b * 8 + h) * NKEY + key) * 96 + 64 + d] = bv;
      }
    }
  }
}

__device__ void phase_attn_scalar(const Params& p, const bf16_t* Qall, const bf16_t* Kall, const bf16_t* Vt, bf16_t* CAT) {
  const int ql = threadIdx.x & 255, half = threadIdx.x >> 8;
  for (int it = blockIdx.x; it < 1056; it += gridDim.x) {
    int b, h, q0, nk;
    if (it < 1024) { b = it >> 8; h = (it >> 5) & 7; q0 = 256 + (it & 31) * 256; nk = NKEY; }
    else { const int i2 = it - 1024; b = i2 >> 3; h = i2 & 7; q0 = 0; nk = 256; }
    const int qi = q0 + ql;
    const size_t bh = (size_t)(b * 8 + h);
    float q[96];
    {
      const u32x4* qp = (const u32x4*)(Qall + (bh * NKEY + qi) * 96);
#pragma unroll
      for (int i = 0; i < 12; ++i) { u32x4 v = qp[i];
#pragma unroll
        for (int e = 0; e < 4; ++e) { q[8 * i + 2 * e] = lo2f(v[e]); q[8 * i + 2 * e + 1] = hi2f(v[e]); } }
    }
    float o[32];
#pragma unroll
    for (int i = 0; i < 32; ++i) o[i] = 0.f;
    float mrun = -1e30f, lrun = 0.f;
    for (int k0 = 0; k0 < nk; k0 += 4) {
      float s[4];
#pragma unroll
      for (int kk = 0; kk < 4; ++kk) {
        const u32x4* kp = (const u32x4*)(Kall + (bh * NKEY + k0 + kk) * 96);
        float a = 0.f;
#pragma unroll
        for (int i = 0; i < 12; ++i) { u32x4 v = kp[i];
#pragma unroll
          for (int e = 0; e < 4; ++e) a += q[8 * i + 2 * e] * lo2f(v[e]) + q[8 * i + 2 * e + 1] * hi2f(v[e]); }
        s[kk] = a;
      }
      const float mx = fmaxf(fmaxf(s[0], s[1]), fmaxf(s[2], s[3]));
      const float mnew = fmaxf(mrun, mx);
      const float alpha = exp2f(mrun - mnew);
      const float p0 = exp2f(s[0] - mnew), p1 = exp2f(s[1] - mnew), p2 = exp2f(s[2] - mnew), p3 = exp2f(s[3] - mnew);
      lrun = lrun * alpha + p0 + p1 + p2 + p3;
      mrun = mnew;
#pragma unroll
      for (int dv = 0; dv < 32; ++dv) {
        u32x2 v = *(const u32x2*)(Vt + (bh * 64 + half * 32 + dv) * NKEY + k0);
        o[dv] = o[dv] * alpha + p0 * lo2f(v.x) + p1 * hi2f(v.x) + p2 * lo2f(v.y) + p3 * hi2f(v.y);
      }
    }
    const float il = 1.f / lrun;
    const int r = qi < 256 ? b * 256 + qi : NCTX + b * 8192 + (qi - 256);
    u32x4* op = (u32x4*)(CAT + (size_t)r * DM + 512 + h * 64 + half * 32);
#pragma unroll
    for (int i = 0; i < 4; ++i) {
      u32x4 v; v.x = pk2(o[8 * i] * il, o[8 * i + 1] * il); v.y = pk2(o[8 * i + 2] * il, o[8 * i + 3] * il);
      v.z = pk2(o[8 * i + 4] * il, o[8 * i + 5] * il); v.w = pk2(o[8 * i + 6] * il, o[8 * i + 7] * il);
      op[i] = v;
    }
  }
}

typedef float f32x16 __attribute__((ext_vector_type(16)));
__device__ __forceinline__ float ex2(float x) { return __builtin_amdgcn_exp2f(x); }
template <bool SAFE>
__device__ void phase_attn(const Params& p, const bf16_t* Qall, const bf16_t* Kall, const bf16_t* Vt, bf16_t* CAT, LAS unsigned char* lds) {
  const int tid = threadIdx.x, w = __builtin_amdgcn_readfirstlane(tid >> 6), lane = tid & 63, r = lane & 31, hh = lane >> 5;
  constexpr int KROW = 104, VROW = 72;
  constexpr int KBYTES = 64 * KROW * 2, VBYTES = 64 * VROW * 2, BUF = KBYTES + VBYTES;
  unsigned soff[3];
#pragma unroll
  for (int j = 0; j < 3; ++j) {
    const int ci = (3 * w + j) * 64 + lane;
    if (3 * w + j < 13) { const int row = ci / 13, part = ci % 13; soff[j] = (unsigned)(row * 96 + (part < 12 ? part : 0) * 8) * 2u; }
    else { const int c2 = ci - 832, dv = c2 / 9, part = c2 % 9; soff[j] = (unsigned)((dv < 64 ? dv : 0) * NKEY + (part < 8 ? part : 0) * 8) * 2u; }
  }
#define ATT_STAGE(bufi, k0_) do { _Pragma("unroll") for (int j_ = 0; j_ < 3; ++j_) if (j_ == 0 || w < 7) { \
    const char* g_ = (3 * w + j_ < 13) ? (const char*)kbase + soff[j_] + (size_t)(k0_) * 192 : (const char*)vbase + soff[j_] + (size_t)(k0_) * 2; \
    __builtin_amdgcn_global_load_lds((const unsigned*)g_, (LAS unsigned*)(lds + (bufi) * BUF + (3 * w + j_) * 1024), 16, 0, 0); } } while (0)
  for (int it = blockIdx.x; it < 544; it += gridDim.x) {
    if (SAFE && p.aflag[it] == 0u) continue;
    bool wbad = false;
    int b, h, q0, nk, nq;
    if (it < 512) { b = it >> 7; h = (it >> 4) & 7; q0 = 256 + (it & 15) * 512; nk = NKEY; nq = 512; }
    else { const int i2 = it - 512; b = i2 >> 3; h = i2 & 7; q0 = 0; nk = 256; nq = 256; }
    const size_t bh = (size_t)(b * 8 + h);
    const int qw = 64 * w;
    const bool wact = qw < nq;
    const int qbase = q0 + (wact ? qw : 0) + r;
    bf16x8 qf[2][6];
#pragma unroll
    for (int qb = 0; qb < 2; ++qb) {
      const bf16_t* qp = Qall + (bh * NKEY + qbase + 32 * qb) * 96 + 8 * hh;
#pragma unroll
      for (int c = 0; c < 6; ++c) qf[qb][c] = *(const bf16x8*)(qp + 16 * c);
    }
    f32x16 o[2][2];
#pragma unroll
    for (int qb = 0; qb < 2; ++qb)
#pragma unroll
      for (int i = 0; i < 16; ++i) { o[qb][0][i] = 0.f; o[qb][1][i] = 0.f; }
    float mrun[2] = {0.f, 0.f}, lrun[2] = {0.f, 0.f};
    const bf16_t* kbase = Kall + bh * NKEY * 96;
    const bf16_t* vbase = Vt + bh * 64 * NKEY;
    ATT_STAGE(0, 0);
    asm volatile("s_waitcnt vmcnt(0)" ::: "memory");
    __syncthreads();
    const int ntile = nk >> 6;
    for (int i = 0; i < ntile; ++i) {
      const bool more = (i + 1 < ntile);
      if (more) ATT_STAGE((i + 1) & 1, (i + 1) * 64);
      LAS unsigned char* kb_ = lds + (i & 1) * BUF;
      LAS unsigned char* vb_ = kb_ + KBYTES;
      f32x16 s[2][2];
#pragma unroll
      for (int qb = 0; qb < 2; ++qb)
#pragma unroll
        for (int e = 0; e < 16; ++e) { s[qb][0][e] = 0.f; s[qb][1][e] = 0.f; }
#pragma unroll
      for (int c = 0; c < 6; ++c) {
        const bf16x8 ka = *(const LAS bf16x8*)(kb_ + (r * KROW + 16 * c + 8 * hh) * 2);
        const bf16x8 kb2 = *(const LAS bf16x8*)(kb_ + ((32 + r) * KROW + 16 * c + 8 * hh) * 2);
#pragma unroll
        for (int qb = 0; qb < 2; ++qb) {
          s[qb][0] = __builtin_amdgcn_mfma_f32_32x32x16_bf16(ka, qf[qb][c], s[qb][0], 0, 0, 0);
          s[qb][1] = __builtin_amdgcn_mfma_f32_32x32x16_bf16(kb2, qf[qb][c], s[qb][1], 0, 0, 0);
        }
      }
#pragma unroll
      for (int qb = 0; qb < 2; ++qb) {
        if (SAFE) {
          float mx = fmaxf(s[qb][0][0], s[qb][1][0]);
#pragma unroll
          for (int e = 1; e < 16; ++e) mx = fmaxf(mx, fmaxf(s[qb][0][e], s[qb][1][e]));
          mx = fmaxf(mx, __shfl_xor(mx, 32));
          const bool need = (i == 0) || (mx - mrun[qb] > 8.f);
          if (__builtin_amdgcn_ballot_w64(need) != 0ull) {
            const float nm = need ? mx : mrun[qb];
            const float alpha = (i == 0) ? 1.f : ex2(mrun[qb] - nm);
            mrun[qb] = nm; lrun[qb] *= alpha;
#pragma unroll
            for (int e = 0; e < 16; ++e) { o[qb][0][e] *= alpha; o[qb][1][e] *= alpha; }
          }
        }
        f32x2 ps2 = {0.f, 0.f};
        const f32x2 m2 = {mrun[qb], mrun[qb]};
#pragma unroll
        for (int kb = 0; kb < 2; ++kb)
#pragma unroll
          for (int e = 0; e < 16; e += 2) {
            f32x2 t = {s[qb][kb][e], s[qb][kb][e + 1]};
            if (SAFE) t = t - m2;
            t.x = ex2(t.x); t.y = ex2(t.y);
            ps2 += t;
            s[qb][kb][e] = t.x; s[qb][kb][e + 1] = t.y;
          }
        lrun[qb] += ps2.x + ps2.y;
        if (!SAFE) wbad = wbad || !(ps2.x + ps2.y < 1.2089258e24f);
      }
#pragma unroll
      for (int kb = 0; kb < 2; ++kb)
#pragma unroll
        for (int t = 0; t < 2; ++t) {
          const int kofs = 32 * kb + 16 * t + 4 * hh;
          u32x4 va, vb2;
          { const u32x2 lo = *(const LAS u32x2*)(vb_ + (r * VROW + kofs) * 2), hi = *(const LAS u32x2*)(vb_ + (r * VROW + kofs + 8) * 2); va.x = lo.x; va.y = lo.y; va.z = hi.x; va.w = hi.y; }
          { const u32x2 lo = *(const LAS u32x2*)(vb_ + ((32 + r) * VROW + kofs) * 2), hi = *(const LAS u32x2*)(vb_ + ((32 + r) * VROW + kofs + 8) * 2); vb2.x = lo.x; vb2.y = lo.y; vb2.z = hi.x; vb2.w = hi.y; }
#pragma unroll
          for (int qb = 0; qb < 2; ++qb) {
            u32x4 pw;
            pw.x = pk2(s[qb][kb][8 * t], s[qb][kb][8 * t + 1]); pw.y = pk2(s[qb][kb][8 * t + 2], s[qb][kb][8 * t + 3]);
            pw.z = pk2(s[qb][kb][8 * t + 4], s[qb][kb][8 * t + 5]); pw.w = pk2(s[qb][kb][8 * t + 6], s[qb][kb][8 * t + 7]);
            const bf16x8 pf = __builtin_bit_cast(bf16x8, pw);
            o[qb][0] = __builtin_amdgcn_mfma_f32_32x32x16_bf16(__builtin_bit_cast(bf16x8, va), pf, o[qb][0], 0, 0, 0);
            o[qb][1] = __builtin_amdgcn_mfma_f32_32x32x16_bf16(__builtin_bit_cast(bf16x8, vb2), pf, o[qb][1], 0, 0, 0);
          }
        }
      asm volatile("s_waitcnt vmcnt(0)" ::: "memory");
      __syncthreads();
    }
    if (!SAFE) { if (__builtin_amdgcn_ballot_w64(wbad) != 0ull && lane == 0) p.aflag[it] = 1u; }
    if (wact) {
#pragma unroll
      for (int qb = 0; qb < 2; ++qb) {
        float l = lrun[qb]; l += __shfl_xor(l, 32);
        if (!SAFE) { if (__builtin_amdgcn_ballot_w64(!(l > 8.6736174e-19f)) != 0ull && lane == 0) p.aflag[it] = 1u; }
        const float il = 1.f / l;
        const int qi = qbase + 32 * qb;
        const int row = qi < 256 ? b * 256 + qi : NCTX + b * 8192 + (qi - 256);
        bf16_t* op = CAT + (size_t)row * DM + 512 + h * 64 + 4 * hh;
#pragma unroll
        for (int g = 0; g < 4; ++g) {
          u32x2 a; a.x = pk2(o[qb][0][4 * g] * il, o[qb][0][4 * g + 1] * il); a.y = pk2(o[qb][0][4 * g + 2] * il, o[qb][0][4 * g + 3] * il);
          *(u32x2*)(op + 8 * g) = a;
          u32x2 c; c.x = pk2(o[qb][1][4 * g] * il, o[qb][1][4 * g + 1] * il); c.y = pk2(o[qb][1][4 * g + 2] * il, o[qb][1][4 * g + 3] * il);
          *(u32x2*)(op + 32 + 8 * g) = c;
        }
      }
    }
  }
}
#undef ATT_STAGE

__device__ void phase_hgrn_scalar(const Params& p, int dir, const bf16_t* Qh, const bf16_t* Vv, const bf16_t* Gg, const _Float16* Lx, bf16_t* O, float* sm) {
  float* sf = sm; float* sk = sm + 128; float* sq = sm + 256; float* part = sm + 384;   float* red = sm + 896;
  const int tid = threadIdx.x, dv = tid & 127, kg = tid >> 7;
  for (int it = blockIdx.x; it < 32; it += gridDim.x) {
    const int b = it >> 3, h = it & 7;
    float S[32];
#pragma unroll
    for (int i = 0; i < 32; ++i) S[i] = 0.f;
    for (int n = 0; n < NKEY; ++n) {
      int r; bool latent = n >= 256;
      if (!latent) r = b * 256 + (dir == 0 ? n : 255 - n);
      else r = NCTX + b * 8192 + (dir == 0 ? (n - 256) : (8191 - (n - 256)));
      const size_t off = (size_t)r * DM + h * 128;
      if (tid < 128) {
        const float f = __expf((float)Lx[off + tid]);
        sf[tid] = f; sk[tid] = 1.f - f; sq[tid] = bf2f(Qh[off + tid]);
      }
      __syncthreads();
      const float v = bf2f(Vv[off + dv]);
      float po = 0.f;
#pragma unroll
      for (int i = 0; i < 32; ++i) { const int dk = kg * 32 + i; S[i] = sf[dk] * S[i] + sk[dk] * v; po += S[i] * sq[dk]; }
      if (latent) {
        part[kg * 128 + dv] = po;
        __syncthreads();
        if (tid < 128) {
          float o = part[tid] + part[128 + tid] + part[256 + tid] + part[384 + tid];
          if (dir == 0) O[off + tid] = f2bf(o);
          else {
            o += bf2f(O[off + tid]);
            float ss = wave_sum(o * o);
            if ((tid & 63) == 0) red[tid >> 6] = ss;
            part[tid] = o;
          }
        }
        __syncthreads();
        if (dir == 1 && tid < 128) {
          const float o = part[tid];
          const float rstd = rsqrtf((red[0] + red[1]) * (1.f / 128.f) + 1e-6f);
          const float g = bf2f(Gg[off + tid]);
          O[off + tid] = f2bf(o * rstd * p.g_norm_g[tid] * g * sigmoidf_(g));
        }
      }
      __syncthreads();
    }
  }
}

template <bool OUT>
__device__ void phase_hgrn(const Params& p, const bf16_t* Qh, const bf16_t* Vv, const _Float16* Lfb, bf16_t* Of, bf16_t* Ob, float* Sseg, float* Dlog, LAS unsigned char* lds) {
  constexpr int NSEG = 4, CPS = 33, NIT = OUT ? 64 * NSEG : 64 * (NSEG - 1);
  constexpr int QT = 0, KT = QT + 64 * 136 * 2, KE = KT + 64 * 136 * 2, VT = KE + 128 * 72 * 2, AT = VT + 128 * 72 * 2,
                ST = AT + 64 * 72 * 2, DC = ST + 128 * 136 * 2, TOT = DC + 512;
  const int tid = threadIdx.x, w = tid >> 6, lane = tid & 63, r = lane & 31, hh = lane >> 5;
  const int dk = tid & 127, tq = tid >> 7;
  const int dvb = w & 3, wh = w >> 2;
  for (int it = blockIdx.x; it < NIT; it += gridDim.x) {
    const int bhd = OUT ? it >> 2 : it / 3, sg = OUT ? it & 3 : it % 3;
    const int b = bhd >> 4, h = (bhd >> 1) & 7, dir = bhd & 1;
    const int c_begin = sg * CPS, c_end = c_begin + CPS;
    const _Float16* Lx = Lfb + (size_t)dir * ((size_t)M_ALL * DM);
    const int sgn = dir ? -1 : 1;
    f32x16 S0, S1;
#pragma unroll
    for (int e = 0; e < 16; ++e) { S0[e] = 0.f; S1[e] = 0.f; }
    if constexpr (OUT) {
      for (int sp = 0; sp < sg; ++sp) {
        const float* sp_ = Sseg + ((size_t)(bhd * 3 + sp) * 8 + w) * 2048;
        const float* dl = Dlog + (size_t)(bhd * 3 + sp) * 128;
#pragma unroll
        for (int g = 0; g < 4; ++g) {
          const f32x4 d0 = *(const f32x4*)(dl + 32 * (2 * wh) + 8 * g + 4 * hh), d1 = *(const f32x4*)(dl + 32 * (2 * wh + 1) + 8 * g + 4 * hh);
#pragma unroll
          for (int j = 0; j < 4; ++j) {
            S0[4 * g + j] = S0[4 * g + j] * __expf(d0[j]) + sp_[(4 * g + j) * 64 + lane];
            S1[4 * g + j] = S1[4 * g + j] * __expf(d1[j]) + sp_[1024 + (4 * g + j) * 64 + lane];
          }
        }
      }
#pragma unroll
      for (int g = 0; g < 4; ++g) {
        u32x2 a0; a0.x = pk2(S0[4 * g], S0[4 * g + 1]); a0.y = pk2(S0[4 * g + 2], S0[4 * g + 3]);
        *(LAS u32x2*)(lds + ST + ((32 * dvb + r) * 136 + 32 * (2 * wh) + 8 * g + 4 * hh) * 2) = a0;
        u32x2 a1; a1.x = pk2(S1[4 * g], S1[4 * g + 1]); a1.y = pk2(S1[4 * g + 2], S1[4 * g + 3]);
        *(LAS u32x2*)(lds + ST + ((32 * dvb + r) * 136 + 32 * (2 * wh + 1) + 8 * g + 4 * hh) * 2) = a1;
      }
    }
    float dsum = 0.f;
    _Float16 lfr[16]; bf16_t qr[16], vr[16];
    {
      const int cn = c_begin;
      const int rb0 = (cn < 4) ? b * 256 + (dir ? 255 - 64 * cn : 64 * cn) : NCTX + b * 8192 + (dir ? 8191 - 64 * (cn - 4) : 64 * (cn - 4));
      const size_t o0 = (size_t)(rb0 + sgn * 16 * tq) * DM + h * 128 + dk;
#pragma unroll
      for (int i = 0; i < 16; ++i) { const size_t o = o0 + (ptrdiff_t)(sgn * i) * DM; lfr[i] = Lx[o]; if constexpr (OUT) qr[i] = Qh[o]; else qr[i] = 0; vr[i] = Vv[o]; }
    }
    __syncthreads();
    for (int c = c_begin; c < c_end; ++c) {
      const int rbase = (c < 4) ? b * 256 + (dir ? 255 - 64 * c : 64 * c) : NCTX + b * 8192 + (dir ? 8191 - 64 * (c - 4) : 64 * (c - 4));
      float lf[16], cs[16];
      float run = 0.f;
#pragma unroll
      for (int i = 0; i < 16; ++i) { lf[i] = (float)lfr[i]; run += lf[i]; cs[i] = run; }
      *(LAS float*)(lds + TOT + (tq * 128 + dk) * 4) = run;
      __syncthreads();
      float offs = 0.f, blast = 0.f;
#pragma unroll
      for (int g = 0; g < 4; ++g) { const float t = *(const LAS float*)(lds + TOT + (g * 128 + dk) * 4); blast += t; if (g < tq) offs += t; }
      {
        const float eblast = __expf(blast);
        unsigned kew[8], vw[8];
#pragma unroll
        for (int i = 0; i < 16; i += 2) {
          float qt[2], kt[2], ke[2];
#pragma unroll
          for (int e = 0; e < 2; ++e) {
            const float bb = offs + cs[i + e];
            const float k = 1.f - __expf(lf[i + e]);
            const float ken = k * __expf(-bb);
            if constexpr (OUT) { qt[e] = bf2f(qr[i + e]) * __expf(bb); kt[e] = ken; }
            ke[e] = ken * eblast;
          }
          if constexpr (OUT) {
            const unsigned qp = pk2(qt[0], qt[1]), kp = pk2(kt[0], kt[1]);
            const int s = 16 * tq + i;
            *(LAS bf16_t*)(lds + QT + (s * 136 + dk) * 2) = (bf16_t)(qp & 0xffffu);
            *(LAS bf16_t*)(lds + QT + ((s + 1) * 136 + dk) * 2) = (bf16_t)(qp >> 16);
            *(LAS bf16_t*)(lds + KT + (s * 136 + dk) * 2) = (bf16_t)(kp & 0xffffu);
            *(LAS bf16_t*)(lds + KT + ((s + 1) * 136 + dk) * 2) = (bf16_t)(kp >> 16);
          }
          kew[i >> 1] = pk2(ke[0], ke[1]);
          vw[i >> 1] = (unsigned)vr[i] | ((unsigned)vr[i + 1] << 16);
        }
        *(LAS u32x4*)(lds + KE + (dk * 72 + 16 * tq) * 2) = (u32x4){kew[0], kew[1], kew[2], kew[3]};
        *(LAS u32x4*)(lds + KE + (dk * 72 + 16 * tq + 8) * 2) = (u32x4){kew[4], kew[5], kew[6], kew[7]};
        *(LAS u32x4*)(lds + VT + (dk * 72 + 16 * tq) * 2) = (u32x4){vw[0], vw[1], vw[2], vw[3]};
        *(LAS u32x4*)(lds + VT + (dk * 72 + 16 * tq + 8) * 2) = (u32x4){vw[4], vw[5], vw[6], vw[7]};
        if (tq == 0) *(LAS float*)(lds + DC + dk * 4) = eblast;
        dsum += blast;
      }
      __syncthreads();
      if (c + 1 < c_end) {
        const int cn = c + 1;
        const int rb = (cn < 4) ? b * 256 + (dir ? 255 - 64 * cn : 64 * cn) : NCTX + b * 8192 + (dir ? 8191 - 64 * (cn - 4) : 64 * (cn - 4));
        const size_t o0 = (size_t)(rb + sgn * 16 * tq) * DM + h * 128 + dk;
#pragma unroll
        for (int i = 0; i < 16; ++i) { const size_t o = o0 + (ptrdiff_t)(sgn * i) * DM; lfr[i] = Lx[o]; if constexpr (OUT) qr[i] = Qh[o]; else qr[i] = 0; vr[i] = Vv[o]; }
      }
      if (OUT && w < 3) {
        const int sb = (w == 2) ? 1 : 0, tb = (w == 0) ? 0 : 1;
        f32x16 a;
#pragma unroll
        for (int e = 0; e < 16; ++e) a[e] = 0.f;
#pragma unroll
        for (int ks = 0; ks < 8; ++ks) {
          const bf16x8 ka = *(const LAS bf16x8*)(lds + KT + ((32 * sb + r) * 136 + 16 * ks + 8 * hh) * 2);
          const bf16x8 qb = *(const LAS bf16x8*)(lds + QT + ((32 * tb + r) * 136 + 16 * ks + 8 * hh) * 2);
          a = __builtin_amdgcn_mfma_f32_32x32x16_bf16(ka, qb, a, 0, 0, 0);
        }
        const int tok = 32 * tb + r;
#pragma unroll
        for (int g = 0; g < 4; ++g) {
          const int s0 = 32 * sb + 8 * g + 4 * hh;
          const float v0 = (s0 + 0 <= tok) ? a[4 * g + 0] : 0.f, v1 = (s0 + 1 <= tok) ? a[4 * g + 1] : 0.f;
          const float v2 = (s0 + 2 <= tok) ? a[4 * g + 2] : 0.f, v3 = (s0 + 3 <= tok) ? a[4 * g + 3] : 0.f;
          u32x2 o; o.x = pk2(v0, v1); o.y = pk2(v2, v3);
          *(LAS u32x2*)(lds + AT + (tok * 72 + s0) * 2) = o;
        }
      }
      {
#pragma unroll
        for (int g = 0; g < 4; ++g) {
          const f32x4 d0 = *(const LAS f32x4*)(lds + DC + (32 * (2 * wh) + 8 * g + 4 * hh) * 4);
          const f32x4 d1 = *(const LAS f32x4*)(lds + DC + (32 * (2 * wh + 1) + 8 * g + 4 * hh) * 4);
#pragma unroll
          for (int j = 0; j < 4; ++j) { S0[4 * g + j] *= d0[j]; S1[4 * g + j] *= d1[j]; }
        }
#pragma unroll
        for (int ks = 0; ks < 4; ++ks) {
          const bf16x8 vb = *(const LAS bf16x8*)(lds + VT + ((32 * dvb + r) * 72 + 16 * ks + 8 * hh) * 2);
          const bf16x8 k0 = *(const LAS bf16x8*)(lds + KE + ((32 * (2 * wh) + r) * 72 + 16 * ks + 8 * hh) * 2);
          const bf16x8 k1 = *(const LAS bf16x8*)(lds + KE + ((32 * (2 * wh + 1) + r) * 72 + 16 * ks + 8 * hh) * 2);
          S0 = __builtin_amdgcn_mfma_f32_32x32x16_bf16(k0, vb, S0, 0, 0, 0);
          S1 = __builtin_amdgcn_mfma_f32_32x32x16_bf16(k1, vb, S1, 0, 0, 0);
        }
      }
      if constexpr (OUT) {
      __syncthreads();
      {
        const int tb = wh;
        f32x16 o;
#pragma unroll
        for (int e = 0; e < 16; ++e) o[e] = 0.f;
#pragma unroll
        for (int ks = 0; ks < 4; ++ks) {
          if (ks < 2 * (tb + 1)) {
            const bf16x8 va = *(const LAS bf16x8*)(lds + VT + ((32 * dvb + r) * 72 + 16 * ks + 8 * hh) * 2);
            const bf16x8 ab = *(const LAS bf16x8*)(lds + AT + ((32 * tb + r) * 72 + 16 * ks + 8 * hh) * 2);
            o = __builtin_amdgcn_mfma_f32_32x32x16_bf16(va, ab, o, 0, 0, 0);
          }
        }
#pragma unroll
        for (int ks = 0; ks < 8; ++ks) {
          const bf16x8 sa = *(const LAS bf16x8*)(lds + ST + ((32 * dvb + r) * 136 + 16 * ks + 8 * hh) * 2);
          const bf16x8 qb = *(const LAS bf16x8*)(lds + QT + ((32 * tb + r) * 136 + 16 * ks + 8 * hh) * 2);
          o = __builtin_amdgcn_mfma_f32_32x32x16_bf16(sa, qb, o, 0, 0, 0);
        }
        if (c >= 4) {
          const int row = rbase + sgn * (32 * tb + r);
          bf16_t* op = (dir ? Ob + (size_t)(row - NCTX) * DM : Of + (size_t)row * DM) + h * 128 + 32 * dvb + 4 * hh;
#pragma unroll
          for (int g = 0; g < 4; ++g) {
            u32x2 ov; ov.x = pk2(o[4 * g], o[4 * g + 1]); ov.y = pk2(o[4 * g + 2], o[4 * g + 3]);
            *(u32x2*)(op + 8 * g) = ov;
          }
        }
      }
      __syncthreads();
#pragma unroll
      for (int g = 0; g < 4; ++g) {
        u32x2 a0; a0.x = pk2(S0[4 * g], S0[4 * g + 1]); a0.y = pk2(S0[4 * g + 2], S0[4 * g + 3]);
        *(LAS u32x2*)(lds + ST + ((32 * dvb + r) * 136 + 32 * (2 * wh) + 8 * g + 4 * hh) * 2) = a0;
        u32x2 a1; a1.x = pk2(S1[4 * g], S1[4 * g + 1]); a1.y = pk2(S1[4 * g + 2], S1[4 * g + 3]);
        *(LAS u32x2*)(lds + ST + ((32 * dvb + r) * 136 + 32 * (2 * wh + 1) + 8 * g + 4 * hh) * 2) = a1;
      }
      }
    }
    if constexpr (!OUT) {
      float* sp_ = Sseg + ((size_t)(bhd * 3 + sg) * 8 + w) * 2048;
#pragma unroll
      for (int e = 0; e < 16; ++e) { sp_[e * 64 + lane] = S0[e]; sp_[1024 + e * 64 + lane] = S1[e]; }
      if (tq == 0) Dlog[(size_t)(bhd * 3 + sg) * 128 + dk] = dsum;
    }
    __syncthreads();
  }
}

__device__ void phase_hgrn_readout(const Params& p, bf16_t* Of, const bf16_t* Ob, const bf16_t* Gg) {
  const int wave = threadIdx.x >> 6, lane = threadIdx.x & 63;
  for (int r = NCTX + blockIdx.x * 8 + wave; r < M_ALL; r += gridDim.x * 8) {
    const int c0 = lane * 16;
    float o[16];
#pragma unroll
    for (int i = 0; i < 2; ++i) {
      const u32x4 a = *(const u32x4*)(Of + (size_t)r * DM + c0 + 8 * i), bq = *(const u32x4*)(Ob + (size_t)(r - NCTX) * DM + c0 + 8 * i);
#pragma unroll
      for (int e = 0; e < 4; ++e) { o[8 * i + 2 * e] = lo2f(a[e]) + lo2f(bq[e]); o[8 * i + 2 * e + 1] = hi2f(a[e]) + hi2f(bq[e]); }
    }
    float ss = 0.f;
#pragma unroll
    for (int i = 0; i < 16; ++i) ss += o[i] * o[i];
    ss += __shfl_xor(ss, 1); ss += __shfl_xor(ss, 2); ss += __shfl_xor(ss, 4);
    const float rstd = rsqrtf(ss * (1.f / 128.f) + 1e-6f);
    const int cg = c0 & 127;
#pragma unroll
    for (int i = 0; i < 2; ++i) {
      const u32x4 gq = *(const u32x4*)(Gg + (size_t)r * DM + c0 + 8 * i);
      float y[8];
#pragma unroll
      for (int e = 0; e < 8; ++e) {
        const float g = (e & 1) ? hi2f(gq[e >> 1]) : lo2f(gq[e >> 1]);
        y[e] = o[8 * i + e] * rstd * p.g_norm_g[cg + 8 * i + e] * g * sigmoidf_(g);
      }
      u32x4 ov; ov.x = pk2(y[0], y[1]); ov.y = pk2(y[2], y[3]); ov.z = pk2(y[4], y[5]); ov.w = pk2(y[6], y[7]);
      *(u32x4*)(Of + (size_t)r * DM + c0 + 8 * i) = ov;
    }
  }
}

#define XB_TMO      128
#define XB_XCNT(j)  (256  + 64 * (j))
#define XB_XSUB(j)  (1280 + 64 * (j))
#define XB_XGEN(j)  (2304 + 64 * (j))
#define XB_TOP      3328
#define XB_TOPGEN   3392
#define XCD_BAR_WORDS 3456
#define XB_SPIN_CAP (1u << 22)
__device__ __forceinline__ unsigned xb_ld(unsigned* p)              { return __hip_atomic_load(p, __ATOMIC_RELAXED, __HIP_MEMORY_SCOPE_AGENT); }
__device__ __forceinline__ unsigned xb_add(unsigned* p, unsigned v) { return __hip_atomic_fetch_add(p, v, __ATOMIC_RELAXED, __HIP_MEMORY_SCOPE_AGENT); }
__device__ __forceinline__ unsigned xb_xcc_id() { return (unsigned)__builtin_amdgcn_s_getreg((3 << 11) | 20) & 0xFu; }
#define XB_SPIN(cond, bar) do { unsigned _sp = 0; while (cond) { __builtin_amdgcn_s_sleep(1); \
    if ((++_sp & 255u) == 0u) { if (xb_ld(&(bar)[XB_TMO])) break; if (_sp > XB_SPIN_CAP) { atomicAdd(&(bar)[XB_TMO], 1u); break; } } } } while (0)
__device__ __forceinline__ void xcd_barrier_complete(unsigned* bar, unsigned x, unsigned& nloc, unsigned& nx) {
  const unsigned G = gridDim.x * gridDim.y * gridDim.z;
  unsigned sum, cnt, mine, sp = 0u;
  for (;;) {
    sum = 0u; cnt = 0u; mine = 0u;
#pragma unroll
    for (unsigned j = 0; j < 16; ++j) { const unsigned c = xb_ld(&bar[XB_XCNT(j)]); sum += c; cnt += (c > 0u) ? 1u : 0u; mine = (j == x) ? c : mine; }
    if (sum == G) break;
    __builtin_amdgcn_s_sleep(1);
    if ((++sp & 255u) == 0u) { if (xb_ld(&bar[XB_TMO])) break; if (sp > XB_SPIN_CAP) { atomicAdd(&bar[XB_TMO], 1u); break; } }
  }
  nloc = mine > 0u ? mine : 1u; nx = cnt > 0u ? cnt : 1u;
}
__device__ __forceinline__ void xcd_barrier(unsigned* bar, volatile LAS unsigned* st) {
  asm volatile("s_waitcnt vmcnt(0)" ::: "memory");
  __syncthreads();
  if (threadIdx.x == 0) {
    const unsigned x = xb_xcc_id();
    __builtin_amdgcn_s_waitcnt(0);
    unsigned nloc = st[0], nx = st[1];
    if (nloc == 0u) { xcd_barrier_complete(bar, x, nloc, nx); st[0] = nloc; st[1] = nx; }
    const unsigned old = xb_add(&bar[XB_XSUB(x)], 1u);
    const unsigned gen = old / nloc;
    if (old + 1u == (gen + 1u) * nloc) {
      __builtin_amdgcn_fence(__ATOMIC_RELEASE, "agent");
      asm volatile("s_waitcnt vmcnt(0)" ::: "memory");
      const unsigned og = xb_add(&bar[XB_TOP], 1u);
      const unsigned tg = og / nx;
      if (og + 1u == (tg + 1u) * nx) xb_add(&bar[XB_TOPGEN], 1u);
      else XB_SPIN(xb_ld(&bar[XB_TOPGEN]) == tg, bar);
      __builtin_amdgcn_fence(__ATOMIC_ACQUIRE, "agent");
      xb_add(&bar[XB_XGEN(x)], 1u);
      asm volatile("s_waitcnt vmcnt(0)" ::: "memory");
    } else {
      XB_SPIN(xb_ld(&bar[XB_XGEN(x)]) == gen, bar);
      __builtin_amdgcn_fence(__ATOMIC_ACQUIRE, "agent");
      asm volatile("s_waitcnt vmcnt(0)" ::: "memory");
    }
  }
  __syncthreads();
}


template <int PH>
__device__ __forceinline__ void run_phase(const Params& p, bf16_t* shm_) {
  float* smf = (float*)shm_;
  LAS unsigned char* shm = (LAS unsigned char*)shm_;
  const size_t MR = (size_t)M_ALL;
  bf16_t* G = (bf16_t*)p.R;
  bf16_t* P = (bf16_t*)p.R;
  bf16_t* Qall = P + MR * 2048;
  bf16_t* Kall = Qall + (size_t)32 * NKEY * 96;
  bf16_t* Vt = Kall + (size_t)32 * NKEY * 96;
  bf16_t* Qh = (bf16_t*)p.R;
  bf16_t* Vv = Qh + MR * DM;
  bf16_t* Gg = Vv + MR * DM;
  _Float16* Lf = (_Float16*)(Gg + MR * DM);
  _Float16* Lb = Lf + MR * DM;
  const size_t MODL = (size_t)5 * 9216;
  float* PARTF = (float*)(G + MR * DFF);
  float* PARTE = (float*)(Vt + (size_t)32 * 64 * NKEY);
  const float* CG = p.mod + (size_t)4 * 9 * 1024;
  if constexpr (PH == 0) phase_prep(p, smf);
  if constexpr (PH == 1) phase_norm(p, 0, 0, p.ctx, p.x, 0);
  if constexpr (PH == 2) gemm_phase(p.U, DM, p.W13[0], DM, DM, 0, 132, 0, 22, EpiSwiglu{G}, shm);
  if constexpr (PH == 3) gemm_phase(G, DFF, p.W2[0], DFF, DFF, 4, 128, 0, 4, EpiResid{p.ctx, p.x, p.XC, p.out, p.mod + 2 * 1024, 0.5f}, shm, 4, 11, EpiPart{PARTF});
  if constexpr (PH == 4) phase_norm(p, 0, 1, p.ctx, p.out, 0, PARTF, 11, 0.5f, CG + 2 * 1024);
  if constexpr (PH == 5) gemm_phase(p.U, DM, p.WinE, DM, DM, 0, 132, 0, 8, EpiP{P, p.RS}, shm);
  if constexpr (PH == 6) { gemm_phase(P + 1536, 2048, p.Wqkv, 2048, 384, 0, 132, 0, 7, EpiQKV{EpiQ{p.RS, p.rope, Qall}, EpiKV{p.RS, Kall, Vt}}, shm);
                           phase_even_elem(p, P, p.U, Kall); }
  if constexpr (PH == 7) phase_attn<false>(p, Qall, Kall, Vt, p.U, shm);
  if constexpr (PH == 25) phase_attn<true>(p, Qall, Kall, Vt, p.U, shm);
  if constexpr (PH == 8) gemm_phase(p.U, DM, p.WoutE, DM, DM, 4, 128, 0, 4, EpiResid{p.XC, p.out, p.XC, p.out, p.mod + 5 * 1024, 1.0f}, shm, 4, 4, EpiPart{PARTE});
  if constexpr (PH == 9) phase_norm(p, 0, 2, p.XC, p.out, 0, PARTE, 4, 1.0f, CG + 5 * 1024);
  if constexpr (PH == 10) gemm_phase(p.U, DM, p.W13[1], DM, DM, 0, 132, 0, 22, EpiSwiglu{G}, shm);
  if constexpr (PH == 11) gemm_phase(G, DFF, p.W2[1], DFF, DFF, 4, 128, 0, 4, EpiResid{p.XC, p.out, p.XC, p.out, p.mod + 8 * 1024, 0.5f}, shm, 4, 11, EpiPart{PARTF});
  if constexpr (PH == 12) phase_norm(p, 1, 0, p.XC, p.out, 0, PARTF, 11, 0.5f, CG + 8 * 1024);
  if constexpr (PH == 13) gemm_phase(p.U, DM, p.W13[2], DM, DM, 0, 132, 0, 22, EpiSwiglu{G}, shm);
  if constexpr (PH == 14) gemm_phase(G, DFF, p.W2[2], DFF, DFF, 4, 128, 0, 4, EpiResid{p.XC, p.out, p.XC, p.out, p.mod + MODL + 2 * 1024, 0.5f}, shm, 4, 11, EpiPart{PARTF});
  if constexpr (PH == 15) phase_norm(p, 1, 1, p.XC, p.out, 0, PARTF, 11, 0.5f, CG + MODL + 2 * 1024);
  if constexpr (PH == 16) gemm_phase(p.U, DM, p.WinO, DM, DM, 0, 132, 0, 20, EpiOdd{Qh, Vv, Gg, Lf, Lb, p.lb_logits}, shm);
  bf16_t* Ob = (bf16_t*)(Lb + MR * DM);
  float* Sseg = (float*)(Ob + (size_t)32768 * DM);
  float* Dlg = Sseg + (size_t)192 * 16384;
  if constexpr (PH == 17) phase_hgrn<false>(p, Qh, Vv, Lf, p.U, Ob, Sseg, Dlg, shm);
  if constexpr (PH == 18) phase_hgrn<true>(p, Qh, Vv, Lf, p.U, Ob, Sseg, Dlg, shm);
  if constexpr (PH == 24) phase_hgrn_readout(p, p.U, Ob, Gg);
  if constexpr (PH == 19) gemm_phase(p.U, DM, p.WoutO, DM, DM, 4, 128, 0, 4, EpiResid{p.XC, p.out, p.XC, p.out, p.mod + MODL + 5 * 1024, 1.0f}, shm);
  if constexpr (PH == 20) phase_norm(p, 1, 2, p.XC, p.out, NCTX);
  if constexpr (PH == 21) gemm_phase(p.U, DM, p.W13[3], DM, DM, 4, 128, 0, 22, EpiSwiglu{G}, shm);
  if constexpr (PH == 22) gemm_phase(G, DFF, p.W2[3], DFF, DFF, 4, 128, 0, 4, EpiResid{p.XC, p.out, p.XC, p.out, p.mod + MODL + 8 * 1024, 0.5f}, shm);
  if constexpr (PH == 23) phase_final_norm(p);
}

constexpr int N_PHASES = 24;

#define PROBE_DUP -1
template <int PH>
__device__ __forceinline__ void step(const Params& p, int ph0, int ph1, bf16_t* shm) {
  if ((ph0 <= PH && PH < ph1) || (PH >= 24 && ph1 - ph0 > 1)) {
    run_phase<PH>(p, shm);
    if constexpr (PH == PROBE_DUP) { xcd_barrier(p.bar, (volatile LAS unsigned*)((LAS unsigned char*)shm + SHM_B)); run_phase<PH>(p, shm); }
    if (PH != 23 && ph1 - ph0 > 1) xcd_barrier(p.bar, (volatile LAS unsigned*)((LAS unsigned char*)shm + SHM_B));
  }
}

__global__ void __launch_bounds__(NTHR, 2) mega(Params p, int ph0, int ph1) {
  extern __shared__ __attribute__((aligned(16))) bf16_t shm[];
  if (ph1 < 0) cg::this_grid().sync();
  {
    volatile LAS unsigned* st = (volatile LAS unsigned*)((LAS unsigned char*)shm + SHM_B);
    if (threadIdx.x == 0) { st[0] = 0u; st[1] = 0u; }
    __syncthreads();
    if (threadIdx.x == 0) (void)xb_add(&p.bar[XB_XCNT(xb_xcc_id())], 1u);
  }
  step<0>(p, ph0, ph1, shm); step<1>(p, ph0, ph1, shm); step<2>(p, ph0, ph1, shm); step<3>(p, ph0, ph1, shm);
  step<4>(p, ph0, ph1, shm); step<5>(p, ph0, ph1, shm); step<6>(p, ph0, ph1, shm); step<7>(p, ph0, ph1, shm); step<25>(p, ph0, ph1, shm);
  step<8>(p, ph0, ph1, shm); step<9>(p, ph0, ph1, shm); step<10>(p, ph0, ph1, shm); step<11>(p, ph0, ph1, shm);
  step<12>(p, ph0, ph1, shm); step<13>(p, ph0, ph1, shm); step<14>(p, ph0, ph1, shm); step<15>(p, ph0, ph1, shm);
  step<16>(p, ph0, ph1, shm); step<17>(p, ph0, ph1, shm); step<18>(p, ph0, ph1, shm); step<24>(p, ph0, ph1, shm); step<19>(p, ph0, ph1, shm);
  step<20>(p, ph0, ph1, shm); step<21>(p, ph0, ph1, shm); step<22>(p, ph0, ph1, shm); step<23>(p, ph0, ph1, shm);
}

extern "C" void kernel_launch(void* const* d_in, const int* in_sizes, int n_in, void* d_out, int out_size, void* d_ws, size_t ws_size,
                              hipStream_t stream) {
  Params p{};
  const float** f = (const float**)&p;
  for (int i = 0; i < 22; ++i) f[i] = (const float*)d_in[i];
  p.out = (float*)d_out;
  char* w = (char*)d_ws; size_t off = 0;
  auto take = [&](size_t bytes) { char* r = w + off; off += (bytes + 255) & ~(size_t)255; return r; };
  p.W13[3] = (bf16_t*)take((size_t)2 * DFF * DM * 2);
  p.W2[3] = (bf16_t*)take((size_t)DM * DFF * 2);
  p.WinO = (bf16_t*)take((size_t)5120 * 1024 * 2);
  p.WoutO = (bf16_t*)take((size_t)1024 * 1024 * 2);
  p.mod = (float*)take((size_t)2 * 5 * 9216 * 4);
  p.XC = (float*)take((size_t)NCTX * DM * 4);
  p.RS = (float*)take((size_t)M_ALL * 2 * 4);
  p.rope = (float*)take((size_t)8192 * 32 * 4);
  p.bar = (unsigned*)take((size_t)XCD_BAR_WORDS * 4);
  p.aflag = (unsigned*)take((size_t)1024 * 4);
  p.U = (bf16_t*)take((size_t)M_ALL * DM * 2);
  p.R = take(0);
  {
    const size_t early = (size_t)3 * (2 * DFF * DM * 2) + (size_t)3 * (DM * DFF * 2) + (size_t)2048 * 1024 * 2 + (size_t)1792 * 2048 * 2 + (size_t)1024 * 1024 * 2;
    size_t e0 = (ws_size - early) & ~(size_t)255;
    const size_t rbytes = e0 - off;
    if (rbytes < (size_t)M_ALL * DM * 2 * 5 || ws_size - off < (size_t)M_ALL * DM * 2 * 5 + (size_t)32768 * DM * 2)
      fprintf(stderr, "workspace too small: R=%zu ws=%zu\n", rbytes, ws_size);
    if (ws_size - off < (size_t)M_ALL * DM * 2 * 5 + (size_t)32768 * DM * 2 + (size_t)192 * 16384 * 4 + 192 * 128 * 4) fprintf(stderr, "workspace too small for Sseg\n");
    off = e0;
    for (int i = 0; i < 3; ++i) p.W13[i] = (bf16_t*)take((size_t)2 * DFF * DM * 2);
    for (int i = 0; i < 3; ++i) p.W2[i] = (bf16_t*)take((size_t)DM * DFF * 2);
    p.WinE = (bf16_t*)take((size_t)2048 * 1024 * 2);
    p.Wqkv = (bf16_t*)take((size_t)1792 * 2048 * 2);
    p.WoutE = (bf16_t*)take((size_t)1024 * 1024 * 2);
  }
  static bool attr_done = false;
  if (!attr_done) { (void)hipFuncSetAttribute((const void*)mega, hipFuncAttributeMaxDynamicSharedMemorySize, SHM_B + 256); attr_done = true; }
#if 0
  for (int ph = 0; ph < N_PHASES; ++ph) {
    hipLaunchKernelGGL(mega, dim3(256), dim3(NTHR), SHM_B, stream, p, ph, ph + 1);
  }
#else
  static int grid_blocks = 0;
  if (!grid_blocks) {
    int dev = 0, cus = 0, per_cu = 0;
    hipGetDevice(&dev);
    hipDeviceGetAttribute(&cus, hipDeviceAttributeMultiprocessorCount, dev);
    hipOccupancyMaxActiveBlocksPerMultiprocessor(&per_cu, mega, NTHR, SHM_B + 256);
    if (per_cu > 1) per_cu = 1;
    grid_blocks = cus * per_cu;
  }
  int ph0 = 0, ph1 = N_PHASES;
  void* args[] = {&p, &ph0, &ph1};
  (void)hipMemsetAsync(p.bar, 0, (size_t)XCD_BAR_WORDS * 4, stream);
  hipError_t e = hipLaunchCooperativeKernel((void*)mega, dim3(grid_blocks), dim3(NTHR), args, SHM_B + 256, stream);
  if (e != hipSuccess) fprintf(stderr, "cooperative launch failed: %s (grid %d)\n", hipGetErrorString(e), grid_blocks);
#endif
}
```

```cpp
#include <hip/hip_runtime.h>
#include <hip/hip_cooperative_groups.h>
#include <cstdio>
namespace cg = cooperative_groups;

typedef unsigned short bf16_t;
typedef short bf16x8 __attribute__((ext_vector_type(8)));
typedef float f32x4 __attribute__((ext_vector_type(4)));
typedef unsigned u32x2 __attribute__((ext_vector_type(2)));
typedef unsigned u32x4 __attribute__((ext_vector_type(4)));
typedef _Float16 h16x4 __attribute__((ext_vector_type(4)));
typedef _Float16 h16x8 __attribute__((ext_vector_type(8)));

constexpr int M_ALL = 33792;
constexpr int NCTX = 1024;
constexpr int DM = 1024;
constexpr int DFF = 2816;
constexpr int NKEY = 8448;
constexpr int NTHR = 512;
constexpr float QSCALE = 0.10206207261596577f * 1.4426950408889634f;
constexpr float HSCALE = 0.08838834764831845f;

struct Params {
  const float *x, *c, *ctx, *c_ctx, *ada_w, *ada_b, *norm_g, *ffn_w1, *ffn_w3, *ffn_w2, *even_w_in, *even_conv_w,
      *q_norm_g, *w_uq, *kv_norm_g, *w_ukv, *even_w_out, *odd_w_in, *lb_logits, *g_norm_g, *odd_w_out, *final_norm_g;
  float* out;
  bf16_t *W13[4], *W2[4], *WinE, *Wqkv, *WoutE, *WinO, *WoutO;
  float *mod, *XC, *RS, *rope;
  unsigned* bar;
  unsigned* aflag;
  bf16_t* U;
  char* R;
};

__device__ __forceinline__ float bf2f(bf16_t v) { return __uint_as_float(((unsigned)v) << 16); }
typedef float f32x2 __attribute__((ext_vector_type(2)));
typedef __bf16 bf16v2 __attribute__((ext_vector_type(2)));
__device__ __forceinline__ unsigned pk2(float lo, float hi) { f32x2 v = {lo, hi}; return __builtin_bit_cast(unsigned, __builtin_convertvector(v, bf16v2)); }
__device__ __forceinline__ bf16_t f2bf(float f) { return (bf16_t)(pk2(f, 0.f) & 0xffffu); }
__device__ __forceinline__ float lo2f(unsigned u) { return __uint_as_float(u << 16); }
__device__ __forceinline__ float hi2f(unsigned u) { return __uint_as_float(u & 0xffff0000u); }
__device__ __forceinline__ float wave_sum(float v) {
#pragma unroll
  for (int o = 32; o > 0; o >>= 1) v += __shfl_xor(v, o);
  return v;
}
__device__ __forceinline__ float sigmoidf_(float a) { return __builtin_amdgcn_rcpf(1.f + __expf(-a)); }
__device__ __forceinline__ int row_mi(int r) { return r < NCTX ? 4 : ((r - NCTX) >> 13); }
__device__ __forceinline__ void row_bk(int r, int& b, int& key) {
  if (r < NCTX) { b = r >> 8; key = r & 255; } else { int rr = r - NCTX; b = rr >> 13; key = 256 + (rr & 8191); }
}

constexpr int BM = 256, BK = 64, HALF = 128, NXCD = 8, WGM = 8, HT = HALF * BK, SHM_B = 8 * HT * 2;

__device__ __forceinline__ int lds_byte(int r, int c) {
  int st = (r >> 4) * 2 + (c >> 5), rr = r & 15, cc = c & 31, ob = rr * 64 + cc * 2;
  return st * 1024 + (ob ^ (((ob >> 9) & 1) << 5));
}
__device__ __forceinline__ void stage_rc(int b, int& R, int& C) {
  int st = b / 1024, sb = b % 1024, swz = sb ^ (((sb >> 9) & 1) << 5);
  R = (st >> 1) * 16 + swz / 64; C = (st & 1) * 32 + (swz % 64) / 2;
}

#define NO_EPI_DRAIN 1
#define LAS __attribute__((address_space(3)))
struct EpiNone { static constexpr bool HALFOK = false; __device__ __forceinline__ void operator()(const f32x4 (&)[2][2][4][2], int, int, int, int, int, int, int) const {} };
template <class Epi, class Epi2 = EpiNone>
__device__ __forceinline__ void gemm_phase(const bf16_t* A, int lda, const bf16_t* Bt, int ldb, int K, int pm0, int nM, int pn0, int nN,
                                           const Epi& epi, LAS unsigned char* lds, int nsm = 0, int ksl = 1, const Epi2& epi2 = Epi2()) {
  const int tid = threadIdx.x, wid = __builtin_amdgcn_readfirstlane(tid >> 6), lane = tid & 63, wr = wid >> 2, wc = wid & 3, fr = lane & 15, fq = lane >> 4;
  const int nt = K / BK;
  const int nwg = nM * nN, G = gridDim.x;
  const int nsplit = nsm * nN * ksl, nts = nt / ksl;
  if ((int)blockIdx.x >= nwg + nsplit) return;
  const int Rfull = nwg / G, Lleft = nwg - Rfull * G;
  const bool tail_split = Epi::HALFOK && nsm == 0 && Lleft > 0 && 2 * Lleft <= G;
  unsigned voffA[2], voffB[2];
#pragma unroll
  for (int i = 0; i < 2; ++i) { int R, C; stage_rc(tid * 16 + i * 8192, R, C); voffA[i] = (unsigned)(R * lda + C) * 2u; voffB[i] = (unsigned)(R * ldb + C) * 2u; }
  const size_t kstep = (size_t)(BK * 2);
  const size_t hstepA = (size_t)HALF * lda * 2, hstepB = (size_t)HALF * ldb * 2;
  const unsigned ldsw = (unsigned)wid * 1024u;
  const int aoff = lds_byte(wr * 64 + fr, fq * 8), boff = lds_byte(wc * 32 + fr, fq * 8);
#define G_SA(b, h) (((b) * 2 + (h)) * (HT * 2))
#define G_SB(b, h) ((4 + (b) * 2 + (h)) * (HT * 2))
#define G_STAGE(bufoff, gbase, voff) do { _Pragma("unroll") for (int _i = 0; _i < 2; ++_i) \
    __builtin_amdgcn_global_load_lds((const unsigned*)((const char*)(gbase) + (voff)[_i]), (LAS unsigned*)(lds + (bufoff) + ldsw + _i * 8192), 16, 0, 0); } while (0)
#define G_LDA(dst, b, h) do { _Pragma("unroll") for (int m = 0; m < 4; ++m) _Pragma("unroll") for (int k = 0; k < 2; ++k) dst[m][k] = *(const LAS bf16x8*)(lds + G_SA(b, h) + aoff + m * 2048 + k * 1024); } while (0)
#define G_LDB(dst, b, h) do { _Pragma("unroll") for (int n = 0; n < 2; ++n) _Pragma("unroll") for (int k = 0; k < 2; ++k) dst[n][k] = *(const LAS bf16x8*)(lds + G_SB(b, h) + boff + n * 2048 + k * 1024); } while (0)
#define G_MMA(ai, bj, At, Bx) do { __builtin_amdgcn_s_setprio(1); _Pragma("unroll") for (int m = 0; m < 4; ++m) _Pragma("unroll") for (int n = 0; n < 2; ++n) _Pragma("unroll") for (int k = 0; k < 2; ++k) \
    acc[ai][bj][m][n] = __builtin_amdgcn_mfma_f32_16x16x32_bf16(Bx[n][k], At[m][k], acc[ai][bj][m][n], 0, 0, 0); __builtin_amdgcn_s_setprio(0); } while (0)
#define WAIT_V(n) asm volatile("s_waitcnt vmcnt(" #n ")" ::: "memory")
#define WAIT_L(n) asm volatile("s_waitcnt lgkmcnt(" #n ")" ::: "memory")
#define BAR __builtin_amdgcn_s_barrier()
#define SCHED __builtin_amdgcn_sched_barrier(0)
  auto unit = [&](int i, int& pm, int& pn, int& sl, int& hf) -> bool {
    long L = (long)i * G + blockIdx.x; sl = -1; hf = -1;
    if (tail_split && i >= Rfull) { if (i > Rfull || (int)blockIdx.x >= 2 * Lleft) return false; L = (long)Rfull * G + (blockIdx.x >> 1); hf = blockIdx.x & 1; }
    if (L >= nwg) { const int j = (int)(L - nwg); if (j >= nsplit) return false; sl = j % ksl; const int tile = j / ksl; pm = tile / nN; pn = pn0 + tile % nN; return true; }
    int wgid = (int)L; { const int q = nwg / NXCD, r = nwg % NXCD, xcd = wgid % NXCD, off = wgid / NXCD; wgid = (xcd < r ? xcd * (q + 1) : r * (q + 1) + (xcd - r) * q) + off; }
    const int nig = WGM * nN, gid = wgid / nig, fm = gid * WGM, gsz = (nM - fm) < WGM ? (nM - fm) : WGM;
    pm = pm0 + fm + ((wgid % nig) % gsz); pn = pn0 + (wgid % nig) / gsz; return true;
  };
  int cpm, cpn, csl, chf, npm = 0, npn = 0, nsl = -1, nhf = -1, ui = 0;
  unit(0, cpm, cpn, csl, chf);
  f32x4 acc[2][2][4][2];
#pragma unroll
  for (int a = 0; a < 2; ++a)
#pragma unroll
    for (int b = 0; b < 2; ++b)
#pragma unroll
      for (int m = 0; m < 4; ++m)
#pragma unroll
        for (int n = 0; n < 2; ++n) acc[a][b][m][n] = (f32x4){0.f, 0.f, 0.f, 0.f};
  bf16x8 At[4][2], B0[2][2], B1[2][2];
  const char* cA = (const char*)A + (size_t)cpm * 2 * hstepA + (csl < 0 ? 0 : (size_t)csl * nts * kstep) + (chf > 0 ? hstepA : 0);
  size_t chA = chf < 0 ? hstepA : 0, nhA = hstepA;
  const char* cB = (const char*)Bt + (size_t)cpn * 2 * hstepB + (csl < 0 ? 0 : (size_t)csl * nts * kstep);
  G_STAGE(G_SB(0, 0), cB, voffB); G_STAGE(G_SA(0, 0), cA, voffA); G_STAGE(G_SB(0, 1), cB + hstepB, voffB); G_STAGE(G_SA(0, 1), cA + chA, voffA);
  if (wr == 1) BAR;
  WAIT_V(4); BAR;
  G_STAGE(G_SB(1, 0), cB + kstep, voffB); G_STAGE(G_SA(1, 0), cA + kstep, voffA); G_STAGE(G_SB(1, 1), cB + hstepB + kstep, voffB);
  WAIT_V(6); BAR;
#define G_KLOOP(AI1) \
    _Pragma("nounroll") \
    for (int t = 0; t < cnt; t += 2) { \
      const bool last = (t == cnt - 2); \
      const char* a1 = cA + (size_t)(t + 1) * kstep; \
      const char* a2 = last ? nA : cA + (size_t)(t + 2) * kstep; const char* b2 = last ? nB : cB + (size_t)(t + 2) * kstep; \
      const char* a3 = a2 + kstep; const char* b3 = b2 + kstep; \
      G_LDB(B0, 0, 0); SCHED; G_LDA(At, 0, 0); G_STAGE(G_SA(1, 1), a1 + chA, voffA); \
      WAIT_L(8); BAR; WAIT_L(0); G_MMA(0, 0, At, B0); BAR; SCHED; \
      G_LDB(B1, 0, 1); G_STAGE(G_SB(0, 0), b2, voffB); \
      BAR; WAIT_L(0); G_MMA(0, 1, At, B1); BAR; \
      G_LDA(At, 0, 1); G_STAGE(G_SA(0, 0), a2, voffA); \
      BAR; WAIT_L(0); if (AI1) G_MMA(1, 0, At, B0); BAR; SCHED; \
      G_STAGE(G_SB(0, 1), b2 + hstepB, voffB); \
      WAIT_V(6); BAR; if (AI1) G_MMA(1, 1, At, B1); BAR; \
      G_LDB(B0, 1, 0); SCHED; G_LDA(At, 1, 0); G_STAGE(G_SA(0, 1), a2 + (last ? nhA : chA), voffA); \
      WAIT_L(8); BAR; WAIT_L(0); G_MMA(0, 0, At, B0); BAR; SCHED; \
      G_LDB(B1, 1, 1); G_STAGE(G_SB(1, 0), b3, voffB); \
      BAR; WAIT_L(0); G_MMA(0, 1, At, B1); BAR; \
      G_LDA(At, 1, 1); G_STAGE(G_SA(1, 0), a3, voffA); \
      BAR; WAIT_L(0); if (AI1) G_MMA(1, 0, At, B0); BAR; SCHED; \
      G_STAGE(G_SB(1, 1), b3 + hstepB, voffB); \
      WAIT_V(6); BAR; if (AI1) G_MMA(1, 1, At, B1); BAR; \
    }
  bool pending_half = false;
  for (;;) {
    const bool has_next = unit(ui + 1, npm, npn, nsl, nhf);
    const char* nA = has_next ? (const char*)A + (size_t)npm * 2 * hstepA + (nsl < 0 ? 0 : (size_t)nsl * nts * kstep) + (nhf > 0 ? hstepA : 0) : cA;
    const char* nB = has_next ? (const char*)Bt + (size_t)npn * 2 * hstepB + (nsl < 0 ? 0 : (size_t)nsl * nts * kstep) : cB;
    nhA = has_next ? (nhf < 0 ? hstepA : 0) : chA;
    const int cnt = csl < 0 ? nt : nts;
    G_KLOOP(1)
    if (csl < 0) {
      if constexpr (Epi::HALFOK) epi(acc, cpm * BM, cpn * BM, wr, wc, fr, fq, 2);
      else epi(acc, cpm * BM, cpn * BM, wr, wc, fr, fq);
    } else epi2(acc, cpm * BM, cpn * BM, wr, wc, fr, fq, csl);
#ifndef NO_EPI_DRAIN
    WAIT_V(0);
#endif
    if (!has_next) break;
#pragma unroll
    for (int a = 0; a < 2; ++a)
#pragma unroll
      for (int b = 0; b < 2; ++b)
#pragma unroll
        for (int m = 0; m < 4; ++m)
#pragma unroll
          for (int n = 0; n < 2; ++n) acc[a][b][m][n] = (f32x4){0.f, 0.f, 0.f, 0.f};
    cpm = npm; cpn = npn; csl = nsl; chf = nhf; chA = nhA; cA = nA; cB = nB; ++ui;
    if (chf >= 0) { pending_half = true; break; }
  }
  if constexpr (Epi::HALFOK) {
    if (pending_half) {
      const char* nA = cA; const char* nB = cB; nhA = chA;
      const int cnt = nt;
      G_KLOOP(0)
      epi(acc, cpm * BM + (chf > 0 ? HALF : 0), cpn * BM, wr, wc, fr, fq, 1);
    }
  }
#undef G_KLOOP
  WAIT_V(0);
  if (wr == 0) BAR;
  BAR;
}

typedef f32x4 Acc[2][2][4][2];

struct EpiSwiglu { static constexpr bool HALFOK = true;
  bf16_t* G;
  __device__ __forceinline__ void operator()(const Acc& acc, int brow, int bcol, int wr, int wc, int fr, int fq, int nai) const {
    const int f0 = (bcol >> 1) + 32 * wc + 8 * fq;
    asm volatile("s_waitcnt vmcnt(14)" ::: "memory");
#pragma unroll
    for (int ai = 0; ai < 2; ++ai)
#pragma unroll
      for (int m = 0; m < 4; ++m) if (ai < nai) {
        const int r = brow + 128 * ai + 64 * wr + 16 * m + fr;
        u32x4 o;
#pragma unroll
        for (int bj = 0; bj < 2; ++bj) {
          const f32x4 a = acc[ai][bj][m][0], b = acc[ai][bj][m][1];
          const float g0 = a[0] * sigmoidf_(a[0]) * b[0], g1 = a[1] * sigmoidf_(a[1]) * b[1];
          const float g2 = a[2] * sigmoidf_(a[2]) * b[2], g3 = a[3] * sigmoidf_(a[3]) * b[3];
          if (bj == 0) { o.x = pk2(g0, g1); o.y = pk2(g2, g3); } else { o.z = pk2(g0, g1); o.w = pk2(g2, g3); }
        }
        *(u32x4*)(G + (size_t)r * DFF + f0) = o;
      }
  }
};

struct EpiResid { static constexpr bool HALFOK = false;
  const float *srcC, *srcL; float *dstC, *dstL; const float* gate;   float coef;
  __device__ __forceinline__ void operator()(const Acc& acc, int brow, int bcol, int wr, int wc, int fr, int fq) const {
    const float* g = gate + (size_t)row_mi(brow) * 9 * DM + bcol + 32 * wc + 4 * fq;
    f32x4 gv[2][2];
#pragma unroll
    for (int bj = 0; bj < 2; ++bj)
#pragma unroll
      for (int n = 0; n < 2; ++n) gv[bj][n] = coef * *(const f32x4*)(g + 128 * bj + 16 * n);
    const size_t rb = (size_t)(brow - NCTX + 64 * wr + fr) * DM + bcol + 32 * wc + 4 * fq;
#pragma unroll
    for (int ai = 0; ai < 2; ++ai)
#pragma unroll
      for (int mp = 0; mp < 2; ++mp) {
        f32x4 xv[2][2][2];
#pragma unroll
        for (int mm = 0; mm < 2; ++mm)
#pragma unroll
          for (int bj = 0; bj < 2; ++bj)
#pragma unroll
            for (int n = 0; n < 2; ++n)
              xv[mm][bj][n] = *(const f32x4*)(srcL + rb + (size_t)(128 * ai + 16 * (2 * mp + mm)) * DM + 128 * bj + 16 * n);
#pragma unroll
        for (int mm = 0; mm < 2; ++mm)
#pragma unroll
          for (int bj = 0; bj < 2; ++bj)
#pragma unroll
            for (int n = 0; n < 2; ++n)
              *(f32x4*)(dstL + rb + (size_t)(128 * ai + 16 * (2 * mp + mm)) * DM + 128 * bj + 16 * n) = xv[mm][bj][n] + gv[bj][n] * acc[ai][bj][2 * mp + mm][n];
      }
  }
};

struct EpiPart { static constexpr bool HALFOK = false;
  float* PART;
  __device__ __forceinline__ void operator()(const Acc& acc, int brow, int bcol, int wr, int wc, int fr, int fq, int sl) const {
#pragma unroll
    for (int ai = 0; ai < 2; ++ai)
#pragma unroll
      for (int m = 0; m < 4; ++m) {
        const int r = brow + 128 * ai + 64 * wr + 16 * m + fr;
        float* d = PART + ((size_t)sl * NCTX + r) * DM;
#pragma unroll
        for (int bj = 0; bj < 2; ++bj)
#pragma unroll
          for (int n = 0; n < 2; ++n) *(f32x4*)(d + bcol + 128 * bj + 32 * wc + 16 * n + 4 * fq) = acc[ai][bj][m][n];
      }
  }
};

struct EpiBf16 { static constexpr bool HALFOK = false;
  bf16_t* O; int ldc;
  __device__ __forceinline__ void operator()(const Acc& acc, int brow, int bcol, int wr, int wc, int fr, int fq) const {
#pragma unroll
    for (int ai = 0; ai < 2; ++ai)
#pragma unroll
      for (int m = 0; m < 4; ++m) {
        const int r = brow + 128 * ai + 64 * wr + 16 * m + fr;
#pragma unroll
        for (int bj = 0; bj < 2; ++bj)
#pragma unroll
          for (int n = 0; n < 2; ++n) {
            const int c = bcol + 128 * bj + 32 * wc + 16 * n + 4 * fq;
            f32x4 v = acc[ai][bj][m][n];
            u32x2 o; o.x = pk2(v[0], v[1]); o.y = pk2(v[2], v[3]);
            *(u32x2*)(O + (size_t)r * ldc + c) = o;
          }
      }
  }
};

struct EpiP { static constexpr bool HALFOK = true;
  bf16_t* O; float* RS;
  __device__ __forceinline__ void operator()(const Acc& acc, int brow, int bcol, int wr, int wc, int fr, int fq, int nai) const {
    asm volatile("s_waitcnt vmcnt(14)" ::: "memory");
#pragma unroll
    for (int ai = 0; ai < 2; ++ai)
#pragma unroll
      for (int m = 0; m < 4; ++m) if (ai < nai) {
        const int r = brow + 128 * ai + 64 * wr + 16 * m + fr;
        float ss0 = 0.f, ss1 = 0.f;
#pragma unroll
        for (int bj = 0; bj < 2; ++bj) {
          const int c = bcol + 128 * bj + 32 * wc + 8 * fq;
          const f32x4 v0 = acc[ai][bj][m][0], v1 = acc[ai][bj][m][1];
          const float q = v0[0] * v0[0] + v0[1] * v0[1] + v0[2] * v0[2] + v0[3] * v0[3] + v1[0] * v1[0] + v1[1] * v1[1] + v1[2] * v1[2] + v1[3] * v1[3];
          if (bj == 0) ss0 += q; else ss1 += q;
          u32x4 o; o.x = pk2(v0[0], v0[1]); o.y = pk2(v0[2], v0[3]); o.z = pk2(v1[0], v1[1]); o.w = pk2(v1[2], v1[3]);
          *(u32x4*)(O + (size_t)r * 2048 + c) = o;
        }
        if (bcol == 1536) {
          float ss = ss0 + ss1; ss += __shfl_xor(ss, 16); ss += __shfl_xor(ss, 32);
          if (fq == 0) atomicAdd(RS + 2 * r, ss);
        } else if (bcol == 1792) {
          float ss = ss0; ss += __shfl_xor(ss, 16); ss += __shfl_xor(ss, 32);
          if (fq == 0) atomicAdd(RS + 2 * r + 1, ss);
        }
      }
  }
};

struct EpiQ { static constexpr bool HALFOK = false;
  const float* RS; const float* rope;   bf16_t* Qall;
  __device__ __forceinline__ void operator()(const Acc& acc, int brow, int bcol, int wr, int wc, int fr, int fq) const {
#pragma unroll
    for (int ai = 0; ai < 2; ++ai)
#pragma unroll
      for (int m = 0; m < 4; ++m) {
        const int r = brow + 128 * ai + 64 * wr + 16 * m + fr;
        const float rstd = rsqrtf(RS[2 * r] * (1.f / 256.f) + 1e-6f) * QSCALE;
        int b, key; row_bk(r, b, key);
        const bool latent = r >= NCTX;
        const int t = (r - NCTX) & 8191;
        bf16_t* qrow = Qall + ((size_t)(b * 8) * NKEY + key) * 96 + 4 * fq;
#pragma unroll
        for (int bj = 0; bj < 2; ++bj) {
          const int c32 = bcol + 128 * bj + 32 * wc;
          const int h = c32 / 96, d32 = c32 - 96 * h;
#pragma unroll
          for (int n = 0; n < 2; ++n) {
            f32x4 v = acc[ai][bj][m][n] * rstd;
            if (d32 == 64) {
              f32x4 pv;
#pragma unroll
              for (int j = 0; j < 4; ++j) pv[j] = __shfl_xor(v[j], 32);
              if (latent) {
                const float* rp = rope + ((size_t)t * 2 + n) * 16 + 4 * (fq & 1);
                const f32x4 cs = *(const f32x4*)rp, sn = *(const f32x4*)(rp + 8);
                v = (fq < 2) ? (v * cs - pv * sn) : (pv * sn + v * cs);
              }
            }
            u32x2 o; o.x = pk2(v[0], v[1]); o.y = pk2(v[2], v[3]);
            *(u32x2*)(qrow + (size_t)h * (NKEY * 96) + d32 + 16 * n) = o;
          }
        }
      }
  }
};
struct EpiKV { static constexpr bool HALFOK = false;
  const float* RS; bf16_t *Kall, *Vt;
  __device__ __forceinline__ void operator()(const Acc& acc, int brow, int bcol, int wr, int wc, int fr, int fq) const {
#pragma unroll
    for (int ai = 0; ai < 2; ++ai)
#pragma unroll
      for (int m = 0; m < 4; ++m) {
        const int r = brow + 128 * ai + 64 * wr + 16 * m + fr;
        const float rstd = rsqrtf(RS[2 * r + 1] * (1.f / 128.f) + 1e-6f);
        int b, key; row_bk(r, b, key);
        bf16_t* krow = Kall + ((size_t)(b * 8) * NKEY + key) * 96 + 4 * fq;
        bf16_t* vrow = Vt + (size_t)(b * 8) * 64 * NKEY + key + (size_t)(4 * fq) * NKEY;
#pragma unroll
        for (int bj = 0; bj < 2; ++bj) {
          const int cc = bcol - 768 + 128 * bj + 32 * wc, h = cc >> 7, e32 = cc & 127;
#pragma unroll
          for (int n = 0; n < 2; ++n) {
            const f32x4 v = acc[ai][bj][m][n] * rstd;
            if (e32 < 64) {
              u32x2 o; o.x = pk2(v[0], v[1]); o.y = pk2(v[2], v[3]);
              *(u32x2*)(krow + (size_t)h * (NKEY * 96) + e32 + 16 * n) = o;
            } else {
              bf16_t* vp = vrow + (size_t)(h * 64 + e32 - 64 + 16 * n) * NKEY;
#pragma unroll
              for (int j = 0; j < 4; ++j) vp[(size_t)j * NKEY] = f2bf(v[j]);
            }
          }
        }
      }
  }
};

struct EpiQKV { static constexpr bool HALFOK = false;
  EpiQ q; EpiKV kv;
  __device__ __forceinline__ void operator()(const Acc& acc, int brow, int bcol, int wr, int wc, int fr, int fq) const {
    if (bcol < 768) q(acc, brow, bcol, wr, wc, fr, fq); else kv(acc, brow, bcol, wr, wc, fr, fq);
  }
};

struct EpiOdd { static constexpr bool HALFOK = true;
  bf16_t *Qh, *Vv, *Gg; _Float16 *Lf, *Lb; const float* lbl;
  __device__ __forceinline__ void operator()(const Acc& acc, int brow, int bcol, int wr, int wc, int fr, int fq, int nai) const {
    const int sec = bcol >> 10;
    const int cb = (bcol & 1023) + 32 * wc + 8 * fq;
    asm volatile("s_waitcnt vmcnt(14)" ::: "memory");
    if (sec == 2 || sec == 3) {
      const int dir = sec - 2;
      _Float16* O = Lf + (size_t)dir * ((size_t)M_ALL * DM);
#pragma unroll
      for (int bj = 0; bj < 2; ++bj) {
        const int c = cb + 128 * bj;
        f32x4 lb[2];
#pragma unroll
        for (int n = 0; n < 2; ++n) {
          const f32x4 z0 = *(const f32x4*)(lbl + dir * 1024 + c + 4 * n), z1 = *(const f32x4*)(lbl + 2048 + dir * 1024 + c + 4 * n);
#pragma unroll
          for (int j = 0; j < 4; ++j) lb[n][j] = __builtin_amdgcn_rcpf(1.f + __expf(z0[j] - z1[j]));
        }
#pragma unroll
        for (int ai = 0; ai < 2; ++ai)
#pragma unroll
          for (int m = 0; m < 4; ++m) if (ai < nai) {
            const int r = brow + 128 * ai + 64 * wr + 16 * m + fr;
            h16x8 hv;
#pragma unroll
            for (int n = 0; n < 2; ++n) {
              const f32x4 v = acc[ai][bj][m][n];
#pragma unroll
              for (int j = 0; j < 4; ++j) hv[4 * n + j] = (_Float16)__logf(lb[n][j] + (1.f - lb[n][j]) * sigmoidf_(v[j]));
            }
            *(h16x8*)(O + (size_t)r * DM + c) = hv;
          }
      }
    } else {
      bf16_t* O = Qh + (size_t)(sec == 4 ? 2 : sec) * ((size_t)M_ALL * DM);
      const float sc = sec == 0 ? HSCALE : 1.f;
#pragma unroll
      for (int ai = 0; ai < 2; ++ai)
#pragma unroll
        for (int m = 0; m < 4; ++m) if (ai < nai) {
          const int r = brow + 128 * ai + 64 * wr + 16 * m + fr;
#pragma unroll
          for (int bj = 0; bj < 2; ++bj) {
            const int c = cb + 128 * bj;
            const f32x4 v0 = acc[ai][bj][m][0] * sc, v1 = acc[ai][bj][m][1] * sc;
            u32x4 o; o.x = pk2(v0[0], v0[1]); o.y = pk2(v0[2], v0[3]); o.z = pk2(v1[0], v1[1]); o.w = pk2(v1[2], v1[3]);
            *(u32x4*)(O + (size_t)r * DM + c) = o;
          }
        }
    }
  }
};

__device__ __forceinline__ void tr_tile(const float* src, int ldn, int k0, int n0, int nv, bf16_t* dst, int ldk, int kofs, int mode, const float* kscale, float* sm) {
  const int tid = threadIdx.x;
  float v[8];
#pragma unroll
  for (int i = 0; i < 8; ++i) {
    const int e = tid + i * NTHR, k = e >> 6, n = e & 63;
    v[i] = (n < nv) ? src[(size_t)(k0 + k) * ldn + n0 + n] : 0.f;
  }
#pragma unroll
  for (int i = 0; i < 8; ++i) {
    const int e = tid + i * NTHR, k = e >> 6, n = e & 63;
    sm[k * 65 + n] = kscale ? v[i] * kscale[k0 + k] : v[i];
  }
  __syncthreads();
  {
    const int n = tid >> 3, kq = tid & 7;
    const int ng = n0 + n;
    int drow = ng;
    if (mode == 1 || mode == 2) {
      const int pn = ng >> 7, rem = ng & 127, wc = rem >> 5, r2 = rem & 31, fq = r2 >> 3, bj = (r2 >> 2) & 1, j = r2 & 3;
      drow = 256 * pn + 128 * bj + 32 * wc + 16 * (mode - 1) + 4 * fq + j;
    } else if (mode == 3) {
      const int o = ng & 31, fq = o >> 3, nn = (o >> 2) & 1, j = o & 3;
      drow = (ng & ~31) + 16 * nn + 4 * fq + j;
    }
    if (n < nv) {
      u32x4 o;
      o.x = pk2(sm[(8 * kq + 0) * 65 + n], sm[(8 * kq + 1) * 65 + n]);
      o.y = pk2(sm[(8 * kq + 2) * 65 + n], sm[(8 * kq + 3) * 65 + n]);
      o.z = pk2(sm[(8 * kq + 4) * 65 + n], sm[(8 * kq + 5) * 65 + n]);
      o.w = pk2(sm[(8 * kq + 6) * 65 + n], sm[(8 * kq + 7) * 65 + n]);
      *(u32x4*)(dst + (size_t)drow * ldk + kofs + k0 + 8 * kq) = o;
    }
  }
  __syncthreads();
}

__device__ void phase_prep(const Params& p, float* sm) {
  const int tid = threadIdx.x;
  int base = 0;
  const int bid = blockIdx.x, G = gridDim.x;
#define TRJOB(SRC, KK, NN, DST, LDK, KOFS, MODE, KS) { const int nk = (KK) / 64, nn = ((NN) + 63) / 64, tot = nk * nn; \
    int first = (bid - base % G + G) % G; \
    for (int t = first; t < tot; t += G) { const int n0_ = (t % nn) * 64; tr_tile((SRC), (NN), (t / nn) * 64, n0_, ((NN) - n0_) < 64 ? ((NN) - n0_) : 64, (DST), (LDK), (KOFS), (MODE), (KS), sm); } \
    base += tot; }
  for (int lj = 0; lj < 4; ++lj) {
    TRJOB(p.ffn_w1 + (size_t)lj * DM * DFF, DM, DFF, p.W13[lj], DM, 0, 1, nullptr);
    TRJOB(p.ffn_w3 + (size_t)lj * DM * DFF, DM, DFF, p.W13[lj], DM, 0, 2, nullptr);
    TRJOB(p.ffn_w2 + (size_t)lj * DFF * DM, DFF, DM, p.W2[lj], DFF, 0, 0, nullptr);
  }
  TRJOB(p.even_w_in, DM, 1952, p.WinE, DM, 0, 3, nullptr);
  TRJOB(p.w_uq, 256, 768, p.Wqkv, 2048, 0, 0, p.q_norm_g);
  TRJOB(p.w_ukv, 128, 1024, p.Wqkv + (size_t)768 * 2048, 2048, 256, 0, p.kv_norm_g);
  TRJOB(p.even_w_out, DM, DM, p.WoutE, DM, 0, 0, nullptr);
  TRJOB(p.odd_w_in, DM, 5120, p.WinO, DM, 0, 3, nullptr);
  TRJOB(p.odd_w_out, DM, DM, p.WoutO, DM, 0, 0, nullptr);
#undef TRJOB
  for (int i = bid * NTHR + tid; i < 96 * 1024; i += G * NTHR) p.WinE[(size_t)1952 * 1024 + i] = 0;
  for (int i = bid * NTHR + tid; i < 768 * 128; i += G * NTHR) p.Wqkv[(size_t)(i >> 7) * 2048 + 256 + (i & 127)] = 0;
  for (int i = bid * NTHR + tid; i < 1024 * 256; i += G * NTHR) p.Wqkv[(size_t)(768 + (i >> 8)) * 2048 + (i & 255)] = 0;
  for (int i = bid * NTHR + tid; i < M_ALL * 2; i += G * NTHR) p.RS[i] = 0.f;
  for (int i = bid * NTHR + tid; i < 1024; i += G * NTHR) p.aflag[i] = 0u;
  for (int i = bid * NTHR + tid; i < 8192 * 16; i += G * NTHR) {
    const int t = i >> 4, ax = (i >> 3) & 1, fi = i & 7;
    const float pos = (float)(ax == 0 ? (t >> 6) : (t & 63));
    const float ang = pos * exp2f(-(float)fi * (13.287712379549449f / 8.f));
    p.rope[(size_t)(t * 2 + ax) * 16 + fi] = cosf(ang); p.rope[(size_t)(t * 2 + ax) * 16 + 8 + fi] = sinf(ang);
  }
  {
    float* scond = sm;
    float* red = sm + 5 * 1024;
    for (int i = tid; i < 5 * 1024; i += NTHR) {
      const int mi = i >> 10, k = i & 1023;
      const float cv = mi < 4 ? p.c[mi * 1024 + k] : p.c_ctx[k];
      scond[i] = cv * sigmoidf_(cv);
    }
    __syncthreads();
    const int col = tid & 63, kg = tid >> 6;
    for (int it = G - 1 - bid; it < 2 * 144; it += G) {
      const int l = it / 144, n = (it % 144) * 64 + col;
      const float* w = p.ada_w + (size_t)l * 1024 * 9216 + n;
      float a0 = 0, a1 = 0, a2 = 0, a3 = 0, a4 = 0;
#pragma unroll 16
      for (int k = kg * 128; k < kg * 128 + 128; ++k) {
        const float wv = w[(size_t)k * 9216];
        a0 += scond[k] * wv; a1 += scond[1024 + k] * wv; a2 += scond[2048 + k] * wv; a3 += scond[3072 + k] * wv; a4 += scond[4096 + k] * wv;
      }
      red[(kg * 5 + 0) * 64 + col] = a0; red[(kg * 5 + 1) * 64 + col] = a1; red[(kg * 5 + 2) * 64 + col] = a2;
      red[(kg * 5 + 3) * 64 + col] = a3; red[(kg * 5 + 4) * 64 + col] = a4;
      __syncthreads();
      for (int i = tid; i < 5 * 64; i += NTHR) {
        const int mi = i >> 6, cc = i & 63, nn = (it % 144) * 64 + cc;
        float sacc = 0.f;
#pragma unroll
        for (int q = 0; q < 8; ++q) sacc += red[(q * 5 + mi) * 64 + cc];
        p.mod[((size_t)(l * 5 + mi)) * 9216 + nn] = sacc + p.ada_b[l * 9216 + nn];
      }
      __syncthreads();
    }
  }
}

__device__ __forceinline__ void phase_norm(const Params& p, int l, int j, const float* srcC, const float* srcL, int row0,
                           const float* PART = nullptr, int ksl = 0, float coef = 0.f, const float* pgate = nullptr) {
  constexpr int NR = 2;
  const int wave = threadIdx.x >> 6, lane = threadIdx.x & 63;
  const float* g = p.norm_g + (l * 3 + j) * 1024;
  f32x4 gv[4];
#pragma unroll
  for (int i = 0; i < 4; ++i) gv[i] = *(const f32x4*)(g + (lane + 64 * i) * 4);
  const int stride = gridDim.x * 8;
  for (int rb = row0 + blockIdx.x * 8 + wave; rb < M_ALL; rb += stride * NR) {
    f32x4 v[NR][4], sv[NR][4], hv[NR][4];
#pragma unroll
    for (int q = 0; q < NR; ++q) {
      const int rr = rb + q * stride, r = rr < M_ALL ? rr : M_ALL - 1;
      const float* src = r < NCTX ? srcC + (size_t)r * DM : srcL + (size_t)(r - NCTX) * DM;
      const float* sh = p.mod + ((size_t)(l * 5 + row_mi(r)) * 9 + 3 * j) * 1024;
#pragma unroll
      for (int i = 0; i < 4; ++i) { v[q][i] = ((const f32x4*)src)[lane + 64 * i]; hv[q][i] = ((const f32x4*)sh)[lane + 64 * i]; sv[q][i] = ((const f32x4*)(sh + 1024))[lane + 64 * i]; }
      if (ksl > 0 && r < NCTX) {
#pragma unroll
        for (int i = 0; i < 4; ++i) {
          f32x4 a = {0.f, 0.f, 0.f, 0.f};
          for (int sl = 0; sl < ksl; ++sl) a += ((const f32x4*)(PART + ((size_t)sl * NCTX + r) * DM))[lane + 64 * i];
          v[q][i] += coef * ((const f32x4*)pgate)[lane + 64 * i] * a;
        }
      }
    }
#pragma unroll
    for (int q = 0; q < NR; ++q) {
      const int rr = rb + q * stride, r = rr < M_ALL ? rr : M_ALL - 1;
      const bool live = rr < M_ALL;
      float ss = 0.f;
#pragma unroll
      for (int i = 0; i < 4; ++i) ss += v[q][i][0] * v[q][i][0] + v[q][i][1] * v[q][i][1] + v[q][i][2] * v[q][i][2] + v[q][i][3] * v[q][i][3];
      ss = wave_sum(ss);
      const float rstd = rsqrtf(ss * (1.f / 1024.f) + 1e-6f);
      if (live) {
        if (ksl > 0 && r < NCTX) {
#pragma unroll
          for (int i = 0; i < 4; ++i) ((f32x4*)(p.XC + (size_t)r * DM))[lane + 64 * i] = v[q][i];
        }
#pragma unroll
        for (int i = 0; i < 4; ++i) {
          const f32x4 u = v[q][i] * rstd * gv[i] * (1.f + sv[q][i]) + hv[q][i];
          u32x2 o; o.x = pk2(u[0], u[1]); o.y = pk2(u[2], u[3]);
          *(u32x2*)(p.U + (size_t)r * DM + (lane + 64 * i) * 4) = o;
        }
      }
    }
  }
}

__device__ __forceinline__ void phase_final_norm(const Params& p) {
  constexpr int NR = 4;
  const int wave = threadIdx.x >> 6, lane = threadIdx.x & 63;
  f32x4 gv[4];
#pragma unroll
  for (int i = 0; i < 4; ++i) gv[i] = *(const f32x4*)(p.final_norm_g + (lane + 64 * i) * 4);
  const int stride = gridDim.x * 8;
  for (int rb = blockIdx.x * 8 + wave; rb < 32768; rb += stride * NR) {
    f32x4 v[NR][4];
#pragma unroll
    for (int q = 0; q < NR; ++q) {
      const int rr = rb + q * stride, r = rr < 32768 ? rr : 32767;
#pragma unroll
      for (int i = 0; i < 4; ++i) v[q][i] = ((const f32x4*)(p.out + (size_t)r * DM))[lane + 64 * i];
    }
#pragma unroll
    for (int q = 0; q < NR; ++q) {
      const int rr = rb + q * stride, r = rr < 32768 ? rr : 32767;
      const bool live = rr < 32768;
      float ss = 0.f;
#pragma unroll
      for (int i = 0; i < 4; ++i) ss += v[q][i][0] * v[q][i][0] + v[q][i][1] * v[q][i][1] + v[q][i][2] * v[q][i][2] + v[q][i][3] * v[q][i][3];
      ss = wave_sum(ss);
      const float rstd = rsqrtf(ss * (1.f / 1024.f) + 1e-6f);
#pragma unroll
      for (int i = 0; i < 4; ++i) {
        const int c = (lane + 64 * i) * 4;
        if (live) ((f32x4*)(p.out + (size_t)r * DM))[lane + 64 * i] = v[q][i] * rstd * gv[i];
      }
    }
  }
}

__device__ void phase_even_elem(const Params& p, const bf16_t* P, bf16_t* CAT, bf16_t* Kall) {
  const int wave = threadIdx.x >> 6, lane = threadIdx.x & 63;
  for (int r = blockIdx.x * 8 + wave; r < M_ALL; r += gridDim.x * 8) {
    int b, key; row_bk(r, b, key);
    const bool latent = r >= NCTX;
    const int t = latent ? ((r - NCTX) & 8191) : (r & 255), T = latent ? 8192 : 256;
    const int c0 = lane * 8;
    float cv[3][8];
#pragma unroll
    for (int dt = 0; dt < 3; ++dt) {
      const int tt = t + dt - 1;
      if (tt >= 0 && tt < T) {
        const bf16_t* pr = P + (size_t)(r + dt - 1) * 2048;
        u32x4 gc = *(const u32x4*)(pr + 512 + c0), vv = *(const u32x4*)(pr + 1024 + c0);
#pragma unroll
        for (int e = 0; e < 4; ++e) { cv[dt][2 * e] = lo2f(gc[e]) * lo2f(vv[e]); cv[dt][2 * e + 1] = hi2f(gc[e]) * hi2f(vv[e]); }
      } else {
#pragma unroll
        for (int e = 0; e < 8; ++e) cv[dt][e] = 0.f;
      }
    }
    u32x4 gb = *(const u32x4*)(P + (size_t)r * 2048 + c0);
    float o[8];
#pragma unroll
    for (int e = 0; e < 8; ++e) {
      const float w0 = p.even_conv_w[c0 + e], w1 = p.even_conv_w[512 + c0 + e], w2 = p.even_conv_w[1024 + c0 + e];
      const float g = (e & 1) ? hi2f(gb[e >> 1]) : lo2f(gb[e >> 1]);
      o[e] = g * (cv[0][e] * w0 + cv[1][e] * w1 + cv[2][e] * w2);
    }
    u32x4 ov; ov.x = pk2(o[0], o[1]); ov.y = pk2(o[2], o[3]); ov.z = pk2(o[4], o[5]); ov.w = pk2(o[6], o[7]);
    *(u32x4*)(CAT + (size_t)r * DM + c0) = ov;
    {
      const int d = lane & 31;
      float v = bf2f(P[(size_t)r * 2048 + 1920 + d]);
      const float pv = __shfl_xor(v, 8);
      const int idx = d & 15, fi = idx & 7;
      if (latent) {
        const float* rp = p.rope + ((size_t)t * 2 + (d >> 4)) * 16 + fi;
        const float cs = rp[0], sn = rp[8];
        v = (idx < 8) ? (v * cs - pv * sn) : (pv * sn + v * cs);
      }
      const bf16_t bv = f2bf(v);
      if (lane < 32) {
#pragma unroll
        for (int h = 0; h < 8; ++h) Kall[((size_t)(b * 8 + h) * NKEY + key) * 96 + 64 + d] = bv;
      }
    }
  }
}

__device__ void phase_attn_scalar(const Params& p, const bf16_t* Qall, const bf16_t* Kall, const bf16_t* Vt, bf16_t* CAT) {
  const int ql = threadIdx.x & 255, half = threadIdx.x >> 8;
  for (int it = blockIdx.x; it < 1056; it += gridDim.x) {
    int b, h, q0, nk;
    if (it < 1024) { b = it >> 8; h = (it >> 5) & 7; q0 = 256 + (it & 31) * 256; nk = NKEY; }
    else { const int i2 = it - 1024; b = i2 >> 3; h = i2 & 7; q0 = 0; nk = 256; }
    const int qi = q0 + ql;
    const size_t bh = (size_t)(b * 8 + h);
    float q[96];
    {
      const u32x4* qp = (const u32x4*)(Qall + (bh * NKEY + qi) * 96);
#pragma unroll
      for (int i = 0; i < 12; ++i) { u32x4 v = qp[i];
#pragma unroll
        for (int e = 0; e < 4; ++e) { q[8 * i + 2 * e] = lo2f(v[e]); q[8 * i + 2 * e + 1] = hi2f(v[e]); } }
    }
    float o[32];
#pragma unroll
    for (int i = 0; i < 32; ++i) o[i] = 0.f;
    float mrun = -1e30f, lrun = 0.f;
    for (int k0 = 0; k0 < nk; k0 += 4) {
      float s[4];
#pragma unroll
      for (int kk = 0; kk < 4; ++kk) {
        const u32x4* kp = (const u32x4*)(Kall + (bh * NKEY + k0 + kk) * 96);
        float a = 0.f;
#pragma unroll
        for (int i = 0; i < 12; ++i) { u32x4 v = kp[i];
#pragma unroll
          for (int e = 0; e < 4; ++e) a += q[8 * i + 2 * e] * lo2f(v[e]) + q[8 * i + 2 * e + 1] * hi2f(v[e]); }
        s[kk] = a;
      }
      const float mx = fmaxf(fmaxf(s[0], s[1]), fmaxf(s[2], s[3]));
      const float mnew = fmaxf(mrun, mx);
      const float alpha = exp2f(mrun - mnew);
      const float p0 = exp2f(s[0] - mnew), p1 = exp2f(s[1] - mnew), p2 = exp2f(s[2] - mnew), p3 = exp2f(s[3] - mnew);
      lrun = lrun * alpha + p0 + p1 + p2 + p3;
      mrun = mnew;
#pragma unroll
      for (int dv = 0; dv < 32; ++dv) {
        u32x2 v = *(const u32x2*)(Vt + (bh * 64 + half * 32 + dv) * NKEY + k0);
        o[dv] = o[dv] * alpha + p0 * lo2f(v.x) + p1 * hi2f(v.x) + p2 * lo2f(v.y) + p3 * hi2f(v.y);
      }
    }
    const float il = 1.f / lrun;
    const int r = qi < 256 ? b * 256 + qi : NCTX + b * 8192 + (qi - 256);
    u32x4* op = (u32x4*)(CAT + (size_t)r * DM + 512 + h * 64 + half * 32);
#pragma unroll
    for (int i = 0; i < 4; ++i) {
      u32x4 v; v.x = pk2(o[8 * i] * il, o[8 * i + 1] * il); v.y = pk2(o[8 * i + 2] * il, o[8 * i + 3] * il);
      v.z = pk2(o[8 * i + 4] * il, o[8 * i + 5] * il); v.w = pk2(o[8 * i + 6] * il, o[8 * i + 7] * il);
      op[i] = v;
    }
  }
}

typedef float f32x16 __attribute__((ext_vector_type(16)));
__device__ __forceinline__ float ex2(float x) { return __builtin_amdgcn_exp2f(x); }
template <bool SAFE>
__device__ void phase_attn(const Params& p, const bf16_t* Qall, const bf16_t* Kall, const bf16_t* Vt, bf16_t* CAT, LAS unsigned char* lds) {
  const int tid = threadIdx.x, w = __builtin_amdgcn_readfirstlane(tid >> 6), lane = tid & 63, r = lane & 31, hh = lane >> 5;
  constexpr int KROW = 104, VROW = 72;
  constexpr int KBYTES = 64 * KROW * 2, VBYTES = 64 * VROW * 2, BUF = KBYTES + VBYTES;
  unsigned soff[3];
#pragma unroll
  for (int j = 0; j < 3; ++j) {
    const int ci = (3 * w + j) * 64 + lane;
    if (3 * w + j < 13) { const int row = ci / 13, part = ci % 13; soff[j] = (unsigned)(row * 96 + (part < 12 ? part : 0) * 8) * 2u; }
    else { const int c2 = ci - 832, dv = c2 / 9, part = c2 % 9; soff[j] = (unsigned)((dv < 64 ? dv : 0) * NKEY + (part < 8 ? part : 0) * 8) * 2u; }
  }
#define ATT_STAGE(bufi, k0_) do { _Pragma("unroll") for (int j_ = 0; j_ < 3; ++j_) if (j_ == 0 || w < 7) { \
    const char* g_ = (3 * w + j_ < 13) ? (const char*)kbase + soff[j_] + (size_t)(k0_) * 192 : (const char*)vbase + soff[j_] + (size_t)(k0_) * 2; \
    __builtin_amdgcn_global_load_lds((const unsigned*)g_, (LAS unsigned*)(lds + (bufi) * BUF + (3 * w + j_) * 1024), 16, 0, 0); } } while (0)
  for (int it = blockIdx.x; it < 544; it += gridDim.x) {
    if (SAFE && p.aflag[it] == 0u) continue;
    bool wbad = false;
    int b, h, q0, nk, nq;
    if (it < 512) { b = it >> 7; h = (it >> 4) & 7; q0 = 256 + (it & 15) * 512; nk = NKEY; nq = 512; }
    else { const int i2 = it - 512; b = i2 >> 3; h = i2 & 7; q0 = 0; nk = 256; nq = 256; }
    const size_t bh = (size_t)(b * 8 + h);
    const int qw = 64 * w;
    const bool wact = qw < nq;
    const int qbase = q0 + (wact ? qw : 0) + r;
    bf16x8 qf[2][6];
#pragma unroll
    for (int qb = 0; qb < 2; ++qb) {
      const bf16_t* qp = Qall + (bh * NKEY + qbase + 32 * qb) * 96 + 8 * hh;
#pragma unroll
      for (int c = 0; c < 6; ++c) qf[qb][c] = *(const bf16x8*)(qp + 16 * c);
    }
    f32x16 o[2][2];
#pragma unroll
    for (int qb = 0; qb < 2; ++qb)
#pragma unroll
      for (int i = 0; i < 16; ++i) { o[qb][0][i] = 0.f; o[qb][1][i] = 0.f; }
    float mrun[2] = {0.f, 0.f}, lrun[2] = {0.f, 0.f};
    const bf16_t* kbase = Kall + bh * NKEY * 96;
    const bf16_t* vbase = Vt + bh * 64 * NKEY;
    ATT_STAGE(0, 0);
    asm volatile("s_waitcnt vmcnt(0)" ::: "memory");
    __syncthreads();
    const int ntile = nk >> 6;
    for (int i = 0; i < ntile; ++i) {
      const bool more = (i + 1 < ntile);
      if (more) ATT_STAGE((i + 1) & 1, (i + 1) * 64);
      LAS unsigned char* kb_ = lds + (i & 1) * BUF;
      LAS unsigned char* vb_ = kb_ + KBYTES;
      f32x16 s[2][2];
#pragma unroll
      for (int qb = 0; qb < 2; ++qb)
#pragma unroll
        for (int e = 0; e < 16; ++e) { s[qb][0][e] = 0.f; s[qb][1][e] = 0.f; }
#pragma unroll
      for (int c = 0; c < 6; ++c) {
        const bf16x8 ka = *(const LAS bf16x8*)(kb_ + (r * KROW + 16 * c + 8 * hh) * 2);
        const bf16x8 kb2 = *(const LAS bf16x8*)(kb_ + ((32 + r) * KROW + 16 * c + 8 * hh) * 2);
#pragma unroll
        for (int qb = 0; qb < 2; ++qb) {
          s[qb][0] = __builtin_amdgcn_mfma_f32_32x32x16_bf16(ka, qf[qb][c], s[qb][0], 0, 0, 0);
          s[qb][1] = __builtin_amdgcn_mfma_f32_32x32x16_bf16(kb2, qf[qb][c], s[qb][1], 0, 0, 0);
        }
      }
#pragma unroll
      for (int qb = 0; qb < 2; ++qb) {
        if (SAFE) {
          float mx = fmaxf(s[qb][0][0], s[qb][1][0]);
#pragma unroll
          for (int e = 1; e < 16; ++e) mx = fmaxf(mx, fmaxf(s[qb][0][e], s[qb][1][e]));
          mx = fmaxf(mx, __shfl_xor(mx, 32));
          const bool need = (i == 0) || (mx - mrun[qb] > 8.f);
          if (__builtin_amdgcn_ballot_w64(need) != 0ull) {
            const float nm = need ? mx : mrun[qb];
            const float alpha = (i == 0) ? 1.f : ex2(mrun[qb] - nm);
            mrun[qb] = nm; lrun[qb] *= alpha;
#pragma unroll
            for (int e = 0; e < 16; ++e) { o[qb][0][e] *= alpha; o[qb][1][e] *= alpha; }
          }
        }
        f32x2 ps2 = {0.f, 0.f};
        const f32x2 m2 = {mrun[qb], mrun[qb]};
#pragma unroll
        for (int kb = 0; kb < 2; ++kb)
#pragma unroll
          for (int e = 0; e < 16; e += 2) {
            f32x2 t = {s[qb][kb][e], s[qb][kb][e + 1]};
            if (SAFE) t = t - m2;
            t.x = ex2(t.x); t.y = ex2(t.y);
            ps2 += t;
            s[qb][kb][e] = t.x; s[qb][kb][e + 1] = t.y;
          }
        lrun[qb] += ps2.x + ps2.y;
        if (!SAFE) wbad = wbad || !(ps2.x + ps2.y < 1.2089258e24f);
      }
#pragma unroll
      for (int kb = 0; kb < 2; ++kb)
#pragma unroll
        for (int t = 0; t < 2; ++t) {
          const int kofs = 32 * kb + 16 * t + 4 * hh;
          u32x4 va, vb2;
          { const u32x2 lo = *(const LAS u32x2*)(vb_ + (r * VROW + kofs) * 2), hi = *(const LAS u32x2*)(vb_ + (r * VROW + kofs + 8) * 2); va.x = lo.x; va.y = lo.y; va.z = hi.x; va.w = hi.y; }
          { const u32x2 lo = *(const LAS u32x2*)(vb_ + ((32 + r) * VROW + kofs) * 2), hi = *(const LAS u32x2*)(vb_ + ((32 + r) * VROW + kofs + 8) * 2); vb2.x = lo.x; vb2.y = lo.y; vb2.z = hi.x; vb2.w = hi.y; }
#pragma unroll
          for (int qb = 0; qb < 2; ++qb) {
            u32x4 pw;
            pw.x = pk2(s[qb][kb][8 * t], s[qb][kb][8 * t + 1]); pw.y = pk2(s[qb][kb][8 * t + 2], s[qb][kb][8 * t + 3]);
            pw.z = pk2(s[qb][kb][8 * t + 4], s[qb][kb][8 * t + 5]); pw.w = pk2(s[qb][kb][8 * t + 6], s[qb][kb][8 * t + 7]);
            const bf16x8 pf = __builtin_bit_cast(bf16x8, pw);
            o[qb][0] = __builtin_amdgcn_mfma_f32_32x32x16_bf16(__builtin_bit_cast(bf16x8, va), pf, o[qb][0], 0, 0, 0);
            o[qb][1] = __builtin_amdgcn_mfma_f32_32x32x16_bf16(__builtin_bit_cast(bf16x8, vb2), pf, o[qb][1], 0, 0, 0);
          }
        }
      asm volatile("s_waitcnt vmcnt(0)" ::: "memory");
      __syncthreads();
    }
    if (!SAFE) { if (__builtin_amdgcn_ballot_w64(wbad) != 0ull && lane == 0) p.aflag[it] = 1u; }
    if (wact) {
#pragma unroll
      for (int qb = 0; qb < 2; ++qb) {
        float l = lrun[qb]; l += __shfl_xor(l, 32);
        if (!SAFE) { if (__builtin_amdgcn_ballot_w64(!(l > 8.6736174e-19f)) != 0ull && lane == 0) p.aflag[it] = 1u; }
        const float il = 1.f / l;
        const int qi = qbase + 32 * qb;
        const int row = qi < 256 ? b * 256 + qi : NCTX + b * 8192 + (qi - 256);
        bf16_t* op = CAT + (size_t)row * DM + 512 + h * 64 + 4 * hh;
#pragma unroll
        for (int g = 0; g < 4; ++g) {
          u32x2 a; a.x = pk2(o[qb][0][4 * g] * il, o[qb][0][4 * g + 1] * il); a.y = pk2(o[qb][0][4 * g + 2] * il, o[qb][0][4 * g + 3] * il);
          *(u32x2*)(op + 8 * g) = a;
          u32x2 c; c.x = pk2(o[qb][1][4 * g] * il, o[qb][1][4 * g + 1] * il); c.y = pk2(o[qb][1][4 * g + 2] * il, o[qb][1][4 * g + 3] * il);
          *(u32x2*)(op + 32 + 8 * g) = c;
        }
      }
    }
  }
}
#undef ATT_STAGE

__device__ void phase_hgrn_scalar(const Params& p, int dir, const bf16_t* Qh, const bf16_t* Vv, const bf16_t* Gg, const _Float16* Lx, bf16_t* O, float* sm) {
  float* sf = sm; float* sk = sm + 128; float* sq = sm + 256; float* part = sm + 384;   float* red = sm + 896;
  const int tid = threadIdx.x, dv = tid & 127, kg = tid >> 7;
  for (int it = blockIdx.x; it < 32; it += gridDim.x) {
    const int b = it >> 3, h = it & 7;
    float S[32];
#pragma unroll
    for (int i = 0; i < 32; ++i) S[i] = 0.f;
    for (int n = 0; n < NKEY; ++n) {
      int r; bool latent = n >= 256;
      if (!latent) r = b * 256 + (dir == 0 ? n : 255 - n);
      else r = NCTX + b * 8192 + (dir == 0 ? (n - 256) : (8191 - (n - 256)));
      const size_t off = (size_t)r * DM + h * 128;
      if (tid < 128) {
        const float f = __expf((float)Lx[off + tid]);
        sf[tid] = f; sk[tid] = 1.f - f; sq[tid] = bf2f(Qh[off + tid]);
      }
      __syncthreads();
      const float v = bf2f(Vv[off + dv]);
      float po = 0.f;
#pragma unroll
      for (int i = 0; i < 32; ++i) { const int dk = kg * 32 + i; S[i] = sf[dk] * S[i] + sk[dk] * v; po += S[i] * sq[dk]; }
      if (latent) {
        part[kg * 128 + dv] = po;
        __syncthreads();
        if (tid < 128) {
          float o = part[tid] + part[128 + tid] + part[256 + tid] + part[384 + tid];
          if (dir == 0) O[off + tid] = f2bf(o);
          else {
            o += bf2f(O[off + tid]);
            float ss = wave_sum(o * o);
            if ((tid & 63) == 0) red[tid >> 6] = ss;
            part[tid] = o;
          }
        }
        __syncthreads();
        if (dir == 1 && tid < 128) {
          const float o = part[tid];
          const float rstd = rsqrtf((red[0] + red[1]) * (1.f / 128.f) + 1e-6f);
          const float g = bf2f(Gg[off + tid]);
          O[off + tid] = f2bf(o * rstd * p.g_norm_g[tid] * g * sigmoidf_(g));
        }
      }
      __syncthreads();
    }
  }
}

template <bool OUT>
__device__ void phase_hgrn(const Params& p, const bf16_t* Qh, const bf16_t* Vv, const _Float16* Lfb, bf16_t* Of, bf16_t* Ob, float* Sseg, float* Dlog, LAS unsigned char* lds) {
  constexpr int NSEG = 4, CPS = 33, NIT = OUT ? 64 * NSEG : 64 * (NSEG - 1);
  constexpr int QT = 0, KT = QT + 64 * 136 * 2, KE = KT + 64 * 136 * 2, VT = KE + 128 * 72 * 2, AT = VT + 128 * 72 * 2,
                ST = AT + 64 * 72 * 2, DC = ST + 128 * 136 * 2, TOT = DC + 512;
  const int tid = threadIdx.x, w = tid >> 6, lane = tid & 63, r = lane & 31, hh = lane >> 5;
  const int dk = tid & 127, tq = tid >> 7;
  const int dvb = w & 3, wh = w >> 2;
  for (int it = blockIdx.x; it < NIT; it += gridDim.x) {
    const int bhd = OUT ? it >> 2 : it / 3, sg = OUT ? it & 3 : it % 3;
    const int b = bhd >> 4, h = (bhd >> 1) & 7, dir = bhd & 1;
    const int c_begin = sg * CPS, c_end = c_begin + CPS;
    const _Float16* Lx = Lfb + (size_t)dir * ((size_t)M_ALL * DM);
    const int sgn = dir ? -1 : 1;
    f32x16 S0, S1;
#pragma unroll
    for (int e = 0; e < 16; ++e) { S0[e] = 0.f; S1[e] = 0.f; }
    if constexpr (OUT) {
      for (int sp = 0; sp < sg; ++sp) {
        const float* sp_ = Sseg + ((size_t)(bhd * 3 + sp) * 8 + w) * 2048;
        const float* dl = Dlog + (size_t)(bhd * 3 + sp) * 128;
#pragma unroll
        for (int g = 0; g < 4; ++g) {
          const f32x4 d0 = *(const f32x4*)(dl + 32 * (2 * wh) + 8 * g + 4 * hh), d1 = *(const f32x4*)(dl + 32 * (2 * wh + 1) + 8 * g + 4 * hh);
#pragma unroll
          for (int j = 0; j < 4; ++j) {
            S0[4 * g + j] = S0[4 * g + j] * __expf(d0[j]) + sp_[(4 * g + j) * 64 + lane];
            S1[4 * g + j] = S1[4 * g + j] * __expf(d1[j]) + sp_[1024 + (4 * g + j) * 64 + lane];
          }
        }
      }
#pragma unroll
      for (int g = 0; g < 4; ++g) {
        u32x2 a0; a0.x = pk2(S0[4 * g], S0[4 * g + 1]); a0.y = pk2(S0[4 * g + 2], S0[4 * g + 3]);
        *(LAS u32x2*)(lds + ST + ((32 * dvb + r) * 136 + 32 * (2 * wh) + 8 * g + 4 * hh) * 2) = a0;
        u32x2 a1; a1.x = pk2(S1[4 * g], S1[4 * g + 1]); a1.y = pk2(S1[4 * g + 2], S1[4 * g + 3]);
        *(LAS u32x2*)(lds + ST + ((32 * dvb + r) * 136 + 32 * (2 * wh + 1) + 8 * g + 4 * hh) * 2) = a1;
      }
    }
    float dsum = 0.f;
    _Float16 lfr[16]; bf16_t qr[16], vr[16];
    {
      const int cn = c_begin;
      const int rb0 = (cn < 4) ? b * 256 + (dir ? 255 - 64 * cn : 64 * cn) : NCTX + b * 8192 + (dir ? 8191 - 64 * (cn - 4) : 64 * (cn - 4));
      const size_t o0 = (size_t)(rb0 + sgn * 16 * tq) * DM + h * 128 + dk;
#pragma unroll
      for (int i = 0; i < 16; ++i) { const size_t o = o0 + (ptrdiff_t)(sgn * i) * DM; lfr[i] = Lx[o]; if constexpr (OUT) qr[i] = Qh[o]; else qr[i] = 0; vr[i] = Vv[o]; }
    }
    __syncthreads();
    for (int c = c_begin; c < c_end; ++c) {
      const int rbase = (c < 4) ? b * 256 + (dir ? 255 - 64 * c : 64 * c) : NCTX + b * 8192 + (dir ? 8191 - 64 * (c - 4) : 64 * (c - 4));
      float lf[16], cs[16];
      float run = 0.f;
#pragma unroll
      for (int i = 0; i < 16; ++i) { lf[i] = (float)lfr[i]; run += lf[i]; cs[i] = run; }
      *(LAS float*)(lds + TOT + (tq * 128 + dk) * 4) = run;
      __syncthreads();
      float offs = 0.f, blast = 0.f;
#pragma unroll
      for (int g = 0; g < 4; ++g) { const float t = *(const LAS float*)(lds + TOT + (g * 128 + dk) * 4); blast += t; if (g < tq) offs += t; }
      {
        const float eblast = __expf(blast);
        unsigned kew[8], vw[8];
#pragma unroll
        for (int i = 0; i < 16; i += 2) {
          float qt[2], kt[2], ke[2];
#pragma unroll
          for (int e = 0; e < 2; ++e) {
            const float bb = offs + cs[i + e];
            const float k = 1.f - __expf(lf[i + e]);
            const float ken = k * __expf(-bb);
            if constexpr (OUT) { qt[e] = bf2f(qr[i + e]) * __expf(bb); kt[e] = ken; }
            ke[e] = ken * eblast;
          }
          if constexpr (OUT) {
            const unsigned qp = pk2(qt[0], qt[1]), kp = pk2(kt[0], kt[1]);
            const int s = 16 * tq + i;
            *(LAS bf16_t*)(lds + QT + (s * 136 + dk) * 2) = (bf16_t)(qp & 0xffffu);
            *(LAS bf16_t*)(lds + QT + ((s + 1) * 136 + dk) * 2) = (bf16_t)(qp >> 16);
            *(LAS bf16_t*)(lds + KT + (s * 136 + dk) * 2) = (bf16_t)(kp & 0xffffu);
            *(LAS bf16_t*)(lds + KT + ((s + 1) * 136 + dk) * 2) = (bf16_t)(kp >> 16);
          }
          kew[i >> 1] = pk2(ke[0], ke[1]);
          vw[i >> 1] = (unsigned)vr[i] | ((unsigned)vr[i + 1] << 16);
        }
        *(LAS u32x4*)(lds + KE + (dk * 72 + 16 * tq) * 2) = (u32x4){kew[0], kew[1], kew[2], kew[3]};
        *(LAS u32x4*)(lds + KE + (dk * 72 + 16 * tq + 8) * 2) = (u32x4){kew[4], kew[5], kew[6], kew[7]};
        *(LAS u32x4*)(lds + VT + (dk * 72 + 16 * tq) * 2) = (u32x4){vw[0], vw[1], vw[2], vw[3]};
        *(LAS u32x4*)(lds + VT + (dk * 72 + 16 * tq + 8) * 2) = (u32x4){vw[4], vw[5], vw[6], vw[7]};
        if (tq == 0) *(LAS float*)(lds + DC + dk * 4) = eblast;
        dsum += blast;
      }
      __syncthreads();
      if (c + 1 < c_end) {
        const int cn = c + 1;
        const int rb = (cn < 4) ? b * 256 + (dir ? 255 - 64 * cn : 64 * cn) : NCTX + b * 8192 + (dir ? 8191 - 64 * (cn - 4) : 64 * (cn - 4));
        const size_t o0 = (size_t)(rb + sgn * 16 * tq) * DM + h * 128 + dk;
#pragma unroll
        for (int i = 0; i < 16; ++i) { const size_t o = o0 + (ptrdiff_t)(sgn * i) * DM; lfr[i] = Lx[o]; if constexpr (OUT) qr[i] = Qh[o]; else qr[i] = 0; vr[i] = Vv[o]; }
      }
      if (OUT && w < 3) {
        const int sb = (w == 2) ? 1 : 0, tb = (w == 0) ? 0 : 1;
        f32x16 a;
#pragma unroll
        for (int e = 0; e < 16; ++e) a[e] = 0.f;
#pragma unroll
        for (int ks = 0; ks < 8; ++ks) {
          const bf16x8 ka = *(const LAS bf16x8*)(lds + KT + ((32 * sb + r) * 136 + 16 * ks + 8 * hh) * 2);
          const bf16x8 qb = *(const LAS bf16x8*)(lds + QT + ((32 * tb + r) * 136 + 16 * ks + 8 * hh) * 2);
          a = __builtin_amdgcn_mfma_f32_32x32x16_bf16(ka, qb, a, 0, 0, 0);
        }
        const int tok = 32 * tb + r;
#pragma unroll
        for (int g = 0; g < 4; ++g) {
          const int s0 = 32 * sb + 8 * g + 4 * hh;
          const float v0 = (s0 + 0 <= tok) ? a[4 * g + 0] : 0.f, v1 = (s0 + 1 <= tok) ? a[4 * g + 1] : 0.f;
          const float v2 = (s0 + 2 <= tok) ? a[4 * g + 2] : 0.f, v3 = (s0 + 3 <= tok) ? a[4 * g + 3] : 0.f;
          u32x2 o; o.x = pk2(v0, v1); o.y = pk2(v2, v3);
          *(LAS u32x2*)(lds + AT + (tok * 72 + s0) * 2) = o;
        }
      }
      {
#pragma unroll
        for (int g = 0; g < 4; ++g) {
          const f32x4 d0 = *(const LAS f32x4*)(lds + DC + (32 * (2 * wh) + 8 * g + 4 * hh) * 4);
          const f32x4 d1 = *(const LAS f32x4*)(lds + DC + (32 * (2 * wh + 1) + 8 * g + 4 * hh) * 4);
#pragma unroll
          for (int j = 0; j < 4; ++j) { S0[4 * g + j] *= d0[j]; S1[4 * g + j] *= d1[j]; }
        }
#pragma unroll
        for (int ks = 0; ks < 4; ++ks) {
          const bf16x8 vb = *(const LAS bf16x8*)(lds + VT + ((32 * dvb + r) * 72 + 16 * ks + 8 * hh) * 2);
          const bf16x8 k0 = *(const LAS bf16x8*)(lds + KE + ((32 * (2 * wh) + r) * 72 + 16 * ks + 8 * hh) * 2);
          const bf16x8 k1 = *(const LAS bf16x8*)(lds + KE + ((32 * (2 * wh + 1) + r) * 72 + 16 * ks + 8 * hh) * 2);
          S0 = __builtin_amdgcn_mfma_f32_32x32x16_bf16(k0, vb, S0, 0, 0, 0);
          S1 = __builtin_amdgcn_mfma_f32_32x32x16_bf16(k1, vb, S1, 0, 0, 0);
        }
      }
      if constexpr (OUT) {
      __syncthreads();
      {
        const int tb = wh;
        f32x16 o;
#pragma unroll
        for (int e = 0; e < 16; ++e) o[e] = 0.f;
#pragma unroll
        for (int ks = 0; ks < 4; ++ks) {
          if (ks < 2 * (tb + 1)) {
            const bf16x8 va = *(const LAS bf16x8*)(lds + VT + ((32 * dvb + r) * 72 + 16 * ks + 8 * hh) * 2);
            const bf16x8 ab = *(const LAS bf16x8*)(lds + AT + ((32 * tb + r) * 72 + 16 * ks + 8 * hh) * 2);
            o = __builtin_amdgcn_mfma_f32_32x32x16_bf16(va, ab, o, 0, 0, 0);
          }
        }
#pragma unroll
        for (int ks = 0; ks < 8; ++ks) {
          const bf16x8 sa = *(const LAS bf16x8*)(lds + ST + ((32 * dvb + r) * 136 + 16 * ks + 8 * hh) * 2);
          const bf16x8 qb = *(const LAS bf16x8*)(lds + QT + ((32 * tb + r) * 136 + 16 * ks + 8 * hh) * 2);
          o = __builtin_amdgcn_mfma_f32_32x32x16_bf16(sa, qb, o, 0, 0, 0);
        }
        if (c >= 4) {
          const int row = rbase + sgn * (32 * tb + r);
          bf16_t* op = (dir ? Ob + (size_t)(row - NCTX) * DM : Of + (size_t)row * DM) + h * 128 + 32 * dvb + 4 * hh;
#pragma unroll
          for (int g = 0; g < 4; ++g) {
            u32x2 ov; ov.x = pk2(o[4 * g], o[4 * g + 1]); ov.y = pk2(o[4 * g + 2], o[4 * g + 3]);
            *(u32x2*)(op + 8 * g) = ov;
          }
        }
      }
      __syncthreads();
#pragma unroll
      for (int g = 0; g < 4; ++g) {
        u32x2 a0; a0.x = pk2(S0[4 * g], S0[4 * g + 1]); a0.y = pk2(S0[4 * g + 2], S0[4 * g + 3]);
        *(LAS u32x2*)(lds + ST + ((32 * dvb + r) * 136 + 32 * (2 * wh) + 8 * g + 4 * hh) * 2) = a0;
        u32x2 a1; a1.x = pk2(S1[4 * g], S1[4 * g + 1]); a1.y = pk2(S1[4 * g + 2], S1[4 * g + 3]);
        *(LAS u32x2*)(lds + ST + ((32 * dvb + r) * 136 + 32 * (2 * wh + 1) + 8 * g + 4 * hh) * 2) = a1;
      }
      }
    }
    if constexpr (!OUT) {
      float* sp_ = Sseg + ((size_t)(bhd * 3 + sg) * 8 + w) * 2048;
#pragma unroll
      for (int e = 0; e < 16; ++e) { sp_[e * 64 + lane] = S0[e]; sp_[1024 + e * 64 + lane] = S1[e]; }
      if (tq == 0) Dlog[(size_t)(bhd * 3 + sg) * 128 + dk] = dsum;
    }
    __syncthreads();
  }
}

__device__ void phase_hgrn_readout(const Params& p, bf16_t* Of, const bf16_t* Ob, const bf16_t* Gg) {
  const int wave = threadIdx.x >> 6, lane = threadIdx.x & 63;
  for (int r = NCTX + blockIdx.x * 8 + wave; r < M_ALL; r += gridDim.x * 8) {
    const int c0 = lane * 16;
    float o[16];
#pragma unroll
    for (int i = 0; i < 2; ++i) {
      const u32x4 a = *(const u32x4*)(Of + (size_t)r * DM + c0 + 8 * i), bq = *(const u32x4*)(Ob + (size_t)(r - NCTX) * DM + c0 + 8 * i);
#pragma unroll
      for (int e = 0; e < 4; ++e) { o[8 * i + 2 * e] = lo2f(a[e]) + lo2f(bq[e]); o[8 * i + 2 * e + 1] = hi2f(a[e]) + hi2f(bq[e]); }
    }
    float ss = 0.f;
#pragma unroll
    for (int i = 0; i < 16; ++i) ss += o[i] * o[i];
    ss += __shfl_xor(ss, 1); ss += __shfl_xor(ss, 2); ss += __shfl_xor(ss, 4);
    const float rstd = rsqrtf(ss * (1.f / 128.f) + 1e-6f);
    const int cg = c0 & 127;
#pragma unroll
    for (int i = 0; i < 2; ++i) {
      const u32x4 gq = *(const u32x4*)(Gg + (size_t)r * DM + c0 + 8 * i);
      float y[8];
#pragma unroll
      for (int e = 0; e < 8; ++e) {
        const float g = (e & 1) ? hi2f(gq[e >> 1]) : lo2f(gq[e >> 1]);
        y[e] = o[8 * i + e] * rstd * p.g_norm_g[cg + 8 * i + e] * g * sigmoidf_(g);
      }
      u32x4 ov; ov.x = pk2(y[0], y[1]); ov.y = pk2(y[2], y[3]); ov.z = pk2(y[4], y[5]); ov.w = pk2(y[6], y[7]);
      *(u32x4*)(Of + (size_t)r * DM + c0 + 8 * i) = ov;
    }
  }
}

#define XB_TMO      128
#define XB_XCNT(j)  (256  + 64 * (j))
#define XB_XSUB(j)  (1280 + 64 * (j))
#define XB_XGEN(j)  (2304 + 64 * (j))
#define XB_TOP      3328
#define XB_TOPGEN   3392
#define XCD_BAR_WORDS 3456
#define XB_SPIN_CAP (1u << 22)
__device__ __forceinline__ unsigned xb_ld(unsigned* p)              { return __hip_atomic_load(p, __ATOMIC_RELAXED, __HIP_MEMORY_SCOPE_AGENT); }
__device__ __forceinline__ unsigned xb_add(unsigned* p, unsigned v) { return __hip_atomic_fetch_add(p, v, __ATOMIC_RELAXED, __HIP_MEMORY_SCOPE_AGENT); }
__device__ __forceinline__ unsigned xb_xcc_id() { return (unsigned)__builtin_amdgcn_s_getreg((3 << 11) | 20) & 0xFu; }
#define XB_SPIN(cond, bar) do { unsigned _sp = 0; while (cond) { __builtin_amdgcn_s_sleep(1); \
    if ((++_sp & 255u) == 0u) { if (xb_ld(&(bar)[XB_TMO])) break; if (_sp > XB_SPIN_CAP) { atomicAdd(&(bar)[XB_TMO], 1u); break; } } } } while (0)
__device__ __forceinline__ void xcd_barrier_complete(unsigned* bar, unsigned x, unsigned& nloc, unsigned& nx) {
  const unsigned G = gridDim.x * gridDim.y * gridDim.z;
  unsigned sum, cnt, mine, sp = 0u;
  for (;;) {
    sum = 0u; cnt = 0u; mine = 0u;
#pragma unroll
    for (unsigned j = 0; j < 16; ++j) { const unsigned c = xb_ld(&bar[XB_XCNT(j)]); sum += c; cnt += (c > 0u) ? 1u : 0u; mine = (j == x) ? c : mine; }
    if (sum == G) break;
    __builtin_amdgcn_s_sleep(1);
    if ((++sp & 255u) == 0u) { if (xb_ld(&bar[XB_TMO])) break; if (sp > XB_SPIN_CAP) { atomicAdd(&bar[XB_TMO], 1u); break; } }
  }
  nloc = mine > 0u ? mine : 1u; nx = cnt > 0u ? cnt : 1u;
}
__device__ __forceinline__ void xcd_barrier(unsigned* bar, volatile LAS unsigned* st) {
  asm volatile("s_waitcnt vmcnt(0)" ::: "memory");
  __syncthreads();
  if (threadIdx.x == 0) {
    const unsigned x = xb_xcc_id();
    __builtin_amdgcn_s_waitcnt(0);
    unsigned nloc = st[0], nx = st[1];
    if (nloc == 0u) { xcd_barrier_complete(bar, x, nloc, nx); st[0] = nloc; st[1] = nx; }
    const unsigned old = xb_add(&bar[XB_XSUB(x)], 1u);
    const unsigned gen = old / nloc;
    if (old + 1u == (gen + 1u) * nloc) {
      __builtin_amdgcn_fence(__ATOMIC_RELEASE, "agent");
      asm volatile("s_waitcnt vmcnt(0)" ::: "memory");
      const unsigned og = xb_add(&bar[XB_TOP], 1u);
      const unsigned tg = og / nx;
      if (og + 1u == (tg + 1u) * nx) xb_add(&bar[XB_TOPGEN], 1u);
      else XB_SPIN(xb_ld(&bar[XB_TOPGEN]) == tg, bar);
      __builtin_amdgcn_fence(__ATOMIC_ACQUIRE, "agent");
      xb_add(&bar[XB_XGEN(x)], 1u);
      asm volatile("s_waitcnt vmcnt(0)" ::: "memory");
    } else {
      XB_SPIN(xb_ld(&bar[XB_XGEN(x)]) == gen, bar);
      __builtin_amdgcn_fence(__ATOMIC_ACQUIRE, "agent");
      asm volatile("s_waitcnt vmcnt(0)" ::: "memory");
    }
  }
  __syncthreads();
}


template <int PH>
__device__ __forceinline__ void run_phase(const Params& p, bf16_t* shm_) {
  float* smf = (float*)shm_;
  LAS unsigned char* shm = (LAS unsigned char*)shm_;
  const size_t MR = (size_t)M_ALL;
  bf16_t* G = (bf16_t*)p.R;
  bf16_t* P = (bf16_t*)p.R;
  bf16_t* Qall = P + MR * 2048;
  bf16_t* Kall = Qall + (size_t)32 * NKEY * 96;
  bf16_t* Vt = Kall + (size_t)32 * NKEY * 96;
  bf16_t* Qh = (bf16_t*)p.R;
  bf16_t* Vv = Qh + MR * DM;
  bf16_t* Gg = Vv + MR * DM;
  _Float16* Lf = (_Float16*)(Gg + MR * DM);
  _Float16* Lb = Lf + MR * DM;
  const size_t MODL = (size_t)5 * 9216;
  float* PARTF = (float*)(G + MR * DFF);
  float* PARTE = (float*)(Vt + (size_t)32 * 64 * NKEY);
  const float* CG = p.mod + (size_t)4 * 9 * 1024;
  if constexpr (PH == 0) phase_prep(p, smf);
  if constexpr (PH == 1) phase_norm(p, 0, 0, p.ctx, p.x, 0);
  if constexpr (PH == 2) gemm_phase(p.U, DM, p.W13[0], DM, DM, 0, 132, 0, 22, EpiSwiglu{G}, shm);
  if constexpr (PH == 3) gemm_phase(G, DFF, p.W2[0], DFF, DFF, 4, 128, 0, 4, EpiResid{p.ctx, p.x, p.XC, p.out, p.mod + 2 * 1024, 0.5f}, shm, 4, 11, EpiPart{PARTF});
  if constexpr (PH == 4) phase_norm(p, 0, 1, p.ctx, p.out, 0, PARTF, 11, 0.5f, CG + 2 * 1024);
  if constexpr (PH == 5) gemm_phase(p.U, DM, p.WinE, DM, DM, 0, 132, 0, 8, EpiP{P, p.RS}, shm);
  if constexpr (PH == 6) { gemm_phase(P + 1536, 2048, p.Wqkv, 2048, 384, 0, 132, 0, 7, EpiQKV{EpiQ{p.RS, p.rope, Qall}, EpiKV{p.RS, Kall, Vt}}, shm);
                           phase_even_elem(p, P, p.U, Kall); }
  if constexpr (PH == 7) phase_attn<false>(p, Qall, Kall, Vt, p.U, shm);
  if constexpr (PH == 25) phase_attn<true>(p, Qall, Kall, Vt, p.U, shm);
  if constexpr (PH == 8) gemm_phase(p.U, DM, p.WoutE, DM, DM, 4, 128, 0, 4, EpiResid{p.XC, p.out, p.XC, p.out, p.mod + 5 * 1024, 1.0f}, shm, 4, 4, EpiPart{PARTE});
  if constexpr (PH == 9) phase_norm(p, 0, 2, p.XC, p.out, 0, PARTE, 4, 1.0f, CG + 5 * 1024);
  if constexpr (PH == 10) gemm_phase(p.U, DM, p.W13[1], DM, DM, 0, 132, 0, 22, EpiSwiglu{G}, shm);
  if constexpr (PH == 11) gemm_phase(G, DFF, p.W2[1], DFF, DFF, 4, 128, 0, 4, EpiResid{p.XC, p.out, p.XC, p.out, p.mod + 8 * 1024, 0.5f}, shm, 4, 11, EpiPart{PARTF});
  if constexpr (PH == 12) phase_norm(p, 1, 0, p.XC, p.out, 0, PARTF, 11, 0.5f, CG + 8 * 1024);
  if constexpr (PH == 13) gemm_phase(p.U, DM, p.W13[2], DM, DM, 0, 132, 0, 22, EpiSwiglu{G}, shm);
  if constexpr (PH == 14) gemm_phase(G, DFF, p.W2[2], DFF, DFF, 4, 128, 0, 4, EpiResid{p.XC, p.out, p.XC, p.out, p.mod + MODL + 2 * 1024, 0.5f}, shm, 4, 11, EpiPart{PARTF});
  if constexpr (PH == 15) phase_norm(p, 1, 1, p.XC, p.out, 0, PARTF, 11, 0.5f, CG + MODL + 2 * 1024);
  if constexpr (PH == 16) gemm_phase(p.U, DM, p.WinO, DM, DM, 0, 132, 0, 20, EpiOdd{Qh, Vv, Gg, Lf, Lb, p.lb_logits}, shm);
  bf16_t* Ob = (bf16_t*)(Lb + MR * DM);
  float* Sseg = (float*)(Ob + (size_t)32768 * DM);
  float* Dlg = Sseg + (size_t)192 * 16384;
  if constexpr (PH == 17) phase_hgrn<false>(p, Qh, Vv, Lf, p.U, Ob, Sseg, Dlg, shm);
  if constexpr (PH == 18) phase_hgrn<true>(p, Qh, Vv, Lf, p.U, Ob, Sseg, Dlg, shm);
  if constexpr (PH == 24) phase_hgrn_readout(p, p.U, Ob, Gg);
  if constexpr (PH == 19) gemm_phase(p.U, DM, p.WoutO, DM, DM, 4, 128, 0, 4, EpiResid{p.XC, p.out, p.XC, p.out, p.mod + MODL + 5 * 1024, 1.0f}, shm);
  if constexpr (PH == 20) phase_norm(p, 1, 2, p.XC, p.out, NCTX);
  if constexpr (PH == 21) gemm_phase(p.U, DM, p.W13[3], DM, DM, 4, 128, 0, 22, EpiSwiglu{G}, shm);
  if constexpr (PH == 22) gemm_phase(G, DFF, p.W2[3], DFF, DFF, 4, 128, 0, 4, EpiResid{p.XC, p.out, p.XC, p.out, p.mod + MODL + 8 * 1024, 0.5f}, shm);
  if constexpr (PH == 23) phase_final_norm(p);
}

constexpr int N_PHASES = 24;

#define PROBE_DUP -1
template <int PH>
__device__ __forceinline__ void step(const Params& p, int ph0, int ph1, bf16_t* shm) {
  if ((ph0 <= PH && PH < ph1) || (PH >= 24 && ph1 - ph0 > 1)) {
    run_phase<PH>(p, shm);
    if constexpr (PH == PROBE_DUP) { xcd_barrier(p.bar, (volatile LAS unsigned*)((LAS unsigned char*)shm + SHM_B)); run_phase<PH>(p, shm); }
    if (PH != 23 && ph1 - ph0 > 1) xcd_barrier(p.bar, (volatile LAS unsigned*)((LAS unsigned char*)shm + SHM_B));
  }
}

__global__ void __launch_bounds__(NTHR, 2) mega(Params p, int ph0, int ph1) {
  extern __shared__ __attribute__((aligned(16))) bf16_t shm[];
  if (ph1 < 0) cg::this_grid().sync();
  {
    volatile LAS unsigned* st = (volatile LAS unsigned*)((LAS unsigned char*)shm + SHM_B);
    if (threadIdx.x == 0) { st[0] = 0u; st[1] = 0u; }
    __syncthreads();
    if (threadIdx.x == 0) (void)xb_add(&p.bar[XB_XCNT(xb_xcc_id())], 1u);
  }
  step<0>(p, ph0, ph1, shm); step<1>(p, ph0, ph1, shm); step<2>(p, ph0, ph1, shm); step<3>(p, ph0, ph1, shm);
  step<4>(p, ph0, ph1, shm); step<5>(p, ph0, ph1, shm); step<6>(p, ph0, ph1, shm); step<7>(p, ph0, ph1, shm); step<25>(p, ph0, ph1, shm);
  step<8>(p, ph0, ph1, shm); step<9>(p, ph0, ph1, shm); step<10>(p, ph0, ph1, shm); step<11>(p, ph0, ph1, shm);
  step<12>(p, ph0, ph1, shm); step<13>(p, ph0, ph1, shm); step<14>(p, ph0, ph1, shm); step<15>(p, ph0, ph1, shm);
  step<16>(p, ph0, ph1, shm); step<17>(p, ph0, ph1, shm); step<18>(p, ph0, ph1, shm); step<24>(p, ph0, ph1, shm); step<19>(p, ph0, ph1, shm);
  step<20>(p, ph0, ph1, shm); step<21>(p, ph0, ph1, shm); step<22>(p, ph0, ph1, shm); step<23>(p, ph0, ph1, shm);
}

extern "C" void kernel_launch(void* const* d_in, const int* in_sizes, int n_in, void* d_out, int out_size, void* d_ws, size_t ws_size,
                              hipStream_t stream) {
  Params p{};
  const float** f = (const float**)&p;
  for (int i = 0; i < 22; ++i) f[i] = (const float*)d_in[i];
  p.out = (float*)d_out;
  char* w = (char*)d_ws; size_t off = 0;
  auto take = [&](size_t bytes) { char* r = w + off; off += (bytes + 255) & ~(size_t)255; return r; };
  p.W13[3] = (bf16_t*)take((size_t)2 * DFF * DM * 2);
  p.W2[3] = (bf16_t*)take((size_t)DM * DFF * 2);
  p.WinO = (bf16_t*)take((size_t)5120 * 1024 * 2);
  p.WoutO = (bf16_t*)take((size_t)1024 * 1024 * 2);
  p.mod = (float*)take((size_t)2 * 5 * 9216 * 4);
  p.XC = (float*)take((size_t)NCTX * DM * 4);
  p.RS = (float*)take((size_t)M_ALL * 2 * 4);
  p.rope = (float*)take((size_t)8192 * 32 * 4);
  p.bar = (unsigned*)take((size_t)XCD_BAR_WORDS * 4);
  p.aflag = (unsigned*)take((size_t)1024 * 4);
  p.U = (bf16_t*)take((size_t)M_ALL * DM * 2);
  p.R = take(0);
  {
    const size_t early = (size_t)3 * (2 * DFF * DM * 2) + (size_t)3 * (DM * DFF * 2) + (size_t)2048 * 1024 * 2 + (size_t)1792 * 2048 * 2 + (size_t)1024 * 1024 * 2;
    size_t e0 = (ws_size - early) & ~(size_t)255;
    const size_t rbytes = e0 - off;
    if (rbytes < (size_t)M_ALL * DM * 2 * 5 || ws_size - off < (size_t)M_ALL * DM * 2 * 5 + (size_t)32768 * DM * 2)
      fprintf(stderr, "workspace too small: R=%zu ws=%zu\n", rbytes, ws_size);
    if (ws_size - off < (size_t)M_ALL * DM * 2 * 5 + (size_t)32768 * DM * 2 + (size_t)192 * 16384 * 4 + 192 * 128 * 4) fprintf(stderr, "workspace too small for Sseg\n");
    off = e0;
    for (int i = 0; i < 3; ++i) p.W13[i] = (bf16_t*)take((size_t)2 * DFF * DM * 2);
    for (int i = 0; i < 3; ++i) p.W2[i] = (bf16_t*)take((size_t)DM * DFF * 2);
    p.WinE = (bf16_t*)take((size_t)2048 * 1024 * 2);
    p.Wqkv = (bf16_t*)take((size_t)1792 * 2048 * 2);
    p.WoutE = (bf16_t*)take((size_t)1024 * 1024 * 2);
  }
  static bool attr_done = false;
  if (!attr_done) { (void)hipFuncSetAttribute((const void*)mega, hipFuncAttributeMaxDynamicSharedMemorySize, SHM_B + 256); attr_done = true; }
#if 0
  for (int ph = 0; ph < N_PHASES; ++ph) {
    hipLaunchKernelGGL(mega, dim3(256), dim3(NTHR), SHM_B, stream, p, ph, ph + 1);
  }
#else
  static int grid_blocks = 0;
  if (!grid_blocks) {
    int dev = 0, cus = 0, per_cu = 0;
    hipGetDevice(&dev);
    hipDeviceGetAttribute(&cus, hipDeviceAttributeMultiprocessorCount, dev);
    hipOccupancyMaxActiveBlocksPerMultiprocessor(&per_cu, mega, NTHR, SHM_B + 256);
    if (per_cu > 1) per_cu = 1;
    grid_blocks = cus * per_cu;
  }
  int ph0 = 0, ph1 = N_PHASES;
  void* args[] = {&p, &ph0, &ph1};
  (void)hipMemsetAsync(p.bar, 0, (size_t)XCD_BAR_WORDS * 4, stream);
  hipError_t e = hipLaunchCooperativeKernel((void*)mega, dim3(grid_blocks), dim3(NTHR), args, SHM_B + 256, stream);
  if (e != hipSuccess) fprintf(stderr, "cooperative launch failed: %s (grid %d)\n", hipGetErrorString(e), grid_blocks);
#endif
}
```

```cpp
#include <hip/hip_runtime.h>
#include <hip/hip_cooperative_groups.h>
#include <cstdio>
namespace cg = cooperative_groups;

typedef unsigned short bf16_t;
typedef short bf16x8 __attribute__((ext_vector_type(8)));
typedef float f32x4 __attribute__((ext_vector_type(4)));
typedef unsigned u32x2 __attribute__((ext_vector_type(2)));
typedef unsigned u32x4 __attribute__((ext_vector_type(4)));
typedef _Float16 h16x4 __attribute__((ext_vector_type(4)));
typedef _Float16 h16x8 __attribute__((ext_vector_type(8)));

constexpr int M_ALL = 33792;
constexpr int NCTX = 1024;
constexpr int DM = 1024;
constexpr int DFF = 2816;
constexpr int NKEY = 8448;
constexpr int NTHR = 512;
constexpr float QSCALE = 0.10206207261596577f * 1.4426950408889634f;
constexpr float HSCALE = 0.08838834764831845f;

struct Params {
  const float *x, *c, *ctx, *c_ctx, *ada_w, *ada_b, *norm_g, *ffn_w1, *ffn_w3, *ffn_w2, *even_w_in, *even_conv_w,
      *q_norm_g, *w_uq, *kv_norm_g, *w_ukv, *even_w_out, *odd_w_in, *lb_logits, *g_norm_g, *odd_w_out, *final_norm_g;
  float* out;
  bf16_t *W13[4], *W2[4], *WinE, *Wqkv, *WoutE, *WinO, *WoutO;
  float *mod, *XC, *RS, *rope;
  unsigned* bar;
  unsigned* aflag;
  bf16_t* U;
  char* R;
};

__device__ __forceinline__ float bf2f(bf16_t v) { return __uint_as_float(((unsigned)v) << 16); }
typedef float f32x2 __attribute__((ext_vector_type(2)));
typedef __bf16 bf16v2 __attribute__((ext_vector_type(2)));
__device__ __forceinline__ unsigned pk2(float lo, float hi) { f32x2 v = {lo, hi}; return __builtin_bit_cast(unsigned, __builtin_convertvector(v, bf16v2)); }
__device__ __forceinline__ bf16_t f2bf(float f) { return (bf16_t)(pk2(f, 0.f) & 0xffffu); }
__device__ __forceinline__ float lo2f(unsigned u) { return __uint_as_float(u << 16); }
__device__ __forceinline__ float hi2f(unsigned u) { return __uint_as_float(u & 0xffff0000u); }
__device__ __forceinline__ float wave_sum(float v) {
#pragma unroll
  for (int o = 32; o > 0; o >>= 1) v += __shfl_xor(v, o);
  return v;
}
__device__ __forceinline__ float sigmoidf_(float a) { return __builtin_amdgcn_rcpf(1.f + __expf(-a)); }
__device__ __forceinline__ int row_mi(int r) { return r < NCTX ? 4 : ((r - NCTX) >> 13); }
__device__ __forceinline__ void row_bk(int r, int& b, int& key) {
  if (r < NCTX) { b = r >> 8; key = r & 255; } else { int rr = r - NCTX; b = rr >> 13; key = 256 + (rr & 8191); }
}

constexpr int BM = 256, BK = 64, HALF = 128, NXCD = 8, WGM = 8, HT = HALF * BK, SHM_B = 8 * HT * 2;

__device__ __forceinline__ int lds_byte(int r, int c) {
  int st = (r >> 4) * 2 + (c >> 5), rr = r & 15, cc = c & 31, ob = rr * 64 + cc * 2;
  return st * 1024 + (ob ^ (((ob >> 9) & 1) << 5));
}
__device__ __forceinline__ void stage_rc(int b, int& R, int& C) {
  int st = b / 1024, sb = b % 1024, swz = sb ^ (((sb >> 9) & 1) << 5);
  R = (st >> 1) * 16 + swz / 64; C = (st & 1) * 32 + (swz % 64) / 2;
}

#define NO_EPI_DRAIN 1
#define LAS __attribute__((address_space(3)))
struct EpiNone { static constexpr bool HALFOK = false; __device__ __forceinline__ void operator()(const f32x4 (&)[2][2][4][2], int, int, int, int, int, int, int) const {} };
template <class Epi, class Epi2 = EpiNone>
__device__ __forceinline__ void gemm_phase(const bf16_t* A, int lda, const bf16_t* Bt, int ldb, int K, int pm0, int nM, int pn0, int nN,
                                           const Epi& epi, LAS unsigned char* lds, int nsm = 0, int ksl = 1, const Epi2& epi2 = Epi2()) {
  const int tid = threadIdx.x, wid = __builtin_amdgcn_readfirstlane(tid >> 6), lane = tid & 63, wr = wid >> 2, wc = wid & 3, fr = lane & 15, fq = lane >> 4;
  const int nt = K / BK;
  const int nwg = nM * nN, G = gridDim.x;
  const int nsplit = nsm * nN * ksl, nts = nt / ksl;
  if ((int)blockIdx.x >= nwg + nsplit) return;
  const int Rfull = nwg / G, Lleft = nwg - Rfull * G;
  const bool tail_split = Epi::HALFOK && nsm == 0 && Lleft > 0 && 2 * Lleft <= G;
  unsigned voffA[2], voffB[2];
#pragma unroll
  for (int i = 0; i < 2; ++i) { int R, C; stage_rc(tid * 16 + i * 8192, R, C); voffA[i] = (unsigned)(R * lda + C) * 2u; voffB[i] = (unsigned)(R * ldb + C) * 2u; }
  const size_t kstep = (size_t)(BK * 2);
  const size_t hstepA = (size_t)HALF * lda * 2, hstepB = (size_t)HALF * ldb * 2;
  const unsigned ldsw = (unsigned)wid * 1024u;
  const int aoff = lds_byte(wr * 64 + fr, fq * 8), boff = lds_byte(wc * 32 + fr, fq * 8);
#define G_SA(b, h) (((b) * 2 + (h)) * (HT * 2))
#define G_SB(b, h) ((4 + (b) * 2 + (h)) * (HT * 2))
#define G_STAGE(bufoff, gbase, voff) do { _Pragma("unroll") for (int _i = 0; _i < 2; ++_i) \
    __builtin_amdgcn_global_load_lds((const unsigned*)((const char*)(gbase) + (voff)[_i]), (LAS unsigned*)(lds + (bufoff) + ldsw + _i * 8192), 16, 0, 0); } while (0)
#define G_LDA(dst, b, h) do { _Pragma("unroll") for (int m = 0; m < 4; ++m) _Pragma("unroll") for (int k = 0; k < 2; ++k) dst[m][k] = *(const LAS bf16x8*)(lds + G_SA(b, h) + aoff + m * 2048 + k * 1024); } while (0)
#define G_LDB(dst, b, h) do { _Pragma("unroll") for (int n = 0; n < 2; ++n) _Pragma("unroll") for (int k = 0; k < 2; ++k) dst[n][k] = *(const LAS bf16x8*)(lds + G_SB(b, h) + boff + n * 2048 + k * 1024); } while (0)
#define G_MMA(ai, bj, At, Bx) do { __builtin_amdgcn_s_setprio(1); _Pragma("unroll") for (int m = 0; m < 4; ++m) _Pragma("unroll") for (int n = 0; n < 2; ++n) _Pragma("unroll") for (int k = 0; k < 2; ++k) \
    acc[ai][bj][m][n] = __builtin_amdgcn_mfma_f32_16x16x32_bf16(Bx[n][k], At[m][k], acc[ai][bj][m][n], 0, 0, 0); __builtin_amdgcn_s_setprio(0); } while (0)
#define WAIT_V(n) asm volatile("s_waitcnt vmcnt(" #n ")" ::: "memory")
#define WAIT_L(n) asm volatile("s_waitcnt lgkmcnt(" #n ")" ::: "memory")
#define BAR __builtin_amdgcn_s_barrier()
#define SCHED __builtin_amdgcn_sched_barrier(0)
  auto unit = [&](int i, int& pm, int& pn, int& sl, int& hf) -> bool {
    long L = (long)i * G + blockIdx.x; sl = -1; hf = -1;
    if (tail_split && i >= Rfull) { if (i > Rfull || (int)blockIdx.x >= 2 * Lleft) return false; L = (long)Rfull * G + (blockIdx.x >> 1); hf = blockIdx.x & 1; }
    if (L >= nwg) { const int j = (int)(L - nwg); if (j >= nsplit) return false; sl = j % ksl; const int tile = j / ksl; pm = tile / nN; pn = pn0 + tile % nN; return true; }
    int wgid = (int)L; { const int q = nwg / NXCD, r = nwg % NXCD, xcd = wgid % NXCD, off = wgid / NXCD; wgid = (xcd < r ? xcd * (q + 1) : r * (q + 1) + (xcd - r) * q) + off; }
    const int nig = WGM * nN, gid = wgid / nig, fm = gid * WGM, gsz = (nM - fm) < WGM ? (nM - fm) : WGM;
    pm = pm0 + fm + ((wgid % nig) % gsz); pn = pn0 + (wgid % nig) / gsz; return true;
  };
  int cpm, cpn, csl, chf, npm = 0, npn = 0, nsl = -1, nhf = -1, ui = 0;
  unit(0, cpm, cpn, csl, chf);
  f32x4 acc[2][2][4][2];
#pragma unroll
  for (int a = 0; a < 2; ++a)
#pragma unroll
    for (int b = 0; b < 2; ++b)
#pragma unroll
      for (int m = 0; m < 4; ++m)
#pragma unroll
        for (int n = 0; n < 2; ++n) acc[a][b][m][n] = (f32x4){0.f, 0.f, 0.f, 0.f};
  bf16x8 At[4][2], B0[2][2], B1[2][2];
  const char* cA = (const char*)A + (size_t)cpm * 2 * hstepA + (csl < 0 ? 0 : (size_t)csl * nts * kstep) + (chf > 0 ? hstepA : 0);
  size_t chA = chf < 0 ? hstepA : 0, nhA = hstepA;
  const char* cB = (const char*)Bt + (size_t)cpn * 2 * hstepB + (csl < 0 ? 0 : (size_t)csl * nts * kstep);
  G_STAGE(G_SB(0, 0), cB, voffB); G_STAGE(G_SA(0, 0), cA, voffA); G_STAGE(G_SB(0, 1), cB + hstepB, voffB); G_STAGE(G_SA(0, 1), cA + chA, voffA);
  if (wr == 1) BAR;
  WAIT_V(4); BAR;
  G_STAGE(G_SB(1, 0), cB + kstep, voffB); G_STAGE(G_SA(1, 0), cA + kstep, voffA); G_STAGE(G_SB(1, 1), cB + hstepB + kstep, voffB);
  WAIT_V(6); BAR;
#define G_KLOOP(AI1) \
    _Pragma("nounroll") \
    for (int t = 0; t < cnt; t += 2) { \
      const bool last = (t == cnt - 2); \
      const char* a1 = cA + (size_t)(t + 1) * kstep; \
      const char* a2 = last ? nA : cA + (size_t)(t + 2) * kstep; const char* b2 = last ? nB : cB + (size_t)(t + 2) * kstep; \
      const char* a3 = a2 + kstep; const char* b3 = b2 + kstep; \
      G_LDB(B0, 0, 0); SCHED; G_LDA(At, 0, 0); G_STAGE(G_SA(1, 1), a1 + chA, voffA); \
      WAIT_L(8); BAR; WAIT_L(0); G_MMA(0, 0, At, B0); BAR; SCHED; \
      G_LDB(B1, 0, 1); G_STAGE(G_SB(0, 0), b2, voffB); \
      BAR; WAIT_L(0); G_MMA(0, 1, At, B1); BAR; \
      G_LDA(At, 0, 1); G_STAGE(G_SA(0, 0), a2, voffA); \
      BAR; WAIT_L(0); if (AI1) G_MMA(1, 0, At, B0); BAR; SCHED; \
      G_STAGE(G_SB(0, 1), b2 + hstepB, voffB); \
      WAIT_V(6); BAR; if (AI1) G_MMA(1, 1, At, B1); BAR; \
      G_LDB(B0, 1, 0); SCHED; G_LDA(At, 1, 0); G_STAGE(G_SA(0, 1), a2 + (last ? nhA : chA), voffA); \
      WAIT_L(8); BAR; WAIT_L(0); G_MMA(0, 0, At, B0); BAR; SCHED; \
      G_LDB(B1, 1, 1); G_STAGE(G_SB(1, 0), b3, voffB); \
      BAR; WAIT_L(0); G_MMA(0, 1, At, B1); BAR; \
      G_LDA(At, 1, 1); G_STAGE(G_SA(1, 0), a3, voffA); \
      BAR; WAIT_L(0); if (AI1) G_MMA(1, 0, At, B0); BAR; SCHED; \
      G_STAGE(G_SB(1, 1), b3 + hstepB, voffB); \
      WAIT_V(6); BAR; if (AI1) G_MMA(1, 1, At, B1); BAR; \
    }
  bool pending_half = false;
  for (;;) {
    const bool has_next = unit(ui + 1, npm, npn, nsl, nhf);
    const char* nA = has_next ? (const char*)A + (size_t)npm * 2 * hstepA + (nsl < 0 ? 0 : (size_t)nsl * nts * kstep) + (nhf > 0 ? hstepA : 0) : cA;
    const char* nB = has_next ? (const char*)Bt + (size_t)npn * 2 * hstepB + (nsl < 0 ? 0 : (size_t)nsl * nts * kstep) : cB;
    nhA = has_next ? (nhf < 0 ? hstepA : 0) : chA;
    const int cnt = csl < 0 ? nt : nts;
    G_KLOOP(1)
    if (csl < 0) {
      if constexpr (Epi::HALFOK) epi(acc, cpm * BM, cpn * BM, wr, wc, fr, fq, 2);
      else epi(acc, cpm * BM, cpn * BM, wr, wc, fr, fq);
    } else epi2(acc, cpm * BM, cpn * BM, wr, wc, fr, fq, csl);
#ifndef NO_EPI_DRAIN
    WAIT_V(0);
#endif
    if (!has_next) break;
#pragma unroll
    for (int a = 0; a < 2; ++a)
#pragma unroll
      for (int b = 0; b < 2; ++b)
#pragma unroll
        for (int m = 0; m < 4; ++m)
#pragma unroll
          for (int n = 0; n < 2; ++n) acc[a][b][m][n] = (f32x4){0.f, 0.f, 0.f, 0.f};
    cpm = npm; cpn = npn; csl = nsl; chf = nhf; chA = nhA; cA = nA; cB = nB; ++ui;
    if (chf >= 0) { pending_half = true; break; }
  }
  if constexpr (Epi::HALFOK) {
    if (pending_half) {
      const char* nA = cA; const char* nB = cB; nhA = chA;
      const int cnt = nt;
      G_KLOOP(0)
      epi(acc, cpm * BM + (chf > 0 ? HALF : 0), cpn * BM, wr, wc, fr, fq, 1);
    }
  }
#undef G_KLOOP
  WAIT_V(0);
  if (wr == 0) BAR;
  BAR;
}

typedef f32x4 Acc[2][2][4][2];

struct EpiSwiglu { static constexpr bool HALFOK = true;
  bf16_t* G;
  __device__ __forceinline__ void operator()(const Acc& acc, int brow, int bcol, int wr, int wc, int fr, int fq, int nai) const {
    const int f0 = (bcol >> 1) + 32 * wc + 8 * fq;
    asm volatile("s_waitcnt vmcnt(14)" ::: "memory");
#pragma unroll
    for (int ai = 0; ai < 2; ++ai)
#pragma unroll
      for (int m = 0; m < 4; ++m) if (ai < nai) {
        const int r = brow + 128 * ai + 64 * wr + 16 * m + fr;
        u32x4 o;
#pragma unroll
        for (int bj = 0; bj < 2; ++bj) {
          const f32x4 a = acc[ai][bj][m][0], b = acc[ai][bj][m][1];
          const float g0 = a[0] * sigmoidf_(a[0]) * b[0], g1 = a[1] * sigmoidf_(a[1]) * b[1];
          const float g2 = a[2] * sigmoidf_(a[2]) * b[2], g3 = a[3] * sigmoidf_(a[3]) * b[3];
          if (bj == 0) { o.x = pk2(g0, g1); o.y = pk2(g2, g3); } else { o.z = pk2(g0, g1); o.w = pk2(g2, g3); }
        }
        *(u32x4*)(G + (size_t)r * DFF + f0) = o;
      }
  }
};

struct EpiResid { static constexpr bool HALFOK = false;
  const float *srcC, *srcL; float *dstC, *dstL; const float* gate;   float coef;
  __device__ __forceinline__ void operator()(const Acc& acc, int brow, int bcol, int wr, int wc, int fr, int fq) const {
    const float* g = gate + (size_t)row_mi(brow) * 9 * DM + bcol + 32 * wc + 4 * fq;
    f32x4 gv[2][2];
#pragma unroll
    for (int bj = 0; bj < 2; ++bj)
#pragma unroll
      for (int n = 0; n < 2; ++n) gv[bj][n] = coef * *(const f32x4*)(g + 128 * bj + 16 * n);
    const size_t rb = (size_t)(brow - NCTX + 64 * wr + fr) * DM + bcol + 32 * wc + 4 * fq;
#pragma unroll
    for (int ai = 0; ai < 2; ++ai)
#pragma unroll
      for (int mp = 0; mp < 2; ++mp) {
        f32x4 xv[2][2][2];
#pragma unroll
        for (int mm = 0; mm < 2; ++mm)
#pragma unroll
          for (int bj = 0; bj < 2; ++bj)
#pragma unroll
            for (int n = 0; n < 2; ++n)
              xv[mm][bj][n] = *(const f32x4*)(srcL + rb + (size_t)(128 * ai + 16 * (2 * mp + mm)) * DM + 128 * bj + 16 * n);
#pragma unroll
        for (int mm = 0; mm < 2; ++mm)
#pragma unroll
          for (int bj = 0; bj < 2; ++bj)
#pragma unroll
            for (int n = 0; n < 2; ++n)
              *(f32x4*)(dstL + rb + (size_t)(128 * ai + 16 * (2 * mp + mm)) * DM + 128 * bj + 16 * n) = xv[mm][bj][n] + gv[bj][n] * acc[ai][bj][2 * mp + mm][n];
      }
  }
};

struct EpiPart { static constexpr bool HALFOK = false;
  float* PART;
  __device__ __forceinline__ void operator()(const Acc& acc, int brow, int bcol, int wr, int wc, int fr, int fq, int sl) const {
#pragma unroll
    for (int ai = 0; ai < 2; ++ai)
#pragma unroll
      for (int m = 0; m < 4; ++m) {
        const int r = brow + 128 * ai + 64 * wr + 16 * m + fr;
        float* d = PART + ((size_t)sl * NCTX + r) * DM;
#pragma unroll
        for (int bj = 0; bj < 2; ++bj)
#pragma unroll
          for (int n = 0; n < 2; ++n) *(f32x4*)(d + bcol + 128 * bj + 32 * wc + 16 * n + 4 * fq) = acc[ai][bj][m][n];
      }
  }
};

struct EpiBf16 { static constexpr bool HALFOK = false;
  bf16_t* O; int ldc;
  __device__ __forceinline__ void operator()(const Acc& acc, int brow, int bcol, int wr, int wc, int fr, int fq) const {
#pragma unroll
    for (int ai = 0; ai < 2; ++ai)
#pragma unroll
      for (int m = 0; m < 4; ++m) {
        const int r = brow + 128 * ai + 64 * wr + 16 * m + fr;
#pragma unroll
        for (int bj = 0; bj < 2; ++bj)
#pragma unroll
          for (int n = 0; n < 2; ++n) {
            const int c = bcol + 128 * bj + 32 * wc + 16 * n + 4 * fq;
            f32x4 v = acc[ai][bj][m][n];
            u32x2 o; o.x = pk2(v[0], v[1]); o.y = pk2(v[2], v[3]);
            *(u32x2*)(O + (size_t)r * ldc + c) = o;
          }
      }
  }
};

struct EpiP { static constexpr bool HALFOK = true;
  bf16_t* O; float* RS;
  __device__ __forceinline__ void operator()(const Acc& acc, int brow, int bcol, int wr, int wc, int fr, int fq, int nai) const {
    asm volatile("s_waitcnt vmcnt(14)" ::: "memory");
#pragma unroll
    for (int ai = 0; ai < 2; ++ai)
#pragma unroll
      for (int m = 0; m < 4; ++m) if (ai < nai) {
        const int r = brow + 128 * ai + 64 * wr + 16 * m + fr;
        float ss0 = 0.f, ss1 = 0.f;
#pragma unroll
        for (int bj = 0; bj < 2; ++bj) {
          const int c = bcol + 128 * bj + 32 * wc + 8 * fq;
          const f32x4 v0 = acc[ai][bj][m][0], v1 = acc[ai][bj][m][1];
          const float q = v0[0] * v0[0] + v0[1] * v0[1] + v0[2] * v0[2] + v0[3] * v0[3] + v1[0] * v1[0] + v1[1] * v1[1] + v1[2] * v1[2] + v1[3] * v1[3];
          if (bj == 0) ss0 += q; else ss1 += q;
          u32x4 o; o.x = pk2(v0[0], v0[1]); o.y = pk2(v0[2], v0[3]); o.z = pk2(v1[0], v1[1]); o.w = pk2(v1[2], v1[3]);
          *(u32x4*)(O + (size_t)r * 2048 + c) = o;
        }
        if (bcol == 1536) {
          float ss = ss0 + ss1; ss += __shfl_xor(ss, 16); ss += __shfl_xor(ss, 32);
          if (fq == 0) atomicAdd(RS + 2 * r, ss);
        } else if (bcol == 1792) {
          float ss = ss0; ss += __shfl_xor(ss, 16); ss += __shfl_xor(ss, 32);
          if (fq == 0) atomicAdd(RS + 2 * r + 1, ss);
        }
      }
  }
};

struct EpiQ { static constexpr bool HALFOK = false;
  const float* RS; const float* rope;   bf16_t* Qall;
  __device__ __forceinline__ void operator()(const Acc& acc, int brow, int bcol, int wr, int wc, int fr, int fq) const {
#pragma unroll
    for (int ai = 0; ai < 2; ++ai)
#pragma unroll
      for (int m = 0; m < 4; ++m) {
        const int r = brow + 128 * ai + 64 * wr + 16 * m + fr;
        const float rstd = rsqrtf(RS[2 * r] * (1.f / 256.f) + 1e-6f) * QSCALE;
        int b, key; row_bk(r, b, key);
        const bool latent = r >= NCTX;
        const int t = (r - NCTX) & 8191;
        bf16_t* qrow = Qall + ((size_t)(b * 8) * NKEY + key) * 96 + 4 * fq;
#pragma unroll
        for (int bj = 0; bj < 2; ++bj) {
          const int c32 = bcol + 128 * bj + 32 * wc;
          const int h = c32 / 96, d32 = c32 - 96 * h;
#pragma unroll
          for (int n = 0; n < 2; ++n) {
            f32x4 v = acc[ai][bj][m][n] * rstd;
            if (d32 == 64) {
              f32x4 pv;
#pragma unroll
              for (int j = 0; j < 4; ++j) pv[j] = __shfl_xor(v[j], 32);
              if (latent) {
                const float* rp = rope + ((size_t)t * 2 + n) * 16 + 4 * (fq & 1);
                const f32x4 cs = *(const f32x4*)rp, sn = *(const f32x4*)(rp + 8);
                v = (fq < 2) ? (v * cs - pv * sn) : (pv * sn + v * cs);
              }
            }
            u32x2 o; o.x = pk2(v[0], v[1]); o.y = pk2(v[2], v[3]);
            *(u32x2*)(qrow + (size_t)h * (NKEY * 96) + d32 + 16 * n) = o;
          }
        }
      }
  }
};
struct EpiKV { static constexpr bool HALFOK = false;
  const float* RS; bf16_t *Kall, *Vt;
  __device__ __forceinline__ void operator()(const Acc& acc, int brow, int bcol, int wr, int wc, int fr, int fq) const {
#pragma unroll
    for (int ai = 0; ai < 2; ++ai)
#pragma unroll
      for (int m = 0; m < 4; ++m) {
        const int r = brow + 128 * ai + 64 * wr + 16 * m + fr;
        const float rstd = rsqrtf(RS[2 * r + 1] * (1.f / 128.f) + 1e-6f);
        int b, key; row_bk(r, b, key);
        bf16_t* krow = Kall + ((size_t)(b * 8) * NKEY + key) * 96 + 4 * fq;
        bf16_t* vrow = Vt + (size_t)(b * 8) * 64 * NKEY + key + (size_t)(4 * fq) * NKEY;
#pragma unroll
        for (int bj = 0; bj < 2; ++bj) {
          const int cc = bcol - 768 + 128 * bj + 32 * wc, h = cc >> 7, e32 = cc & 127;
#pragma unroll
          for (int n = 0; n < 2; ++n) {
            const f32x4 v = acc[ai][bj][m][n] * rstd;
            if (e32 < 64) {
              u32x2 o; o.x = pk2(v[0], v[1]); o.y = pk2(v[2], v[3]);
              *(u32x2*)(krow + (size_t)h * (NKEY * 96) + e32 + 16 * n) = o;
            } else {
              bf16_t* vp = vrow + (size_t)(h * 64 + e32 - 64 + 16 * n) * NKEY;
#pragma unroll
              for (int j = 0; j < 4; ++j) vp[(size_t)j * NKEY] = f2bf(v[j]);
            }
          }
        }
      }
  }
};

struct EpiQKV { static constexpr bool HALFOK = false;
  EpiQ q; EpiKV kv;
  __device__ __forceinline__ void operator()(const Acc& acc, int brow, int bcol, int wr, int wc, int fr, int fq) const {
    if (bcol < 768) q(acc, brow, bcol, wr, wc, fr, fq); else kv(acc, brow, bcol, wr, wc, fr, fq);
  }
};

struct EpiOdd { static constexpr bool HALFOK = true;
  bf16_t *Qh, *Vv, *Gg; _Float16 *Lf, *Lb; const float* lbl;
  __device__ __forceinline__ void operator()(const Acc& acc, int brow, int bcol, int wr, int wc, int fr, int fq, int nai) const {
    const int sec = bcol >> 10;
    const int cb = (bcol & 1023) + 32 * wc + 8 * fq;
    asm volatile("s_waitcnt vmcnt(14)" ::: "memory");
    if (sec == 2 || sec == 3) {
      const int dir = sec - 2;
      _Float16* O = Lf + (size_t)dir * ((size_t)M_ALL * DM);
#pragma unroll
      for (int bj = 0; bj < 2; ++bj) {
        const int c = cb + 128 * bj;
        f32x4 lb[2];
#pragma unroll
        for (int n = 0; n < 2; ++n) {
          const f32x4 z0 = *(const f32x4*)(lbl + dir * 1024 + c + 4 * n), z1 = *(const f32x4*)(lbl + 2048 + dir * 1024 + c + 4 * n);
#pragma unroll
          for (int j = 0; j < 4; ++j) lb[n][j] = __builtin_amdgcn_rcpf(1.f + __expf(z0[j] - z1[j]));
        }
#pragma unroll
        for (int ai = 0; ai < 2; ++ai)
#pragma unroll
          for (int m = 0; m < 4; ++m) if (ai < nai) {
            const int r = brow + 128 * ai + 64 * wr + 16 * m + fr;
            h16x8 hv;
#pragma unroll
            for (int n = 0; n < 2; ++n) {
              const f32x4 v = acc[ai][bj][m][n];
#pragma unroll
              for (int j = 0; j < 4; ++j) hv[4 * n + j] = (_Float16)(0.6931471805599453f * __builtin_amdgcn_logf(lb[n][j] + (1.f - lb[n][j]) * sigmoidf_(v[j])));
            }
            *(h16x8*)(O + (size_t)r * DM + c) = hv;
          }
      }
    } else {
      bf16_t* O = Qh + (size_t)(sec == 4 ? 2 : sec) * ((size_t)M_ALL * DM);
      const float sc = sec == 0 ? HSCALE : 1.f;
#pragma unroll
      for (int ai = 0; ai < 2; ++ai)
#pragma unroll
        for (int m = 0; m < 4; ++m) if (ai < nai) {
          const int r = brow + 128 * ai + 64 * wr + 16 * m + fr;
#pragma unroll
          for (int bj = 0; bj < 2; ++bj) {
            const int c = cb + 128 * bj;
            const f32x4 v0 = acc[ai][bj][m][0] * sc, v1 = acc[ai][bj][m][1] * sc;
            u32x4 o; o.x = pk2(v0[0], v0[1]); o.y = pk2(v0[2], v0[3]); o.z = pk2(v1[0], v1[1]); o.w = pk2(v1[2], v1[3]);
            *(u32x4*)(O + (size_t)r * DM + c) = o;
          }
        }
    }
  }
};

__device__ __forceinline__ void tr_tile(const float* src, int ldn, int k0, int n0, int nv, bf16_t* dst, int ldk, int kofs, int mode, const float* kscale, float* sm) {
  const int tid = threadIdx.x;
  float v[8];
#pragma unroll
  for (int i = 0; i < 8; ++i) {
    const int e = tid + i * NTHR, k = e >> 6, n = e & 63;
    v[i] = (n < nv) ? src[(size_t)(k0 + k) * ldn + n0 + n] : 0.f;
  }
#pragma unroll
  for (int i = 0; i < 8; ++i) {
    const int e = tid + i * NTHR, k = e >> 6, n = e & 63;
    sm[k * 65 + n] = kscale ? v[i] * kscale[k0 + k] : v[i];
  }
  __syncthreads();
  {
    const int n = tid >> 3, kq = tid & 7;
    const int ng = n0 + n;
    int drow = ng;
    if (mode == 1 || mode == 2) {
      const int pn = ng >> 7, rem = ng & 127, wc = rem >> 5, r2 = rem & 31, fq = r2 >> 3, bj = (r2 >> 2) & 1, j = r2 & 3;
      drow = 256 * pn + 128 * bj + 32 * wc + 16 * (mode - 1) + 4 * fq + j;
    } else if (mode == 3) {
      const int o = ng & 31, fq = o >> 3, nn = (o >> 2) & 1, j = o & 3;
      drow = (ng & ~31) + 16 * nn + 4 * fq + j;
    }
    if (n < nv) {
      u32x4 o;
      o.x = pk2(sm[(8 * kq + 0) * 65 + n], sm[(8 * kq + 1) * 65 + n]);
      o.y = pk2(sm[(8 * kq + 2) * 65 + n], sm[(8 * kq + 3) * 65 + n]);
      o.z = pk2(sm[(8 * kq + 4) * 65 + n], sm[(8 * kq + 5) * 65 + n]);
      o.w = pk2(sm[(8 * kq + 6) * 65 + n], sm[(8 * kq + 7) * 65 + n]);
      *(u32x4*)(dst + (size_t)drow * ldk + kofs + k0 + 8 * kq) = o;
    }
  }
  __syncthreads();
}

__device__ void phase_prep(const Params& p, float* sm) {
  const int tid = threadIdx.x;
  int base = 0;
  const int bid = blockIdx.x, G = gridDim.x;
#define TRJOB(SRC, KK, NN, DST, LDK, KOFS, MODE, KS) { const int nk = (KK) / 64, nn = ((NN) + 63) / 64, tot = nk * nn; \
    int first = (bid - base % G + G) % G; \
    for (int t = first; t < tot; t += G) { const int n0_ = (t % nn) * 64; tr_tile((SRC), (NN), (t / nn) * 64, n0_, ((NN) - n0_) < 64 ? ((NN) - n0_) : 64, (DST), (LDK), (KOFS), (MODE), (KS), sm); } \
    base += tot; }
  for (int lj = 0; lj < 4; ++lj) {
    TRJOB(p.ffn_w1 + (size_t)lj * DM * DFF, DM, DFF, p.W13[lj], DM, 0, 1, nullptr);
    TRJOB(p.ffn_w3 + (size_t)lj * DM * DFF, DM, DFF, p.W13[lj], DM, 0, 2, nullptr);
    TRJOB(p.ffn_w2 + (size_t)lj * DFF * DM, DFF, DM, p.W2[lj], DFF, 0, 0, nullptr);
  }
  TRJOB(p.even_w_in, DM, 1952, p.WinE, DM, 0, 3, nullptr);
  TRJOB(p.w_uq, 256, 768, p.Wqkv, 2048, 0, 0, p.q_norm_g);
  TRJOB(p.w_ukv, 128, 1024, p.Wqkv + (size_t)768 * 2048, 2048, 256, 0, p.kv_norm_g);
  TRJOB(p.even_w_out, DM, DM, p.WoutE, DM, 0, 0, nullptr);
  TRJOB(p.odd_w_in, DM, 5120, p.WinO, DM, 0, 3, nullptr);
  TRJOB(p.odd_w_out, DM, DM, p.WoutO, DM, 0, 0, nullptr);
#undef TRJOB
  for (int i = bid * NTHR + tid; i < 96 * 1024; i += G * NTHR) p.WinE[(size_t)1952 * 1024 + i] = 0;
  for (int i = bid * NTHR + tid; i < 768 * 128; i += G * NTHR) p.Wqkv[(size_t)(i >> 7) * 2048 + 256 + (i & 127)] = 0;
  for (int i = bid * NTHR + tid; i < 1024 * 256; i += G * NTHR) p.Wqkv[(size_t)(768 + (i >> 8)) * 2048 + (i & 255)] = 0;
  for (int i = bid * NTHR + tid; i < M_ALL * 2; i += G * NTHR) p.RS[i] = 0.f;
  for (int i = bid * NTHR + tid; i < 1024; i += G * NTHR) p.aflag[i] = 0u;
  for (int i = bid * NTHR + tid; i < 8192 * 16; i += G * NTHR) {
    const int t = i >> 4, ax = (i >> 3) & 1, fi = i & 7;
    const float pos = (float)(ax == 0 ? (t >> 6) : (t & 63));
    const float ang = pos * exp2f(-(float)fi * (13.287712379549449f / 8.f));
    p.rope[(size_t)(t * 2 + ax) * 16 + fi] = cosf(ang); p.rope[(size_t)(t * 2 + ax) * 16 + 8 + fi] = sinf(ang);
  }
  {
    float* scond = sm;
    float* red = sm + 5 * 1024;
    for (int i = tid; i < 5 * 1024; i += NTHR) {
      const int mi = i >> 10, k = i & 1023;
      const float cv = mi < 4 ? p.c[mi * 1024 + k] : p.c_ctx[k];
      scond[i] = cv * sigmoidf_(cv);
    }
    __syncthreads();
    const int col = tid & 63, kg = tid >> 6;
    for (int it = G - 1 - bid; it < 2 * 144; it += G) {
      const int l = it / 144, n = (it % 144) * 64 + col;
      const float* w = p.ada_w + (size_t)l * 1024 * 9216 + n;
      float a0 = 0, a1 = 0, a2 = 0, a3 = 0, a4 = 0;
#pragma unroll 16
      for (int k = kg * 128; k < kg * 128 + 128; ++k) {
        const float wv = w[(size_t)k * 9216];
        a0 += scond[k] * wv; a1 += scond[1024 + k] * wv; a2 += scond[2048 + k] * wv; a3 += scond[3072 + k] * wv; a4 += scond[4096 + k] * wv;
      }
      red[(kg * 5 + 0) * 64 + col] = a0; red[(kg * 5 + 1) * 64 + col] = a1; red[(kg * 5 + 2) * 64 + col] = a2;
      red[(kg * 5 + 3) * 64 + col] = a3; red[(kg * 5 + 4) * 64 + col] = a4;
      __syncthreads();
      for (int i = tid; i < 5 * 64; i += NTHR) {
        const int mi = i >> 6, cc = i & 63, nn = (it % 144) * 64 + cc;
        float sacc = 0.f;
#pragma unroll
        for (int q = 0; q < 8; ++q) sacc += red[(q * 5 + mi) * 64 + cc];
        p.mod[((size_t)(l * 5 + mi)) * 9216 + nn] = sacc + p.ada_b[l * 9216 + nn];
      }
      __syncthreads();
    }
  }
}

__device__ __forceinline__ void phase_norm(const Params& p, int l, int j, const float* srcC, const float* srcL, int row0,
                           const float* PART = nullptr, int ksl = 0, float coef = 0.f, const float* pgate = nullptr) {
  constexpr int NR = 2;
  const int wave = threadIdx.x >> 6, lane = threadIdx.x & 63;
  const float* g = p.norm_g + (l * 3 + j) * 1024;
  f32x4 gv[4];
#pragma unroll
  for (int i = 0; i < 4; ++i) gv[i] = *(const f32x4*)(g + (lane + 64 * i) * 4);
  const int stride = gridDim.x * 8;
  for (int rb = row0 + blockIdx.x * 8 + wave; rb < M_ALL; rb += stride * NR) {
    f32x4 v[NR][4], sv[NR][4], hv[NR][4];
#pragma unroll
    for (int q = 0; q < NR; ++q) {
      const int rr = rb + q * stride, r = rr < M_ALL ? rr : M_ALL - 1;
      const float* src = r < NCTX ? srcC + (size_t)r * DM : srcL + (size_t)(r - NCTX) * DM;
      const float* sh = p.mod + ((size_t)(l * 5 + row_mi(r)) * 9 + 3 * j) * 1024;
#pragma unroll
      for (int i = 0; i < 4; ++i) { v[q][i] = ((const f32x4*)src)[lane + 64 * i]; hv[q][i] = ((const f32x4*)sh)[lane + 64 * i]; sv[q][i] = ((const f32x4*)(sh + 1024))[lane + 64 * i]; }
      if (ksl > 0 && r < NCTX) {
#pragma unroll
        for (int i = 0; i < 4; ++i) {
          f32x4 a = {0.f, 0.f, 0.f, 0.f};
          for (int sl = 0; sl < ksl; ++sl) a += ((const f32x4*)(PART + ((size_t)sl * NCTX + r) * DM))[lane + 64 * i];
          v[q][i] += coef * ((const f32x4*)pgate)[lane + 64 * i] * a;
        }
      }
    }
#pragma unroll
    for (int q = 0; q < NR; ++q) {
      const int rr = rb + q * stride, r = rr < M_ALL ? rr : M_ALL - 1;
      const bool live = rr < M_ALL;
      float ss = 0.f;
#pragma unroll
      for (int i = 0; i < 4; ++i) ss += v[q][i][0] * v[q][i][0] + v[q][i][1] * v[q][i][1] + v[q][i][2] * v[q][i][2] + v[q][i][3] * v[q][i][3];
      ss = wave_sum(ss);
      const float rstd = rsqrtf(ss * (1.f / 1024.f) + 1e-6f);
      if (live) {
        if (ksl > 0 && r < NCTX) {
#pragma unroll
          for (int i = 0; i < 4; ++i) ((f32x4*)(p.XC + (size_t)r * DM))[lane + 64 * i] = v[q][i];
        }
#pragma unroll
        for (int i = 0; i < 4; ++i) {
          const f32x4 u = v[q][i] * rstd * gv[i] * (1.f + sv[q][i]) + hv[q][i];
          u32x2 o; o.x = pk2(u[0], u[1]); o.y = pk2(u[2], u[3]);
          *(u32x2*)(p.U + (size_t)r * DM + (lane + 64 * i) * 4) = o;
        }
      }
    }
  }
}

__device__ __forceinline__ void phase_final_norm(const Params& p) {
  constexpr int NR = 4;
  const int wave = threadIdx.x >> 6, lane = threadIdx.x & 63;
  f32x4 gv[4];
#pragma unroll
  for (int i = 0; i < 4; ++i) gv[i] = *(const f32x4*)(p.final_norm_g + (lane + 64 * i) * 4);
  const int stride = gridDim.x * 8;
  for (int rb = blockIdx.x * 8 + wave; rb < 32768; rb += stride * NR) {
    f32x4 v[NR][4];
#pragma unroll
    for (int q = 0; q < NR; ++q) {
      const int rr = rb + q * stride, r = rr < 32768 ? rr : 32767;
#pragma unroll
      for (int i = 0; i < 4; ++i) v[q][i] = ((const f32x4*)(p.out + (size_t)r * DM))[lane + 64 * i];
    }
#pragma unroll
    for (int q = 0; q < NR; ++q) {
      const int rr = rb + q * stride, r = rr < 32768 ? rr : 32767;
      const bool live = rr < 32768;
      float ss = 0.f;
#pragma unroll
      for (int i = 0; i < 4; ++i) ss += v[q][i][0] * v[q][i][0] + v[q][i][1] * v[q][i][1] + v[q][i][2] * v[q][i][2] + v[q][i][3] * v[q][i][3];
      ss = wave_sum(ss);
      const float rstd = rsqrtf(ss * (1.f / 1024.f) + 1e-6f);
#pragma unroll
      for (int i = 0; i < 4; ++i) {
        const int c = (lane + 64 * i) * 4;
        if (live) ((f32x4*)(p.out + (size_t)r * DM))[lane + 64 * i] = v[q][i] * rstd * gv[i];
      }
    }
  }
}

__device__ void phase_even_elem(const Params& p, const bf16_t* P, bf16_t* CAT, bf16_t* Kall) {
  const int wave = threadIdx.x >> 6, lane = threadIdx.x & 63;
  for (int r = blockIdx.x * 8 + wave; r < M_ALL; r += gridDim.x * 8) {
    int b, key; row_bk(r, b, key);
    const bool latent = r >= NCTX;
    const int t = latent ? ((r - NCTX) & 8191) : (r & 255), T = latent ? 8192 : 256;
    const int c0 = lane * 8;
    float cv[3][8];
#pragma unroll
    for (int dt = 0; dt < 3; ++dt) {
      const int tt = t + dt - 1;
      if (tt >= 0 && tt < T) {
        const bf16_t* pr = P + (size_t)(r + dt - 1) * 2048;
        u32x4 gc = *(const u32x4*)(pr + 512 + c0), vv = *(const u32x4*)(pr + 1024 + c0);
#pragma unroll
        for (int e = 0; e < 4; ++e) { cv[dt][2 * e] = lo2f(gc[e]) * lo2f(vv[e]); cv[dt][2 * e + 1] = hi2f(gc[e]) * hi2f(vv[e]); }
      } else {
#pragma unroll
        for (int e = 0; e < 8; ++e) cv[dt][e] = 0.f;
      }
    }
    u32x4 gb = *(const u32x4*)(P + (size_t)r * 2048 + c0);
    float o[8];
#pragma unroll
    for (int e = 0; e < 8; ++e) {
      const float w0 = p.even_conv_w[c0 + e], w1 = p.even_conv_w[512 + c0 + e], w2 = p.even_conv_w[1024 + c0 + e];
      const float g = (e & 1) ? hi2f(gb[e >> 1]) : lo2f(gb[e >> 1]);
      o[e] = g * (cv[0][e] * w0 + cv[1][e] * w1 + cv[2][e] * w2);
    }
    u32x4 ov; ov.x = pk2(o[0], o[1]); ov.y = pk2(o[2], o[3]); ov.z = pk2(o[4], o[5]); ov.w = pk2(o[6], o[7]);
    *(u32x4*)(CAT + (size_t)r * DM + c0) = ov;
    {
      const int d = lane & 31;
      float v = bf2f(P[(size_t)r * 2048 + 1920 + d]);
      const float pv = __shfl_xor(v, 8);
      const int idx = d & 15, fi = idx & 7;
      if (latent) {
        const float* rp = p.rope + ((size_t)t * 2 + (d >> 4)) * 16 + fi;
        const float cs = rp[0], sn = rp[8];
        v = (idx < 8) ? (v * cs - pv * sn) : (pv * sn + v * cs);
      }
      const bf16_t bv = f2bf(v);
      if (lane < 32) {
#pragma unroll
        for (int h = 0; h < 8; ++h) Kall[((size_t)(b * 8 + h) * NKEY + key) * 96 + 64 + d] = bv;
      }
    }
  }
}

__device__ void phase_attn_scalar(const Params& p, const bf16_t* Qall, const bf16_t* Kall, const bf16_t* Vt, bf16_t* CAT) {
  const int ql = threadIdx.x & 255, half = threadIdx.x >> 8;
  for (int it = blockIdx.x; it < 1056; it += gridDim.x) {
    int b, h, q0, nk;
    if (it < 1024) { b = it >> 8; h = (it >> 5) & 7; q0 = 256 + (it & 31) * 256; nk = NKEY; }
    else { const int i2 = it - 1024; b = i2 >> 3; h = i2 & 7; q0 = 0; nk = 256; }
    const int qi = q0 + ql;
    const size_t bh = (size_t)(b * 8 + h);
    float q[96];
    {
      const u32x4* qp = (const u32x4*)(Qall + (bh * NKEY + qi) * 96);
#pragma unroll
      for (int i = 0; i < 12; ++i) { u32x4 v = qp[i];
#pragma unroll
        for (int e = 0; e < 4; ++e) { q[8 * i + 2 * e] = lo2f(v[e]); q[8 * i + 2 * e + 1] = hi2f(v[e]); } }
    }
    float o[32];
#pragma unroll
    for (int i = 0; i < 32; ++i) o[i] = 0.f;
    float mrun = -1e30f, lrun = 0.f;
    for (int k0 = 0; k0 < nk; k0 += 4) {
      float s[4];
#pragma unroll
      for (int kk = 0; kk < 4; ++kk) {
        const u32x4* kp = (const u32x4*)(Kall + (bh * NKEY + k0 + kk) * 96);
        float a = 0.f;
#pragma unroll
        for (int i = 0; i < 12; ++i) { u32x4 v = kp[i];
#pragma unroll
          for (int e = 0; e < 4; ++e) a += q[8 * i + 2 * e] * lo2f(v[e]) + q[8 * i + 2 * e + 1] * hi2f(v[e]); }
        s[kk] = a;
      }
      const float mx = fmaxf(fmaxf(s[0], s[1]), fmaxf(s[2], s[3]));
      const float mnew = fmaxf(mrun, mx);
      const float alpha = exp2f(mrun - mnew);
      const float p0 = exp2f(s[0] - mnew), p1 = exp2f(s[1] - mnew), p2 = exp2f(s[2] - mnew), p3 = exp2f(s[3] - mnew);
      lrun = lrun * alpha + p0 + p1 + p2 + p3;
      mrun = mnew;
#pragma unroll
      for (int dv = 0; dv < 32; ++dv) {
        u32x2 v = *(const u32x2*)(Vt + (bh * 64 + half * 32 + dv) * NKEY + k0);
        o[dv] = o[dv] * alpha + p0 * lo2f(v.x) + p1 * hi2f(v.x) + p2 * lo2f(v.y) + p3 * hi2f(v.y);
      }
    }
    const float il = 1.f / lrun;
    const int r = qi < 256 ? b * 256 + qi : NCTX + b * 8192 + (qi - 256);
    u32x4* op = (u32x4*)(CAT + (size_t)r * DM + 512 + h * 64 + half * 32);
#pragma unroll
    for (int i = 0; i < 4; ++i) {
      u32x4 v; v.x = pk2(o[8 * i] * il, o[8 * i + 1] * il); v.y = pk2(o[8 * i + 2] * il, o[8 * i + 3] * il);
      v.z = pk2(o[8 * i + 4] * il, o[8 * i + 5] * il); v.w = pk2(o[8 * i + 6] * il, o[8 * i + 7] * il);
      op[i] = v;
    }
  }
}

typedef float f32x16 __attribute__((ext_vector_type(16)));
__device__ __forceinline__ float ex2(float x) { return __builtin_amdgcn_exp2f(x); }
template <bool SAFE>
__device__ void phase_attn(const Params& p, const bf16_t* Qall, const bf16_t* Kall, const bf16_t* Vt, bf16_t* CAT, LAS unsigned char* lds) {
  const int tid = threadIdx.x, w = __builtin_amdgcn_readfirstlane(tid >> 6), lane = tid & 63, r = lane & 31, hh = lane >> 5;
  constexpr int KROW = 104, VROW = 72;
  constexpr int KBYTES = 64 * KROW * 2, VBYTES = 64 * VROW * 2, BUF = KBYTES + VBYTES;
  unsigned soff[3];
#pragma unroll
  for (int j = 0; j < 3; ++j) {
    const int ci = (3 * w + j) * 64 + lane;
    if (3 * w + j < 13) { const int row = ci / 13, part = ci % 13; soff[j] = (unsigned)(row * 96 + (part < 12 ? part : 0) * 8) * 2u; }
    else { const int c2 = ci - 832, dv = c2 / 9, part = c2 % 9; soff[j] = (unsigned)((dv < 64 ? dv : 0) * NKEY + (part < 8 ? part : 0) * 8) * 2u; }
  }
#define ATT_STAGE(bufi, k0_) do { _Pragma("unroll") for (int j_ = 0; j_ < 3; ++j_) if (j_ == 0 || w < 7) { \
    const char* g_ = (3 * w + j_ < 13) ? (const char*)kbase + soff[j_] + (size_t)(k0_) * 192 : (const char*)vbase + soff[j_] + (size_t)(k0_) * 2; \
    __builtin_amdgcn_global_load_lds((const unsigned*)g_, (LAS unsigned*)(lds + (bufi) * BUF + (3 * w + j_) * 1024), 16, 0, 0); } } while (0)
  for (int it = blockIdx.x; it < 544; it += gridDim.x) {
    if (SAFE && p.aflag[it] == 0u) continue;
    bool wbad = false;
    int b, h, q0, nk, nq;
    if (it < 512) { b = it >> 7; h = (it >> 4) & 7; q0 = 256 + (it & 15) * 512; nk = NKEY; nq = 512; }
    else { const int i2 = it - 512; b = i2 >> 3; h = i2 & 7; q0 = 0; nk = 256; nq = 256; }
    const size_t bh = (size_t)(b * 8 + h);
    const int qw = 64 * w;
    const bool wact = qw < nq;
    const int qbase = q0 + (wact ? qw : 0) + r;
    bf16x8 qf[2][6];
#pragma unroll
    for (int qb = 0; qb < 2; ++qb) {
      const bf16_t* qp = Qall + (bh * NKEY + qbase + 32 * qb) * 96 + 8 * hh;
#pragma unroll
      for (int c = 0; c < 6; ++c) qf[qb][c] = *(const bf16x8*)(qp + 16 * c);
    }
    f32x16 o[2][2];
#pragma unroll
    for (int qb = 0; qb < 2; ++qb)
#pragma unroll
      for (int i = 0; i < 16; ++i) { o[qb][0][i] = 0.f; o[qb][1][i] = 0.f; }
    float mrun[2] = {0.f, 0.f}, lrun[2] = {0.f, 0.f};
    const bf16_t* kbase = Kall + bh * NKEY * 96;
    const bf16_t* vbase = Vt + bh * 64 * NKEY;
    ATT_STAGE(0, 0);
    asm volatile("s_waitcnt vmcnt(0)" ::: "memory");
    __syncthreads();
    const int ntile = nk >> 6;
    for (int i = 0; i < ntile; ++i) {
      const bool more = (i + 1 < ntile);
      if (more) ATT_STAGE((i + 1) & 1, (i + 1) * 64);
      LAS unsigned char* kb_ = lds + (i & 1) * BUF;
      LAS unsigned char* vb_ = kb_ + KBYTES;
      f32x16 s[2][2];
#pragma unroll
      for (int qb = 0; qb < 2; ++qb)
#pragma unroll
        for (int e = 0; e < 16; ++e) { s[qb][0][e] = 0.f; s[qb][1][e] = 0.f; }
#pragma unroll
      for (int c = 0; c < 6; ++c) {
        const bf16x8 ka = *(const LAS bf16x8*)(kb_ + (r * KROW + 16 * c + 8 * hh) * 2);
        const bf16x8 kb2 = *(const LAS bf16x8*)(kb_ + ((32 + r) * KROW + 16 * c + 8 * hh) * 2);
#pragma unroll
        for (int qb = 0; qb < 2; ++qb) {
          s[qb][0] = __builtin_amdgcn_mfma_f32_32x32x16_bf16(ka, qf[qb][c], s[qb][0], 0, 0, 0);
          s[qb][1] = __builtin_amdgcn_mfma_f32_32x32x16_bf16(kb2, qf[qb][c], s[qb][1], 0, 0, 0);
        }
      }
#pragma unroll
      for (int qb = 0; qb < 2; ++qb) {
        if (SAFE) {
          float mx = fmaxf(s[qb][0][0], s[qb][1][0]);
#pragma unroll
          for (int e = 1; e < 16; ++e) mx = fmaxf(mx, fmaxf(s[qb][0][e], s[qb][1][e]));
          mx = fmaxf(mx, __shfl_xor(mx, 32));
          const bool need = (i == 0) || (mx - mrun[qb] > 8.f);
          if (__builtin_amdgcn_ballot_w64(need) != 0ull) {
            const float nm = need ? mx : mrun[qb];
            const float alpha = (i == 0) ? 1.f : ex2(mrun[qb] - nm);
            mrun[qb] = nm; lrun[qb] *= alpha;
#pragma unroll
            for (int e = 0; e < 16; ++e) { o[qb][0][e] *= alpha; o[qb][1][e] *= alpha; }
          }
        }
        f32x2 ps2 = {0.f, 0.f};
        const f32x2 m2 = {mrun[qb], mrun[qb]};
#pragma unroll
        for (int kb = 0; kb < 2; ++kb)
#pragma unroll
          for (int e = 0; e < 16; e += 2) {
            f32x2 t = {s[qb][kb][e], s[qb][kb][e + 1]};
            if (SAFE) t = t - m2;
            t.x = ex2(t.x); t.y = ex2(t.y);
            ps2 += t;
            s[qb][kb][e] = t.x; s[qb][kb][e + 1] = t.y;
          }
        lrun[qb] += ps2.x + ps2.y;
        if (!SAFE) wbad = wbad || !(ps2.x + ps2.y < 1.2089258e24f);
      }
#pragma unroll
      for (int kb = 0; kb < 2; ++kb)
#pragma unroll
        for (int t = 0; t < 2; ++t) {
          const int kofs = 32 * kb + 16 * t + 4 * hh;
          u32x4 va, vb2;
          { const u32x2 lo = *(const LAS u32x2*)(vb_ + (r * VROW + kofs) * 2), hi = *(const LAS u32x2*)(vb_ + (r * VROW + kofs + 8) * 2); va.x = lo.x; va.y = lo.y; va.z = hi.x; va.w = hi.y; }
          { const u32x2 lo = *(const LAS u32x2*)(vb_ + ((32 + r) * VROW + kofs) * 2), hi = *(const LAS u32x2*)(vb_ + ((32 + r) * VROW + kofs + 8) * 2); vb2.x = lo.x; vb2.y = lo.y; vb2.z = hi.x; vb2.w = hi.y; }
#pragma unroll
          for (int qb = 0; qb < 2; ++qb) {
            u32x4 pw;
            pw.x = pk2(s[qb][kb][8 * t], s[qb][kb][8 * t + 1]); pw.y = pk2(s[qb][kb][8 * t + 2], s[qb][kb][8 * t + 3]);
            pw.z = pk2(s[qb][kb][8 * t + 4], s[qb][kb][8 * t + 5]); pw.w = pk2(s[qb][kb][8 * t + 6], s[qb][kb][8 * t + 7]);
            const bf16x8 pf = __builtin_bit_cast(bf16x8, pw);
            o[qb][0] = __builtin_amdgcn_mfma_f32_32x32x16_bf16(__builtin_bit_cast(bf16x8, va), pf, o[qb][0], 0, 0, 0);
            o[qb][1] = __builtin_amdgcn_mfma_f32_32x32x16_bf16(__builtin_bit_cast(bf16x8, vb2), pf, o[qb][1], 0, 0, 0);
          }
        }
      asm volatile("s_waitcnt vmcnt(0)" ::: "memory");
      __syncthreads();
    }
    if (!SAFE) { if (__builtin_amdgcn_ballot_w64(wbad) != 0ull && lane == 0) p.aflag[it] = 1u; }
    if (wact) {
#pragma unroll
      for (int qb = 0; qb < 2; ++qb) {
        float l = lrun[qb]; l += __shfl_xor(l, 32);
        if (!SAFE) { if (__builtin_amdgcn_ballot_w64(!(l > 8.6736174e-19f)) != 0ull && lane == 0) p.aflag[it] = 1u; }
        const float il = 1.f / l;
        const int qi = qbase + 32 * qb;
        const int row = qi < 256 ? b * 256 + qi : NCTX + b * 8192 + (qi - 256);
        bf16_t* op = CAT + (size_t)row * DM + 512 + h * 64 + 4 * hh;
#pragma unroll
        for (int g = 0; g < 4; ++g) {
          u32x2 a; a.x = pk2(o[qb][0][4 * g] * il, o[qb][0][4 * g + 1] * il); a.y = pk2(o[qb][0][4 * g + 2] * il, o[qb][0][4 * g + 3] * il);
          *(u32x2*)(op + 8 * g) = a;
          u32x2 c; c.x = pk2(o[qb][1][4 * g] * il, o[qb][1][4 * g + 1] * il); c.y = pk2(o[qb][1][4 * g + 2] * il, o[qb][1][4 * g + 3] * il);
          *(u32x2*)(op + 32 + 8 * g) = c;
        }
      }
    }
  }
}
#undef ATT_STAGE

__device__ void phase_hgrn_scalar(const Params& p, int dir, const bf16_t* Qh, const bf16_t* Vv, const bf16_t* Gg, const _Float16* Lx, bf16_t* O, float* sm) {
  float* sf = sm; float* sk = sm + 128; float* sq = sm + 256; float* part = sm + 384;   float* red = sm + 896;
  const int tid = threadIdx.x, dv = tid & 127, kg = tid >> 7;
  for (int it = blockIdx.x; it < 32; it += gridDim.x) {
    const int b = it >> 3, h = it & 7;
    float S[32];
#pragma unroll
    for (int i = 0; i < 32; ++i) S[i] = 0.f;
    for (int n = 0; n < NKEY; ++n) {
      int r; bool latent = n >= 256;
      if (!latent) r = b * 256 + (dir == 0 ? n : 255 - n);
      else r = NCTX + b * 8192 + (dir == 0 ? (n - 256) : (8191 - (n - 256)));
      const size_t off = (size_t)r * DM + h * 128;
      if (tid < 128) {
        const float f = __expf((float)Lx[off + tid]);
        sf[tid] = f; sk[tid] = 1.f - f; sq[tid] = bf2f(Qh[off + tid]);
      }
      __syncthreads();
      const float v = bf2f(Vv[off + dv]);
      float po = 0.f;
#pragma unroll
      for (int i = 0; i < 32; ++i) { const int dk = kg * 32 + i; S[i] = sf[dk] * S[i] + sk[dk] * v; po += S[i] * sq[dk]; }
      if (latent) {
        part[kg * 128 + dv] = po;
        __syncthreads();
        if (tid < 128) {
          float o = part[tid] + part[128 + tid] + part[256 + tid] + part[384 + tid];
          if (dir == 0) O[off + tid] = f2bf(o);
          else {
            o += bf2f(O[off + tid]);
            float ss = wave_sum(o * o);
            if ((tid & 63) == 0) red[tid >> 6] = ss;
            part[tid] = o;
          }
        }
        __syncthreads();
        if (dir == 1 && tid < 128) {
          const float o = part[tid];
          const float rstd = rsqrtf((red[0] + red[1]) * (1.f / 128.f) + 1e-6f);
          const float g = bf2f(Gg[off + tid]);
          O[off + tid] = f2bf(o * rstd * p.g_norm_g[tid] * g * sigmoidf_(g));
        }
      }
      __syncthreads();
    }
  }
}

template <bool OUT>
__device__ void phase_hgrn(const Params& p, const bf16_t* Qh, const bf16_t* Vv, const _Float16* Lfb, bf16_t* Of, bf16_t* Ob, float* Sseg, float* Dlog, LAS unsigned char* lds) {
  constexpr int NSEG = 4, CPS = 33, NIT = OUT ? 64 * NSEG : 64 * (NSEG - 1);
  constexpr int QT = 0, KT = QT + 64 * 136 * 2, KE = KT + 64 * 136 * 2, VT = KE + 128 * 72 * 2, AT = VT + 128 * 72 * 2,
                ST = AT + 64 * 72 * 2, DC = ST + 128 * 136 * 2, TOT = DC + 512;
  const int tid = threadIdx.x, w = tid >> 6, lane = tid & 63, r = lane & 31, hh = lane >> 5;
  const int dk = tid & 127, tq = tid >> 7;
  const int dvb = w & 3, wh = w >> 2;
  for (int it = blockIdx.x; it < NIT; it += gridDim.x) {
    const int bhd = OUT ? it >> 2 : it / 3, sg = OUT ? it & 3 : it % 3;
    const int b = bhd >> 4, h = (bhd >> 1) & 7, dir = bhd & 1;
    const int c_begin = sg * CPS, c_end = c_begin + CPS;
    const _Float16* Lx = Lfb + (size_t)dir * ((size_t)M_ALL * DM);
    const int sgn = dir ? -1 : 1;
    f32x16 S0, S1;
#pragma unroll
    for (int e = 0; e < 16; ++e) { S0[e] = 0.f; S1[e] = 0.f; }
    if constexpr (OUT) {
      for (int sp = 0; sp < sg; ++sp) {
        const float* sp_ = Sseg + ((size_t)(bhd * 3 + sp) * 8 + w) * 2048;
        const float* dl = Dlog + (size_t)(bhd * 3 + sp) * 128;
#pragma unroll
        for (int g = 0; g < 4; ++g) {
          const f32x4 d0 = *(const f32x4*)(dl + 32 * (2 * wh) + 8 * g + 4 * hh), d1 = *(const f32x4*)(dl + 32 * (2 * wh + 1) + 8 * g + 4 * hh);
#pragma unroll
          for (int j = 0; j < 4; ++j) {
            S0[4 * g + j] = S0[4 * g + j] * __expf(d0[j]) + sp_[(4 * g + j) * 64 + lane];
            S1[4 * g + j] = S1[4 * g + j] * __expf(d1[j]) + sp_[1024 + (4 * g + j) * 64 + lane];
          }
        }
      }
#pragma unroll
      for (int g = 0; g < 4; ++g) {
        u32x2 a0; a0.x = pk2(S0[4 * g], S0[4 * g + 1]); a0.y = pk2(S0[4 * g + 2], S0[4 * g + 3]);
        *(LAS u32x2*)(lds + ST + ((32 * dvb + r) * 136 + 32 * (2 * wh) + 8 * g + 4 * hh) * 2) = a0;
        u32x2 a1; a1.x = pk2(S1[4 * g], S1[4 * g + 1]); a1.y = pk2(S1[4 * g + 2], S1[4 * g + 3]);
        *(LAS u32x2*)(lds + ST + ((32 * dvb + r) * 136 + 32 * (2 * wh + 1) + 8 * g + 4 * hh) * 2) = a1;
      }
    }
    float dsum = 0.f;
    _Float16 lfr[16]; bf16_t qr[16], vr[16];
    {
      const int cn = c_begin;
      const int rb0 = (cn < 4) ? b * 256 + (dir ? 255 - 64 * cn : 64 * cn) : NCTX + b * 8192 + (dir ? 8191 - 64 * (cn - 4) : 64 * (cn - 4));
      const size_t o0 = (size_t)(rb0 + sgn * 16 * tq) * DM + h * 128 + dk;
#pragma unroll
      for (int i = 0; i < 16; ++i) { const size_t o = o0 + (ptrdiff_t)(sgn * i) * DM; lfr[i] = Lx[o]; if constexpr (OUT) qr[i] = Qh[o]; else qr[i] = 0; vr[i] = Vv[o]; }
    }
    __syncthreads();
    for (int c = c_begin; c < c_end; ++c) {
      const int rbase = (c < 4) ? b * 256 + (dir ? 255 - 64 * c : 64 * c) : NCTX + b * 8192 + (dir ? 8191 - 64 * (c - 4) : 64 * (c - 4));
      float lf[16], cs[16];
      float run = 0.f;
#pragma unroll
      for (int i = 0; i < 16; ++i) { lf[i] = (float)lfr[i]; run += lf[i]; cs[i] = run; }
      *(LAS float*)(lds + TOT + (tq * 128 + dk) * 4) = run;
      __syncthreads();
      float offs = 0.f, blast = 0.f;
#pragma unroll
      for (int g = 0; g < 4; ++g) { const float t = *(const LAS float*)(lds + TOT + (g * 128 + dk) * 4); blast += t; if (g < tq) offs += t; }
      {
        const float eblast = __expf(blast);
        unsigned kew[8], vw[8];
#pragma unroll
        for (int i = 0; i < 16; i += 2) {
          float qt[2], kt[2], ke[2];
#pragma unroll
          for (int e = 0; e < 2; ++e) {
            const float bb = offs + cs[i + e];
            const float k = 1.f - __expf(lf[i + e]);
            const float ken = k * __expf(-bb);
            if constexpr (OUT) { qt[e] = bf2f(qr[i + e]) * __expf(bb); kt[e] = ken; }
            ke[e] = ken * eblast;
          }
          if constexpr (OUT) {
            const unsigned qp = pk2(qt[0], qt[1]), kp = pk2(kt[0], kt[1]);
            const int s = 16 * tq + i;
            *(LAS bf16_t*)(lds + QT + (s * 136 + dk) * 2) = (bf16_t)(qp & 0xffffu);
            *(LAS bf16_t*)(lds + QT + ((s + 1) * 136 + dk) * 2) = (bf16_t)(qp >> 16);
            *(LAS bf16_t*)(lds + KT + (s * 136 + dk) * 2) = (bf16_t)(kp & 0xffffu);
            *(LAS bf16_t*)(lds + KT + ((s + 1) * 136 + dk) * 2) = (bf16_t)(kp >> 16);
          }
          kew[i >> 1] = pk2(ke[0], ke[1]);
          vw[i >> 1] = (unsigned)vr[i] | ((unsigned)vr[i + 1] << 16);
        }
        *(LAS u32x4*)(lds + KE + (dk * 72 + 16 * tq) * 2) = (u32x4){kew[0], kew[1], kew[2], kew[3]};
        *(LAS u32x4*)(lds + KE + (dk * 72 + 16 * tq + 8) * 2) = (u32x4){kew[4], kew[5], kew[6], kew[7]};
        *(LAS u32x4*)(lds + VT + (dk * 72 + 16 * tq) * 2) = (u32x4){vw[0], vw[1], vw[2], vw[3]};
        *(LAS u32x4*)(lds + VT + (dk * 72 + 16 * tq + 8) * 2) = (u32x4){vw[4], vw[5], vw[6], vw[7]};
        if (tq == 0) *(LAS float*)(lds + DC + dk * 4) = eblast;
        dsum += blast;
      }
      __syncthreads();
      if (c + 1 < c_end) {
        const int cn = c + 1;
        const int rb = (cn < 4) ? b * 256 + (dir ? 255 - 64 * cn : 64 * cn) : NCTX + b * 8192 + (dir ? 8191 - 64 * (cn - 4) : 64 * (cn - 4));
        const size_t o0 = (size_t)(rb + sgn * 16 * tq) * DM + h * 128 + dk;
#pragma unroll
        for (int i = 0; i < 16; ++i) { const size_t o = o0 + (ptrdiff_t)(sgn * i) * DM; lfr[i] = Lx[o]; if constexpr (OUT) qr[i] = Qh[o]; else qr[i] = 0; vr[i] = Vv[o]; }
      }
      if (OUT && w < 3) {
        const int sb = (w == 2) ? 1 : 0, tb = (w == 0) ? 0 : 1;
        f32x16 a;
#pragma unroll
        for (int e = 0; e < 16; ++e) a[e] = 0.f;
#pragma unroll
        for (int ks = 0; ks < 8; ++ks) {
          const bf16x8 ka = *(const LAS bf16x8*)(lds + KT + ((32 * sb + r) * 136 + 16 * ks + 8 * hh) * 2);
          const bf16x8 qb = *(const LAS bf16x8*)(lds + QT + ((32 * tb + r) * 136 + 16 * ks + 8 * hh) * 2);
          a = __builtin_amdgcn_mfma_f32_32x32x16_bf16(ka, qb, a, 0, 0, 0);
        }
        const int tok = 32 * tb + r;
#pragma unroll
        for (int g = 0; g < 4; ++g) {
          const int s0 = 32 * sb + 8 * g + 4 * hh;
          const float v0 = (s0 + 0 <= tok) ? a[4 * g + 0] : 0.f, v1 = (s0 + 1 <= tok) ? a[4 * g + 1] : 0.f;
          const float v2 = (s0 + 2 <= tok) ? a[4 * g + 2] : 0.f, v3 = (s0 + 3 <= tok) ? a[4 * g + 3] : 0.f;
          u32x2 o; o.x = pk2(v0, v1); o.y = pk2(v2, v3);
          *(LAS u32x2*)(lds + AT + (tok * 72 + s0) * 2) = o;
        }
      }
      {
#pragma unroll
        for (int g = 0; g < 4; ++g) {
          const f32x4 d0 = *(const LAS f32x4*)(lds + DC + (32 * (2 * wh) + 8 * g + 4 * hh) * 4);
          const f32x4 d1 = *(const LAS f32x4*)(lds + DC + (32 * (2 * wh + 1) + 8 * g + 4 * hh) * 4);
#pragma unroll
          for (int j = 0; j < 4; ++j) { S0[4 * g + j] *= d0[j]; S1[4 * g + j] *= d1[j]; }
        }
#pragma unroll
        for (int ks = 0; ks < 4; ++ks) {
          const bf16x8 vb = *(const LAS bf16x8*)(lds + VT + ((32 * dvb + r) * 72 + 16 * ks + 8 * hh) * 2);
          const bf16x8 k0 = *(const LAS bf16x8*)(lds + KE + ((32 * (2 * wh) + r) * 72 + 16 * ks + 8 * hh) * 2);
          const bf16x8 k1 = *(const LAS bf16x8*)(lds + KE + ((32 * (2 * wh + 1) + r) * 72 + 16 * ks + 8 * hh) * 2);
          S0 = __builtin_amdgcn_mfma_f32_32x32x16_bf16(k0, vb, S0, 0, 0, 0);
          S1 = __builtin_amdgcn_mfma_f32_32x32x16_bf16(k1, vb, S1, 0, 0, 0);
        }
      }
      if constexpr (OUT) {
      __syncthreads();
      {
        const int tb = wh;
        f32x16 o;
#pragma unroll
        for (int e = 0; e < 16; ++e) o[e] = 0.f;
#pragma unroll
        for (int ks = 0; ks < 4; ++ks) {
          if (ks < 2 * (tb + 1)) {
            const bf16x8 va = *(const LAS bf16x8*)(lds + VT + ((32 * dvb + r) * 72 + 16 * ks + 8 * hh) * 2);
            const bf16x8 ab = *(const LAS bf16x8*)(lds + AT + ((32 * tb + r) * 72 + 16 * ks + 8 * hh) * 2);
            o = __builtin_amdgcn_mfma_f32_32x32x16_bf16(va, ab, o, 0, 0, 0);
          }
        }
#pragma unroll
        for (int ks = 0; ks < 8; ++ks) {
          const bf16x8 sa = *(const LAS bf16x8*)(lds + ST + ((32 * dvb + r) * 136 + 16 * ks + 8 * hh) * 2);
          const bf16x8 qb = *(const LAS bf16x8*)(lds + QT + ((32 * tb + r) * 136 + 16 * ks + 8 * hh) * 2);
          o = __builtin_amdgcn_mfma_f32_32x32x16_bf16(sa, qb, o, 0, 0, 0);
        }
        if (c >= 4) {
          const int row = rbase + sgn * (32 * tb + r);
          bf16_t* op = (dir ? Ob + (size_t)(row - NCTX) * DM : Of + (size_t)row * DM) + h * 128 + 32 * dvb + 4 * hh;
#pragma unroll
          for (int g = 0; g < 4; ++g) {
            u32x2 ov; ov.x = pk2(o[4 * g], o[4 * g + 1]); ov.y = pk2(o[4 * g + 2], o[4 * g + 3]);
            *(u32x2*)(op + 8 * g) = ov;
          }
        }
      }
      __syncthreads();
#pragma unroll
      for (int g = 0; g < 4; ++g) {
        u32x2 a0; a0.x = pk2(S0[4 * g], S0[4 * g + 1]); a0.y = pk2(S0[4 * g + 2], S0[4 * g + 3]);
        *(LAS u32x2*)(lds + ST + ((32 * dvb + r) * 136 + 32 * (2 * wh) + 8 * g + 4 * hh) * 2) = a0;
        u32x2 a1; a1.x = pk2(S1[4 * g], S1[4 * g + 1]); a1.y = pk2(S1[4 * g + 2], S1[4 * g + 3]);
        *(LAS u32x2*)(lds + ST + ((32 * dvb + r) * 136 + 32 * (2 * wh + 1) + 8 * g + 4 * hh) * 2) = a1;
      }
      }
    }
    if constexpr (!OUT) {
      float* sp_ = Sseg + ((size_t)(bhd * 3 + sg) * 8 + w) * 2048;
#pragma unroll
      for (int e = 0; e < 16; ++e) { sp_[e * 64 + lane] = S0[e]; sp_[1024 + e * 64 + lane] = S1[e]; }
      if (tq == 0) Dlog[(size_t)(bhd * 3 + sg) * 128 + dk] = dsum;
    }
    __syncthreads();
  }
}

__device__ void phase_hgrn_readout(const Params& p, bf16_t* Of, const bf16_t* Ob, const bf16_t* Gg) {
  const int wave = threadIdx.x >> 6, lane = threadIdx.x & 63;
  for (int r = NCTX + blockIdx.x * 8 + wave; r < M_ALL; r += gridDim.x * 8) {
    const int c0 = lane * 16;
    float o[16];
#pragma unroll
    for (int i = 0; i < 2; ++i) {
      const u32x4 a = *(const u32x4*)(Of + (size_t)r * DM + c0 + 8 * i), bq = *(const u32x4*)(Ob + (size_t)(r - NCTX) * DM + c0 + 8 * i);
#pragma unroll
      for (int e = 0; e < 4; ++e) { o[8 * i + 2 * e] = lo2f(a[e]) + lo2f(bq[e]); o[8 * i + 2 * e + 1] = hi2f(a[e]) + hi2f(bq[e]); }
    }
    float ss = 0.f;
#pragma unroll
    for (int i = 0; i < 16; ++i) ss += o[i] * o[i];
    ss += __shfl_xor(ss, 1); ss += __shfl_xor(ss, 2); ss += __shfl_xor(ss, 4);
    const float rstd = rsqrtf(ss * (1.f / 128.f) + 1e-6f);
    const int cg = c0 & 127;
#pragma unroll
    for (int i = 0; i < 2; ++i) {
      const u32x4 gq = *(const u32x4*)(Gg + (size_t)r * DM + c0 + 8 * i);
      float y[8];
#pragma unroll
      for (int e = 0; e < 8; ++e) {
        const float g = (e & 1) ? hi2f(gq[e >> 1]) : lo2f(gq[e >> 1]);
        y[e] = o[8 * i + e] * rstd * p.g_norm_g[cg + 8 * i + e] * g * sigmoidf_(g);
      }
      u32x4 ov; ov.x = pk2(y[0], y[1]); ov.y = pk2(y[2], y[3]); ov.z = pk2(y[4], y[5]); ov.w = pk2(y[6], y[7]);
      *(u32x4*)(Of + (size_t)r * DM + c0 + 8 * i) = ov;
    }
  }
}

#define XB_TMO      128
#define XB_XCNT(j)  (256  + 64 * (j))
#define XB_XSUB(j)  (1280 + 64 * (j))
#define XB_XGEN(j)  (2304 + 64 * (j))
#define XB_TOP      3328
#define XB_TOPGEN   3392
#define XCD_BAR_WORDS 3456
#define XB_SPIN_CAP (1u << 22)
__device__ __forceinline__ unsigned xb_ld(unsigned* p)              { return __hip_atomic_load(p, __ATOMIC_RELAXED, __HIP_MEMORY_SCOPE_AGENT); }
__device__ __forceinline__ unsigned xb_add(unsigned* p, unsigned v) { return __hip_atomic_fetch_add(p, v, __ATOMIC_RELAXED, __HIP_MEMORY_SCOPE_AGENT); }
__device__ __forceinline__ unsigned xb_xcc_id() { return (unsigned)__builtin_amdgcn_s_getreg((3 << 11) | 20) & 0xFu; }
#define XB_SPIN(cond, bar) do { unsigned _sp = 0; while (cond) { __builtin_amdgcn_s_sleep(1); \
    if ((++_sp & 255u) == 0u) { if (xb_ld(&(bar)[XB_TMO])) break; if (_sp > XB_SPIN_CAP) { atomicAdd(&(bar)[XB_TMO], 1u); break; } } } } while (0)
__device__ __forceinline__ void xcd_barrier_complete(unsigned* bar, unsigned x, unsigned& nloc, unsigned& nx) {
  const unsigned G = gridDim.x * gridDim.y * gridDim.z;
  unsigned sum, cnt, mine, sp = 0u;
  for (;;) {
    sum = 0u; cnt = 0u; mine = 0u;
#pragma unroll
    for (unsigned j = 0; j < 16; ++j) { const unsigned c = xb_ld(&bar[XB_XCNT(j)]); sum += c; cnt += (c > 0u) ? 1u : 0u; mine = (j == x) ? c : mine; }
    if (sum == G) break;
    __builtin_amdgcn_s_sleep(1);
    if ((++sp & 255u) == 0u) { if (xb_ld(&bar[XB_TMO])) break; if (sp > XB_SPIN_CAP) { atomicAdd(&bar[XB_TMO], 1u); break; } }
  }
  nloc = mine > 0u ? mine : 1u; nx = cnt > 0u ? cnt : 1u;
}
__device__ __forceinline__ void xcd_barrier(unsigned* bar, volatile LAS unsigned* st) {
  asm volatile("s_waitcnt vmcnt(0)" ::: "memory");
  __syncthreads();
  if (threadIdx.x == 0) {
    const unsigned x = xb_xcc_id();
    __builtin_amdgcn_s_waitcnt(0);
    unsigned nloc = st[0], nx = st[1];
    if (nloc == 0u) { xcd_barrier_complete(bar, x, nloc, nx); st[0] = nloc; st[1] = nx; }
    const unsigned old = xb_add(&bar[XB_XSUB(x)], 1u);
    const unsigned gen = old / nloc;
    if (old + 1u == (gen + 1u) * nloc) {
      __builtin_amdgcn_fence(__ATOMIC_RELEASE, "agent");
      asm volatile("s_waitcnt vmcnt(0)" ::: "memory");
      const unsigned og = xb_add(&bar[XB_TOP], 1u);
      const unsigned tg = og / nx;
      if (og + 1u == (tg + 1u) * nx) xb_add(&bar[XB_TOPGEN], 1u);
      else XB_SPIN(xb_ld(&bar[XB_TOPGEN]) == tg, bar);
      __builtin_amdgcn_fence(__ATOMIC_ACQUIRE, "agent");
      xb_add(&bar[XB_XGEN(x)], 1u);
      asm volatile("s_waitcnt vmcnt(0)" ::: "memory");
    } else {
      XB_SPIN(xb_ld(&bar[XB_XGEN(x)]) == gen, bar);
      __builtin_amdgcn_fence(__ATOMIC_ACQUIRE, "agent");
      asm volatile("s_waitcnt vmcnt(0)" ::: "memory");
    }
  }
  __syncthreads();
}


template <int PH>
__device__ __forceinline__ void run_phase(const Params& p, bf16_t* shm_) {
  float* smf = (float*)shm_;
  LAS unsigned char* shm = (LAS unsigned char*)shm_;
  const size_t MR = (size_t)M_ALL;
  bf16_t* G = (bf16_t*)p.R;
  bf16_t* P = (bf16_t*)p.R;
  bf16_t* Qall = P + MR * 2048;
  bf16_t* Kall = Qall + (size_t)32 * NKEY * 96;
  bf16_t* Vt = Kall + (size_t)32 * NKEY * 96;
  bf16_t* Qh = (bf16_t*)p.R;
  bf16_t* Vv = Qh + MR * DM;
  bf16_t* Gg = Vv + MR * DM;
  _Float16* Lf = (_Float16*)(Gg + MR * DM);
  _Float16* Lb = Lf + MR * DM;
  const size_t MODL = (size_t)5 * 9216;
  float* PARTF = (float*)(G + MR * DFF);
  float* PARTE = (float*)(Vt + (size_t)32 * 64 * NKEY);
  const float* CG = p.mod + (size_t)4 * 9 * 1024;
  if constexpr (PH == 0) phase_prep(p, smf);
  if constexpr (PH == 1) phase_norm(p, 0, 0, p.ctx, p.x, 0);
  if constexpr (PH == 2) gemm_phase(p.U, DM, p.W13[0], DM, DM, 0, 132, 0, 22, EpiSwiglu{G}, shm);
  if constexpr (PH == 3) gemm_phase(G, DFF, p.W2[0], DFF, DFF, 4, 128, 0, 4, EpiResid{p.ctx, p.x, p.XC, p.out, p.mod + 2 * 1024, 0.5f}, shm, 4, 11, EpiPart{PARTF});
  if constexpr (PH == 4) phase_norm(p, 0, 1, p.ctx, p.out, 0, PARTF, 11, 0.5f, CG + 2 * 1024);
  if constexpr (PH == 5) gemm_phase(p.U, DM, p.WinE, DM, DM, 0, 132, 0, 8, EpiP{P, p.RS}, shm);
  if constexpr (PH == 6) { gemm_phase(P + 1536, 2048, p.Wqkv, 2048, 384, 0, 132, 0, 7, EpiQKV{EpiQ{p.RS, p.rope, Qall}, EpiKV{p.RS, Kall, Vt}}, shm);
                           phase_even_elem(p, P, p.U, Kall); }
  if constexpr (PH == 7) phase_attn<false>(p, Qall, Kall, Vt, p.U, shm);
  if constexpr (PH == 25) phase_attn<true>(p, Qall, Kall, Vt, p.U, shm);
  if constexpr (PH == 8) gemm_phase(p.U, DM, p.WoutE, DM, DM, 4, 128, 0, 4, EpiResid{p.XC, p.out, p.XC, p.out, p.mod + 5 * 1024, 1.0f}, shm, 4, 4, EpiPart{PARTE});
  if constexpr (PH == 9) phase_norm(p, 0, 2, p.XC, p.out, 0, PARTE, 4, 1.0f, CG + 5 * 1024);
  if constexpr (PH == 10) gemm_phase(p.U, DM, p.W13[1], DM, DM, 0, 132, 0, 22, EpiSwiglu{G}, shm);
  if constexpr (PH == 11) gemm_phase(G, DFF, p.W2[1], DFF, DFF, 4, 128, 0, 4, EpiResid{p.XC, p.out, p.XC, p.out, p.mod + 8 * 1024, 0.5f}, shm, 4, 11, EpiPart{PARTF});
  if constexpr (PH == 12) phase_norm(p, 1, 0, p.XC, p.out, 0, PARTF, 11, 0.5f, CG + 8 * 1024);
  if constexpr (PH == 13) gemm_phase(p.U, DM, p.W13[2], DM, DM, 0, 132, 0, 22, EpiSwiglu{G}, shm);
  if constexpr (PH == 14) gemm_phase(G, DFF, p.W2[2], DFF, DFF, 4, 128, 0, 4, EpiResid{p.XC, p.out, p.XC, p.out, p.mod + MODL + 2 * 1024, 0.5f}, shm, 4, 11, EpiPart{PARTF});
  if constexpr (PH == 15) phase_norm(p, 1, 1, p.XC, p.out, 0, PARTF, 11, 0.5f, CG + MODL + 2 * 1024);
  if constexpr (PH == 16) gemm_phase(p.U, DM, p.WinO, DM, DM, 0, 132, 0, 20, EpiOdd{Qh, Vv, Gg, Lf, Lb, p.lb_logits}, shm);
  bf16_t* Ob = (bf16_t*)(Lb + MR * DM);
  float* Sseg = (float*)(Ob + (size_t)32768 * DM);
  float* Dlg = Sseg + (size_t)192 * 16384;
  if constexpr (PH == 17) phase_hgrn<false>(p, Qh, Vv, Lf, p.U, Ob, Sseg, Dlg, shm);
  if constexpr (PH == 18) phase_hgrn<true>(p, Qh, Vv, Lf, p.U, Ob, Sseg, Dlg, shm);
  if constexpr (PH == 24) phase_hgrn_readout(p, p.U, Ob, Gg);
  if constexpr (PH == 19) gemm_phase(p.U, DM, p.WoutO, DM, DM, 4, 128, 0, 4, EpiResid{p.XC, p.out, p.XC, p.out, p.mod + MODL + 5 * 1024, 1.0f}, shm);
  if constexpr (PH == 20) phase_norm(p, 1, 2, p.XC, p.out, NCTX);
  if constexpr (PH == 21) gemm_phase(p.U, DM, p.W13[3], DM, DM, 4, 128, 0, 22, EpiSwiglu{G}, shm);
  if constexpr (PH == 22) gemm_phase(G, DFF, p.W2[3], DFF, DFF, 4, 128, 0, 4, EpiResid{p.XC, p.out, p.XC, p.out, p.mod + MODL + 8 * 1024, 0.5f}, shm);
  if constexpr (PH == 23) phase_final_norm(p);
}

constexpr int N_PHASES = 24;

#define PROBE_DUP -1
template <int PH>
__device__ __forceinline__ void step(const Params& p, int ph0, int ph1, bf16_t* shm) {
  if ((ph0 <= PH && PH < ph1) || (PH >= 24 && ph1 - ph0 > 1)) {
    run_phase<PH>(p, shm);
    if constexpr (PH == PROBE_DUP) { xcd_barrier(p.bar, (volatile LAS unsigned*)((LAS unsigned char*)shm + SHM_B)); run_phase<PH>(p, shm); }
    if (PH != 23 && ph1 - ph0 > 1) xcd_barrier(p.bar, (volatile LAS unsigned*)((LAS unsigned char*)shm + SHM_B));
  }
}

__global__ void __launch_bounds__(NTHR, 2) mega(Params p, int ph0, int ph1) {
  extern __shared__ __attribute__((aligned(16))) bf16_t shm[];
  if (ph1 < 0) cg::this_grid().sync();
  {
    volatile LAS unsigned* st = (volatile LAS unsigned*)((LAS unsigned char*)shm + SHM_B);
    if (threadIdx.x == 0) { st[0] = 0u; st[1] = 0u; }
    __syncthreads();
    if (threadIdx.x == 0) (void)xb_add(&p.bar[XB_XCNT(xb_xcc_id())], 1u);
  }
  step<0>(p, ph0, ph1, shm); step<1>(p, ph0, ph1, shm); step<2>(p, ph0, ph1, shm); step<3>(p, ph0, ph1, shm);
  step<4>(p, ph0, ph1, shm); step<5>(p, ph0, ph1, shm); step<6>(p, ph0, ph1, shm); step<7>(p, ph0, ph1, shm); step<25>(p, ph0, ph1, shm);
  step<8>(p, ph0, ph1, shm); step<9>(p, ph0, ph1, shm); step<10>(p, ph0, ph1, shm); step<11>(p, ph0, ph1, shm);
  step<12>(p, ph0, ph1, shm); step<13>(p, ph0, ph1, shm); step<14>(p, ph0, ph1, shm); step<15>(p, ph0, ph1, shm);
  step<16>(p, ph0, ph1, shm); step<17>(p, ph0, ph1, shm); step<18>(p, ph0, ph1, shm); step<24>(p, ph0, ph1, shm); step<19>(p, ph0, ph1, shm);
  step<20>(p, ph0, ph1, shm); step<21>(p, ph0, ph1, shm); step<22>(p, ph0, ph1, shm); step<23>(p, ph0, ph1, shm);
}

extern "C" void kernel_launch(void* const* d_in, const int* in_sizes, int n_in, void* d_out, int out_size, void* d_ws, size_t ws_size,
                              hipStream_t stream) {
  Params p{};
  const float** f = (const float**)&p;
  for (int i = 0; i < 22; ++i) f[i] = (const float*)d_in[i];
  p.out = (float*)d_out;
  char* w = (char*)d_ws; size_t off = 0;
  auto take = [&](size_t bytes) { char* r = w + off; off += (bytes + 255) & ~(size_t)255; return r; };
  p.W13[3] = (bf16_t*)take((size_t)2 * DFF * DM * 2);
  p.W2[3] = (bf16_t*)take((size_t)DM * DFF * 2);
  p.WinO = (bf16_t*)take((size_t)5120 * 1024 * 2);
  p.WoutO = (bf16_t*)take((size_t)1024 * 1024 * 2);
  p.mod = (float*)take((size_t)2 * 5 * 9216 * 4);
  p.XC = (float*)take((size_t)NCTX * DM * 4);
  p.RS = (float*)take((size_t)M_ALL * 2 * 4);
  p.rope = (float*)take((size_t)8192 * 32 * 4);
  p.bar = (unsigned*)take((size_t)XCD_BAR_WORDS * 4);
  p.aflag = (unsigned*)take((size_t)1024 * 4);
  p.U = (bf16_t*)take((size_t)M_ALL * DM * 2);
  p.R = take(0);
  {
    const size_t early = (size_t)3 * (2 * DFF * DM * 2) + (size_t)3 * (DM * DFF * 2) + (size_t)2048 * 1024 * 2 + (size_t)1792 * 2048 * 2 + (size_t)1024 * 1024 * 2;
    size_t e0 = (ws_size - early) & ~(size_t)255;
    const size_t rbytes = e0 - off;
    if (rbytes < (size_t)M_ALL * DM * 2 * 5 || ws_size - off < (size_t)M_ALL * DM * 2 * 5 + (size_t)32768 * DM * 2)
      fprintf(stderr, "workspace too small: R=%zu ws=%zu\n", rbytes, ws_size);
    if (ws_size - off < (size_t)M_ALL * DM * 2 * 5 + (size_t)32768 * DM * 2 + (size_t)192 * 16384 * 4 + 192 * 128 * 4) fprintf(stderr, "workspace too small for Sseg\n");
    off = e0;
    for (int i = 0; i < 3; ++i) p.W13[i] = (bf16_t*)take((size_t)2 * DFF * DM * 2);
    for (int i = 0; i < 3; ++i) p.W2[i] = (bf16_t*)take((size_t)DM * DFF * 2);
    p.WinE = (bf16_t*)take((size_t)2048 * 1024 * 2);
    p.Wqkv = (bf16_t*)take((size_t)1792 * 2048 * 2);
    p.WoutE = (bf16_t*)take((size_t)1024 * 1024 * 2);
  }
  static bool attr_done = false;
  if (!attr_done) { (void)hipFuncSetAttribute((const void*)mega, hipFuncAttributeMaxDynamicSharedMemorySize, SHM_B + 256); attr_done = true; }
#if 0
  for (int ph = 0; ph < N_PHASES; ++ph) {
    hipLaunchKernelGGL(mega, dim3(256), dim3(NTHR), SHM_B, stream, p, ph, ph + 1);
  }
#else
  static int grid_blocks = 0;
  if (!grid_blocks) {
    int dev = 0, cus = 0, per_cu = 0;
    hipGetDevice(&dev);
    hipDeviceGetAttribute(&cus, hipDeviceAttributeMultiprocessorCount, dev);
    hipOccupancyMaxActiveBlocksPerMultiprocessor(&per_cu, mega, NTHR, SHM_B + 256);
    if (per_cu > 1) per_cu = 1;
    grid_blocks = cus * per_cu;
  }
  int ph0 = 0, ph1 = N_PHASES;
  void* args[] = {&p, &ph0, &ph1};
  (void)hipMemsetAsync(p.bar, 0, (size_t)XCD_BAR_WORDS * 4, stream);
  hipError_t e = hipLaunchCooperativeKernel((void*)mega, dim3(grid_blocks), dim3(NTHR), args, SHM_B + 256, stream);
  if (e != hipSuccess) fprintf(stderr, "cooperative launch failed: %s (grid %d)\n", hipGetErrorString(e), grid_blocks);
#endif
}
```
